# Optimizing an MI355X kernel written in HIP

```python
import math
import jax
import jax.numpy as jnp
from jax import lax
import numpy as np

D_MODEL = 2048
BATCH = 8
SEQ = 2048
DEPTH = 1

NORM_EPS = 1e-6
CONV_WIDTH = 4
PLE_DIM = 256

GDN_HEAD_DIM = 128
GDN_V_HEADS = D_MODEL // 128
GDN_QK_HEADS = GDN_V_HEADS // 2
GDN_KEY_DIM = GDN_QK_HEADS * GDN_HEAD_DIM
GDN_VALUE_DIM = GDN_V_HEADS * GDN_HEAD_DIM
GDN_CONV_CH = 2 * GDN_KEY_DIM + GDN_VALUE_DIM
GDN_CHUNK = 64

SSM_HEAD_DIM = 64
SSM_HEADS = D_MODEL // 64
SSM_INNER = SSM_HEADS * SSM_HEAD_DIM
SSM_GROUPS = 4
SSM_STATE = 128
SSM_CONV_CH = SSM_INNER + 2 * SSM_GROUPS * SSM_STATE
SSM_CHUNK = 128

D_MIX = GDN_VALUE_DIM + SSM_INNER
IN_SIZES = (GDN_CONV_CH, GDN_VALUE_DIM, GDN_V_HEADS, GDN_V_HEADS, SSM_CONV_CH, SSM_INNER, SSM_HEADS)
IN_COLS = GDN_CONV_CH + GDN_VALUE_DIM + 2 * GDN_V_HEADS + SSM_CONV_CH + SSM_INNER + SSM_HEADS

N_EXPERTS = 32
TOP_K = 4
EXPERT_FF = D_MODEL
SWIGLU_ALPHA = 1.702
SWIGLU_LIMIT = 7.0
MOE_BLOCK = 128

kernel_name = 'hybrid_gdn_ssd_moe_ple_layer'


def rms_norm(x, w):
    xf = x.astype(jnp.float32)
    y = xf * lax.rsqrt(jnp.mean(xf * xf, axis=-1, keepdims=True) + NORM_EPS)
    return (y * w.astype(jnp.float32)).astype(x.dtype)


def l2_normalize(x):
    return x * lax.rsqrt(jnp.sum(x * x, axis=-1, keepdims=True) + NORM_EPS)


def split_columns(t, sizes):
    points = []
    acc = 0
    for s in sizes[:-1]:
        acc += s
        points.append(acc)
    return jnp.split(t, points, axis=-1)


def causal_depthwise_conv(x, w):
    width = w.shape[0]
    seq = x.shape[1]
    xp = jnp.pad(x, ((0, 0), (width - 1, 0), (0, 0)))
    out = xp[:, 0:seq] * w[0]
    for k in range(1, width):
        out = out + xp[:, k:k + seq] * w[k]
    return out


def to_chunks(t, chunk):
    bsz, seq = t.shape[0], t.shape[1]
    t = t.reshape((bsz, seq // chunk, chunk) + t.shape[2:])
    return jnp.moveaxis(t, 3, 2)


def chunked_gated_delta_rule(q, k, v, g, beta):
    bsz, seq, heads, dk = k.shape
    dv = v.shape[-1]
    c = GDN_CHUNK
    q, k, v = to_chunks(q, c), to_chunks(k, c), to_chunks(v, c)
    g, beta = to_chunks(g, c), to_chunks(beta, c)
    g = jnp.cumsum(g, axis=-1)
    causal = jnp.tril(jnp.ones((c, c), dtype=bool))
    strict = jnp.tril(jnp.ones((c, c), dtype=bool), -1)
    decay = jnp.exp(jnp.where(causal, g[..., :, None] - g[..., None, :], -jnp.inf))
    k_beta = k * beta[..., None]
    v_beta = v * beta[..., None]
    lmat = jnp.where(strict, jnp.einsum('bnhcd,bnhsd->bnhcs', k_beta, k) * decay, 0.0)
    tmat = lmat + jnp.eye(c, dtype=lmat.dtype)
    rhs = jnp.concatenate([v_beta, k_beta * jnp.exp(g)[..., None]], axis=-1)
    sol = lax.linalg.triangular_solve(tmat, rhs, left_side=True, lower=True, unit_diagonal=True)
    u, w = sol[..., :dv], sol[..., dv:]
    attn = jnp.einsum('bnhcd,bnhsd->bnhcs', q, k) * decay
    q_dec = q * jnp.exp(g)[..., None]
    k_dec = k * jnp.exp(g[..., -1:] - g)[..., None]
    g_last = jnp.exp(g[..., -1])

    def step(state, inp):
        attn_c, u_c, w_c, qd_c, kd_c, gl_c = inp
        v_new = u_c - jnp.einsum('bhcd,bhdv->bhcv', w_c, state)
        o_c = jnp.einsum('bhcd,bhdv->bhcv', qd_c, state) + jnp.einsum('bhcs,bhsv->bhcv', attn_c, v_new)
        state = state * gl_c[..., None, None] + jnp.einsum('bhcd,bhcv->bhdv', kd_c, v_new)
        return state, o_c

    xs = tuple(jnp.moveaxis(t, 1, 0) for t in (attn, u, w, q_dec, k_dec, g_last))
    state0 = jnp.zeros((bsz, heads, dk, dv), jnp.float32)
    _, o = lax.scan(step, state0, xs)
    o = jnp.moveaxis(jnp.moveaxis(o, 0, 1), 3, 2)
    return o.reshape(bsz, seq, heads, dv)


def gated_deltanet_group(qkv, z, b, a, conv_w, a_log, dt_bias, norm_w):
    bsz, seq, _ = qkv.shape
    f32 = jnp.float32
    qkv = jax.nn.silu(causal_depthwise_conv(qkv, conv_w)).astype(f32)
    q, k, v = jnp.split(qkv, [GDN_KEY_DIM, 2 * GDN_KEY_DIM], axis=-1)
    rep = GDN_V_HEADS // GDN_QK_HEADS
    q = jnp.repeat(l2_normalize(q.reshape(bsz, seq, GDN_QK_HEADS, GDN_HEAD_DIM)), rep, axis=2) * (GDN_HEAD_DIM ** -0.5)
    k = jnp.repeat(l2_normalize(k.reshape(bsz, seq, GDN_QK_HEADS, GDN_HEAD_DIM)), rep, axis=2)
    v = v.reshape(bsz, seq, GDN_V_HEADS, GDN_HEAD_DIM)
    beta = jax.nn.sigmoid(b.astype(f32))
    g = -jnp.exp(a_log.astype(f32)) * jax.nn.softplus(a.astype(f32) + dt_bias.astype(f32))
    o = chunked_gated_delta_rule(q, k, v, g, beta)
    o = rms_norm(o, norm_w) * jax.nn.silu(z.astype(f32).reshape(bsz, seq, GDN_V_HEADS, GDN_HEAD_DIM))
    return o.reshape(bsz, seq, GDN_VALUE_DIM)


def chunked_ssd(x, a, bm, cm):
    bsz, seq, heads, hp = x.shape
    c = SSM_CHUNK
    nc = seq // c
    hg = heads // SSM_GROUPS
    x = x.reshape(bsz, nc, c, SSM_GROUPS, hg, hp)
    a = a.reshape(bsz, nc, c, SSM_GROUPS, hg)
    bm = bm.reshape(bsz, nc, c, SSM_GROUPS, SSM_STATE)
    cm = cm.reshape(bsz, nc, c, SSM_GROUPS, SSM_STATE)
    a_cs = jnp.cumsum(a, axis=2)
    a_t = jnp.moveaxis(a_cs, 2, -1)
    causal = jnp.tril(jnp.ones((c, c), dtype=bool))
    lmat = jnp.exp(jnp.where(causal, a_t[..., :, None] - a_t[..., None, :], -jnp.inf))
    cb = jnp.einsum('bclgn,bcsgn->bcgls', cm, bm)
    y_diag = jnp.einsum('bcghls,bcsghp->bclghp', cb[:, :, :, None] * lmat, x)
    decay_states = jnp.exp(a_cs[:, :, -1:] - a_cs)
    states = jnp.einsum('bclgn,bclghp->bcghpn', bm, x * decay_states[..., None])
    chunk_decay = jnp.exp(a_cs[:, :, -1])

    def step(carry, inp):
        s_c, d_c = inp
        return carry * d_c[..., None, None] + s_c, carry

    init = jnp.zeros((bsz, SSM_GROUPS, hg, hp, SSM_STATE), jnp.float32)
    _, prev = lax.scan(step, init, (jnp.moveaxis(states, 1, 0), jnp.moveaxis(chunk_decay, 1, 0)))
    prev = jnp.moveaxis(prev, 0, 1)
    y_off = jnp.einsum('bclgn,bcghpn->bclghp', cm, prev) * jnp.exp(a_cs)[..., None]
    return (y_diag + y_off).reshape(bsz, seq, heads, hp)


def mamba2_group(xbc, z, dt_raw, conv_w, conv_b, a_log, dt_bias, d_skip, norm_w):
    bsz, seq, _ = xbc.shape
    f32 = jnp.float32
    xbc = jax.nn.silu(causal_depthwise_conv(xbc, conv_w) + conv_b).astype(f32)
    xs, bm, cm = jnp.split(xbc, [SSM_INNER, SSM_INNER + SSM_GROUPS * SSM_STATE], axis=-1)
    xs = xs.reshape(bsz, seq, SSM_HEADS, SSM_HEAD_DIM)
    bm = bm.reshape(bsz, seq, SSM_GROUPS, SSM_STATE)
    cm = cm.reshape(bsz, seq, SSM_GROUPS, SSM_STATE)
    dt = jax.nn.softplus(dt_raw.astype(f32) + dt_bias.astype(f32))
    a = -jnp.exp(a_log.astype(f32)) * dt
    y = chunked_ssd(xs * dt[..., None], a, bm, cm) + d_skip.astype(f32)[:, None] * xs
    y = y.reshape(bsz, seq, SSM_INNER) * jax.nn.silu(z.astype(f32))
    gw = SSM_INNER // SSM_GROUPS
    y = rms_norm(y.reshape(bsz, seq, SSM_GROUPS, gw), norm_w.reshape(SSM_GROUPS, gw))
    return y.reshape(bsz, seq, SSM_INNER)


def hybrid_mixer(u, w_in, gdn_conv_w, gdn_a_log, gdn_dt_bias, gdn_norm_w, ssm_conv_w, ssm_conv_b,
                 ssm_a_log, ssm_dt_bias, ssm_d, ssm_norm_w, w_out):
    proj = u @ w_in
    gdn_qkv, gdn_z, gdn_b, gdn_a, ssm_xbc, ssm_z, ssm_dt = split_columns(proj, IN_SIZES)
    o_gdn = gated_deltanet_group(gdn_qkv, gdn_z, gdn_b, gdn_a, gdn_conv_w, gdn_a_log, gdn_dt_bias, gdn_norm_w)
    o_ssm = mamba2_group(ssm_xbc, ssm_z, ssm_dt, ssm_conv_w, ssm_conv_b, ssm_a_log, ssm_dt_bias, ssm_d, ssm_norm_w)
    o = jnp.concatenate([o_gdn, o_ssm], axis=-1).astype(u.dtype)
    return o @ w_out


def moe_ffn(u, w_router, b_router, w1, b1, w2, b2):
    bsz, seq, d = u.shape
    xt = u.reshape(-1, d)
    n_tok = xt.shape[0]
    n_rows = n_tok * TOP_K
    logits = (xt @ w_router + b_router).astype(jnp.float32)
    top_vals, top_idx = lax.top_k(logits, TOP_K)
    gates = jax.nn.softmax(top_vals, axis=-1)
    e_flat = top_idx.reshape(-1).astype(jnp.int32)
    t_flat = jnp.repeat(jnp.arange(n_tok, dtype=jnp.int32), TOP_K)
    g_flat = gates.reshape(-1)
    order = jnp.argsort(e_flat)
    e_sorted, t_sorted, g_sorted = e_flat[order], t_flat[order], g_flat[order]
    counts = jnp.bincount(e_flat, length=N_EXPERTS)
    padded = ((counts + MOE_BLOCK - 1) // MOE_BLOCK) * MOE_BLOCK
    pad_end = jnp.cumsum(padded)
    pad_start = pad_end - padded
    sort_start = jnp.cumsum(counts) - counts
    dest = pad_start[e_sorted] + (jnp.arange(n_rows, dtype=jnp.int32) - sort_start[e_sorted])
    n_blocks = n_rows // MOE_BLOCK + N_EXPERTS
    tok_pad = jnp.zeros((n_blocks * MOE_BLOCK,), jnp.int32).at[dest].set(t_sorted)
    gate_pad = jnp.zeros((n_blocks * MOE_BLOCK,), jnp.float32).at[dest].set(g_sorted)
    block_start = jnp.arange(n_blocks, dtype=jnp.int32) * MOE_BLOCK
    block_expert = jnp.minimum(jnp.searchsorted(pad_end, block_start, side='right'), N_EXPERTS - 1)

    def expert_block(args):
        idx, e = args
        h = xt[idx] @ w1[e] + b1[e]
        glu = jnp.minimum(h[:, :EXPERT_FF], SWIGLU_LIMIT)
        lin = jnp.clip(h[:, EXPERT_FF:], -SWIGLU_LIMIT, SWIGLU_LIMIT)
        act = glu * jax.nn.sigmoid(SWIGLU_ALPHA * glu) * (lin + 1.0)
        return act @ w2[e] + b2[e]

    out = lax.map(expert_block, (tok_pad.reshape(n_blocks, MOE_BLOCK), block_expert))
    out = out.reshape(-1, d) * gate_pad[:, None].astype(out.dtype)
    y = jnp.zeros_like(xt).at[tok_pad].add(out)
    return y.reshape(bsz, seq, d)


def _dt_bias(key, shape):
    dt = jnp.exp(jax.random.uniform(key, shape, jnp.float32, math.log(1e-3), math.log(1e-1)))
    return dt + jnp.log(-jnp.expm1(-dt))


def setup_inputs(seed: int = 0) -> dict:
    key = jax.random.key(seed)
    ks = jax.random.split(key, 32)
    f32 = jnp.float32

    def nrm(k, shape, scale):
        return jax.random.normal(k, shape, f32) * scale

    def gain(k, shape):
        return 1.0 + 0.02 * jax.random.normal(k, shape, f32)

    L = DEPTH
    return {
        'x': nrm(ks[0], (BATCH, SEQ, D_MODEL), 1.0),
        'p': nrm(ks[1], (DEPTH, BATCH, SEQ, PLE_DIM), 1.0),
        'mix_norm': gain(ks[2], (L, D_MODEL)),
        'w_in': nrm(ks[3], (L, D_MODEL, IN_COLS), D_MODEL ** -0.5),
        'gdn_conv_w': nrm(ks[4], (L, CONV_WIDTH, GDN_CONV_CH), CONV_WIDTH ** -0.5),
        'gdn_a_log': jnp.log(jax.random.uniform(ks[5], (L, GDN_V_HEADS), f32, 1.0, 16.0)),
        'gdn_dt_bias': _dt_bias(ks[6], (L, GDN_V_HEADS)),
        'gdn_norm_w': gain(ks[7], (L, GDN_HEAD_DIM)),
        'ssm_conv_w': nrm(ks[8], (L, CONV_WIDTH, SSM_CONV_CH), CONV_WIDTH ** -0.5),
        'ssm_conv_b': nrm(ks[9], (L, SSM_CONV_CH), 0.02),
        'ssm_a_log': jnp.log(jax.random.uniform(ks[10], (L, SSM_HEADS), f32, 1.0, 16.0)),
        'ssm_dt_bias': _dt_bias(ks[11], (L, SSM_HEADS)),
        'ssm_d': gain(ks[12], (L, SSM_HEADS)),
        'ssm_norm_w': gain(ks[13], (L, SSM_INNER)),
        'w_out': nrm(ks[14], (L, D_MIX, D_MODEL), D_MIX ** -0.5),
        'ffn_norm': gain(ks[15], (L, D_MODEL)),
        'w_router': nrm(ks[16], (L, D_MODEL, N_EXPERTS), D_MODEL ** -0.5),
        'b_router': nrm(ks[17], (L, N_EXPERTS), 0.01),
        'w_mlp1': nrm(ks[18], (L, N_EXPERTS, D_MODEL, 2 * EXPERT_FF), D_MODEL ** -0.5),
        'b_mlp1': nrm(ks[19], (L, N_EXPERTS, 2 * EXPERT_FF), 0.01),
        'w_mlp2': nrm(ks[20], (L, N_EXPERTS, EXPERT_FF, D_MODEL), EXPERT_FF ** -0.5),
        'b_mlp2': nrm(ks[21], (L, N_EXPERTS, D_MODEL), 0.01),
        'ple_norm': gain(ks[22], (L, D_MODEL)),
        'w_ple_gate': nrm(ks[23], (L, D_MODEL, D_MODEL), D_MODEL ** -0.5),
        'w_ple_proj': nrm(ks[24], (L, PLE_DIM, D_MODEL), PLE_DIM ** -0.5),
        'final_norm': gain(ks[25], (D_MODEL,)),
    }


def reference(x, p, mix_norm, w_in, gdn_conv_w, gdn_a_log, gdn_dt_bias, gdn_norm_w, ssm_conv_w, ssm_conv_b,
              ssm_a_log, ssm_dt_bias, ssm_d, ssm_norm_w, w_out, ffn_norm, w_router, b_router, w_mlp1, b_mlp1,
              w_mlp2, b_mlp2, ple_norm, w_ple_gate, w_ple_proj, final_norm):
    h = x
    for i in range(DEPTH):
        u = rms_norm(h, mix_norm[i])
        h = h + hybrid_mixer(u, w_in[i], gdn_conv_w[i], gdn_a_log[i], gdn_dt_bias[i], gdn_norm_w[i],
                             ssm_conv_w[i], ssm_conv_b[i], ssm_a_log[i], ssm_dt_bias[i], ssm_d[i],
                             ssm_norm_w[i], w_out[i])
        u = rms_norm(h, ffn_norm[i])
        h = h + moe_ffn(u, w_router[i], b_router[i], w_mlp1[i], b_mlp1[i], w_mlp2[i], b_mlp2[i])
        u = rms_norm(h, ple_norm[i])
        h = h + (p[i] @ w_ple_proj[i]) * jax.nn.sigmoid(u @ w_ple_gate[i])
    return rms_norm(h, final_norm)
```

```cpp
#include <hip/hip_runtime.h>
#include <cstdio>
#include <cstdint>

#ifndef MK_N_LAUNCHES
#define MK_N_LAUNCHES 1
#endif

#ifndef REPEAT_MASK
#define REPEAT_MASK 0
#endif
#define GAS __attribute__((address_space(1)))
#define LAS __attribute__((address_space(3)))
typedef unsigned short bf16;
typedef short bf16x8 __attribute__((ext_vector_type(8)));
typedef float f32x4 __attribute__((ext_vector_type(4)));
typedef float f32x3 __attribute__((ext_vector_type(3)));
typedef float f32x2 __attribute__((ext_vector_type(2)));
typedef unsigned u32x4 __attribute__((ext_vector_type(4)));
typedef unsigned u32x2 __attribute__((ext_vector_type(2)));

constexpr int M = 16384, SEQ = 2048, NB = 8, D = 2048;
constexpr int NPROJ = 11264, NSM = 64, INCOLS = 11328;
constexpr int DMIX = 4096, NE = 32, FF = 2048, PLE = 256;
constexpr int C_Q = 0, C_K = 1024, C_V = 2048, C_GZ = 4096, C_X = 6144, C_B = 8192, C_C = 8704, C_SZ = 9216;
constexpr int MAXSLOT = 73728;
constexpr float EPS = 1e-6f;

constexpr size_t MiB = 1u << 20;
constexpr size_t WS_CTL = 0, CTL_ZERO_BYTES = 1 * MiB;
constexpr size_t WS_WINT = 1 * MiB;
constexpr size_t WS_WSMT = 45 * MiB;
constexpr size_t WS_WOUTT = 46 * MiB;
constexpr size_t WS_WGATET = 62 * MiB;
constexpr size_t WS_WPROJT = 70 * MiB;
constexpr size_t WS_WRT = 71 * MiB;
constexpr size_t WS_W1T = 72 * MiB;
constexpr size_t WS_W2T = 584 * MiB;
constexpr size_t WS_U = 840 * MiB;
constexpr size_t WS_PBF = 904 * MiB;
constexpr size_t WS_PP = 912 * MiB;
constexpr size_t WS_PROJ = 976 * MiB;
constexpr size_t WS_PSM = 1328 * MiB;
constexpr size_t WS_GW = 1332 * MiB;
constexpr size_t WS_GQD = 1396 * MiB;
constexpr size_t WS_GKDT = 1460 * MiB;
constexpr size_t WS_GUT = 1524 * MiB;
constexpr size_t WS_GATT = 1588 * MiB;
constexpr size_t WS_GGL = 1620 * MiB;
constexpr size_t WS_ORAW = 1621 * MiB;
constexpr size_t WS_YG = 1685 * MiB;
constexpr size_t WS_SSQG = WS_ORAW;
constexpr size_t WS_SSQ = 1749 * MiB;
constexpr size_t WS_OMIX = 1751 * MiB;
constexpr size_t WS_TOPI = 1879 * MiB;
constexpr size_t WS_GATE = 1880 * MiB;
constexpr size_t WS_SLOT = 1881 * MiB;
constexpr size_t WS_TOKS = 1882 * MiB;
constexpr size_t WS_GSLOT = 1882 * MiB + 512 * 1024;
constexpr size_t WS_ACT = 1883 * MiB;
constexpr size_t WS_Y2 = 2171 * MiB;
constexpr size_t WS_QKVC = 2459 * MiB;
constexpr size_t WS_XBCC = 2587 * MiB;
constexpr size_t WS_GCS = 2683 * MiB;
constexpr size_t WS_U8 = 2684 * MiB;
constexpr size_t WS_HB = 2716 * MiB;
constexpr size_t WS_SSDT = 2780 * MiB;
constexpr size_t WS_END = 2788 * MiB;
constexpr int CW_TMO = 0, CW_CODE = 1;
constexpr int CW_CNT = 1024;
constexpr int CW_FILL = 1024 + 64;
constexpr int CW_BAR = 4096;

constexpr int LDS_BYTES = 163840;
constexpr int MISC_OFF = 163840 - 512;
constexpr int SCR_BYTES = MISC_OFF;

#define LDS_WAIT() asm volatile("s_waitcnt lgkmcnt(0)" ::: "memory")
#define VM_WAIT() asm volatile("s_waitcnt vmcnt(0)" ::: "memory")
#define RLX_AGENT __ATOMIC_RELAXED, __HIP_MEMORY_SCOPE_AGENT

typedef __bf16 bf16x2_t __attribute__((ext_vector_type(2)));
__device__ __forceinline__ unsigned f2bf(float f) { return (unsigned)__builtin_bit_cast(unsigned short, (__bf16)f); }
__device__ __forceinline__ unsigned pk2(float lo, float hi) { f32x2 v = {lo, hi}; return __builtin_bit_cast(unsigned, __builtin_convertvector(v, bf16x2_t)); }
__device__ __forceinline__ float bf2f(unsigned b) { return __builtin_bit_cast(float, b << 16); }
__device__ __forceinline__ float bflo(unsigned w) { return __builtin_bit_cast(float, w << 16); }
__device__ __forceinline__ float bfhi(unsigned w) { return __builtin_bit_cast(float, w & 0xffff0000u); }
__device__ __forceinline__ f32x4 h4_ld(const bf16* p) { const u32x2 w = *(const u32x2*)p; return (f32x4){bflo(w.x), bfhi(w.x), bflo(w.y), bfhi(w.y)}; }
__device__ __forceinline__ float sigmoidf_(float x) { return __builtin_amdgcn_rcpf(1.0f + __expf(-x)); }
__device__ __forceinline__ float siluf_(float x) { return x * __builtin_amdgcn_rcpf(1.0f + __expf(-x)); }
__device__ __forceinline__ float softplusf_(float x) { return fmaxf(x, 0.f) + log1pf(__expf(-fabsf(x))); }
__device__ __forceinline__ float wave_sum(float v) {
#pragma unroll
    for (int o = 1; o < 64; o <<= 1) v += __shfl_xor(v, o);
    return v;
}
__device__ __forceinline__ void h4_st(bf16* p, f32x4 v) { u32x2 w; w.x = pk2(v[0], v[1]); w.y = pk2(v[2], v[3]); *(u32x2*)p = w; }
__device__ __forceinline__ f32x4 mfma16(bf16x8 a, bf16x8 b, f32x4 c) { return __builtin_amdgcn_mfma_f32_16x16x32_bf16(a, b, c, 0, 0, 0); }

template <class T> __device__ __forceinline__ void launder(T& r) { asm volatile("" : "+v"(r)); }
template <class T, int N> __device__ __forceinline__ void launder(T (&r)[N]) {
#pragma unroll
    for (int i = 0; i < N; ++i) asm volatile("" : "+v"(r[i])); }

namespace pg8 {
constexpr int BM = 256, BK = 64, HALF = 128, HTB = HALF * BK * 2, STAGE_BYTES = 8 * HTB, NXCD = 8, WGM = 8;
__host__ __device__ __forceinline__ int lds_byte(int r, int c) { const int st = (r >> 4) * 2 + (c >> 5), rr = r & 15, cc = c & 31, ob = rr * 64 + cc * 2; return st * 1024 + (ob ^ (((ob >> 9) & 1) << 5)); }
__host__ __device__ __forceinline__ void stage_rc(int b, int& R, int& C) { const int st = b / 1024, sb = b % 1024, swz = sb ^ (((sb >> 9) & 1) << 5); R = (st >> 1) * 16 + swz / 64; C = (st & 1) * 32 + (swz % 64) / 2; }
__host__ __device__ __forceinline__ int perm32(int rho) { const int n = rho >> 4, i = rho & 15; return 8 * (i >> 2) + 4 * n + (i & 3); }

struct Unit { int pm, pn, aux, hsel; const char* A; const char* B; };

struct StaticOrder {
    static constexpr bool GATHER = false, HALFSEL = false;
    int nM, nN, nwg, G, c, KB, i0 = 0, i1 = 1 << 30; const char* A; const char* Bt;
    __device__ void init(const void* A_, const void* Bt_, int Mrows, int N, int K_, int G_, int c_, bool f8 = false) { A = (const char*)A_; Bt = (const char*)Bt_; nM = Mrows / BM; nN = N / BM; nwg = nM * nN; G = G_; c = c_; KB = f8 ? K_ : 2 * K_; }
    __device__ bool next(int i, Unit& u) const {
        i += i0; if (i >= i1) return false;
        const long L = (long)i * G + c; if (L >= nwg) return false;
        int wgid = (int)L; { const int q = nwg / NXCD, r = nwg % NXCD, xcd = wgid % NXCD, off = wgid / NXCD; wgid = (xcd < r ? xcd * (q + 1) : r * (q + 1) + (xcd - r) * q) + off; }
        const int nig = WGM * nN, gid = wgid / nig, fm = gid * WGM, gsz = (nM - fm) < WGM ? (nM - fm) : WGM;
        u.pm = fm + ((wgid % nig) % gsz); u.pn = (wgid % nig) / gsz; u.aux = 0; u.hsel = 0;
        u.A = A + (size_t)u.pm * BM * KB; u.B = Bt + (size_t)u.pn * BM * KB; return true;
    }
    __device__ __forceinline__ void a_off(const Unit&, const int (&sR)[2], const int (&sC)[2], unsigned (&v)[2][2], const LAS unsigned char* = nullptr) const {
#pragma unroll
        for (int h = 0; h < 2; ++h)
#pragma unroll
            for (int i = 0; i < 2; ++i) v[h][i] = (unsigned)((h * HALF + sR[i]) * KB + sC[i] * 2);
    }
};

typedef int v8i __attribute__((ext_vector_type(8)));
constexpr int WSCL = 0x79797979;
constexpr float WMUL = 64.0f;
__device__ __forceinline__ const GAS char* pin64(const void* q) { const unsigned long long b = (unsigned long long)q;
    return (const GAS char*)(((unsigned long long)(unsigned)__builtin_amdgcn_readfirstlane((int)(b >> 32)) << 32) | (unsigned)__builtin_amdgcn_readfirstlane((int)b)); }
template <class Epi, class Sched, bool ALIGN_EPI = true, bool SP2 = true, bool F8 = false>
__device__ __forceinline__ void gemm_phase(LAS unsigned char* lds, const int K, const Sched& S, const Epi& E) {
    int tid_ = threadIdx.x; asm volatile("" : "+v"(tid_));
    const int tid = tid_, wid = __builtin_amdgcn_readfirstlane(tid >> 6), lane = tid & 63, wr = wid >> 2, wc = wid & 3, fr = lane & 15, fq = lane >> 4;
    const int KB = F8 ? K : 2 * K;
    const int nt = KB / (BK * 2);
    int sR[2], sC[2]; unsigned voffB[2];
#pragma unroll
    for (int i = 0; i < 2; ++i) { int R, C; stage_rc(tid * 16 + i * 8192, R, C); sR[i] = R; sC[i] = C; const int Rb = Epi::PERM ? ((R & ~31) + perm32(R & 31)) : R; voffB[i] = (unsigned)(Rb * KB + C * 2); }
    const size_t kstep = (size_t)(BK * 2);
    const size_t hstepB = (size_t)HALF * KB;
    const unsigned ldsw = (unsigned)wid * 1024u;
    const int aoff = F8 ? lds_byte(wr * 64 + fr, fq * 16) : lds_byte(wr * 64 + fr, fq * 8), boff = F8 ? lds_byte(wc * 32 + fr, fq * 16) : lds_byte(wc * 32 + fr, fq * 8);
    constexpr int FR2 = F8 ? 16 : 1024;
#define PG8_SA(b, h) (((b) * 2 + (h)) * HTB)
#define PG8_SB(b, h) ((4 + (b) * 2 + (h)) * HTB)
#define PG8_STAGE(bufoff, gbase, voff) do { const GAS char* _g = pin64(gbase); _Pragma("unroll") for (int _i = 0; _i < 2; ++_i) \
        __builtin_amdgcn_global_load_lds((const GAS unsigned*)(_g + (voff)[_i]), (LAS unsigned*)(lds + (bufoff) + ldsw + _i * 8192), 16, 0, 0); } while (0)
#define PG8_LDA(dst, b, h) do { _Pragma("unroll") for (int m = 0; m < 4; ++m) { dst[m].hv[0] = *(const LAS bf16x8*)(lds + PG8_SA(b, h) + aoff + m * 2048); dst[m].hv[1] = *(const LAS bf16x8*)(lds + PG8_SA(b, h) + aoff + FR2 + m * 2048); } } while (0)
#define PG8_LDB(dst, b, h) do { _Pragma("unroll") for (int n = 0; n < 2; ++n) { dst[n].hv[0] = *(const LAS bf16x8*)(lds + PG8_SB(b, h) + boff + n * 2048); dst[n].hv[1] = *(const LAS bf16x8*)(lds + PG8_SB(b, h) + boff + FR2 + n * 2048); } } while (0)
#define PG8_MMA(ai, bj, At, Bt) do { __builtin_amdgcn_s_setprio(1); _Pragma("unroll") for (int m = 0; m < 4; ++m) _Pragma("unroll") for (int n = 0; n < 2; ++n) { \
        if constexpr (F8) { asm volatile("v_mfma_scale_f32_16x16x128_f8f6f4 %0, %1, %2, %0, %3, %4 op_sel_hi:[0,0,0]" : "+v"(acc[ai][bj][m][n]) : "v"(Bt[n].v), "v"(At[m].v), "v"(wscl), "v"(ascl)); } \
        else { _Pragma("unroll") for (int k = 0; k < 2; ++k) acc[ai][bj][m][n] = __builtin_amdgcn_mfma_f32_16x16x32_bf16(Bt[n].hv[k], At[m].hv[k], acc[ai][bj][m][n], 0, 0, 0); } } __builtin_amdgcn_s_setprio(0); } while (0)
#define PG8_WAIT_V(n) asm volatile("s_waitcnt vmcnt(" #n ")" ::: "memory")
#define PG8_WAIT_L(n) asm volatile("s_waitcnt lgkmcnt(" #n ")" ::: "memory")
#define PG8_BAR __builtin_amdgcn_s_barrier()
#define PG8_SCHED __builtin_amdgcn_sched_barrier(0)
    Unit cur, nxt; int ui = 0;
    if (!S.next(0, cur)) return;
    unsigned vA[2][2], nvA[2][2];
    constexpr int NS = Epi::NSIDE; constexpr int SIDE_OFF = 131072;
    int par = 0;
#define PG8_SIDE(u, pr) do { if constexpr (NS > 0) { if (wid < 4) { _Pragma("unroll") for (int _k = 0; _k < NS; ++_k) \
        __builtin_amdgcn_global_load_lds((const GAS unsigned*)E.side_src(u, _k, tid), (LAS unsigned*)(lds + SIDE_OFF + ((pr) * NS + _k) * 1024 + wid * 256), 4, 0, 0); } } } while (0)
    PG8_SIDE(cur, 0);
    if constexpr (NS > 0) { asm volatile("s_waitcnt vmcnt(0)" ::: "memory"); __builtin_amdgcn_s_barrier(); }
    S.a_off(cur, sR, sC, vA, lds + SIDE_OFF + 1024);
    if constexpr (Epi::RESCALE) { E.build(cur, lds, tid); if ((REPEAT_MASK >> 21) & 1) { PG8_SCHED; E.build(cur, lds, tid); } PG8_SCHED; }
    f32x4 acc[2][2][4][2];
    if constexpr (NS > 0) E.init_acc(acc, lds + SIDE_OFF, wc, fq);
    else {
#pragma unroll
    for (int a = 0; a < 2; ++a)
#pragma unroll
        for (int b = 0; b < 2; ++b)
#pragma unroll
            for (int m = 0; m < 4; ++m)
#pragma unroll
                for (int n = 0; n < 2; ++n) acc[a][b][m][n] = (f32x4){0.f, 0.f, 0.f, 0.f};
    }
    union Frag { bf16x8 hv[2]; v8i v; };
    Frag At[4], B0[2], B1[2];
    int wscl = WSCL, ascl = 0x7f7f7f7f; if constexpr (F8) { asm volatile("" : "+v"(wscl), "+v"(ascl)); }
    const char* cA = cur.A; const char* cB = cur.B;
    if constexpr (SP2) {
        PG8_STAGE(PG8_SB(0, 0), cB, voffB); PG8_STAGE(PG8_SB(0, 1), cB + hstepB, voffB); PG8_STAGE(PG8_SA(0, 0), cA, vA[0]); PG8_STAGE(PG8_SA(0, 1), cA, vA[1]);
        if (wr == 1) PG8_BAR;
        PG8_WAIT_V(2); PG8_BAR;
        PG8_STAGE(PG8_SB(1, 0), cB + kstep, voffB); PG8_STAGE(PG8_SA(1, 0), cA + kstep, vA[0]); PG8_STAGE(PG8_SB(1, 1), cB + hstepB + kstep, voffB);
        PG8_WAIT_V(6); PG8_BAR;
    } else {
        PG8_STAGE(PG8_SB(0, 0), cB, voffB); PG8_STAGE(PG8_SA(0, 0), cA, vA[0]); PG8_STAGE(PG8_SB(0, 1), cB + hstepB, voffB); PG8_STAGE(PG8_SA(0, 1), cA, vA[1]);
        if (wr == 1) PG8_BAR;
        PG8_WAIT_V(4); PG8_BAR;
        PG8_STAGE(PG8_SB(1, 0), cB + kstep, voffB); PG8_STAGE(PG8_SA(1, 0), cA + kstep, vA[0]); PG8_STAGE(PG8_SB(1, 1), cB + hstepB + kstep, voffB);
        PG8_WAIT_V(6); PG8_BAR;
    }
    for (;;) {
        const bool has_next = S.next(ui + 1, nxt);
        const char* nAp = has_next ? nxt.A : cA; const char* nBp = has_next ? nxt.B : cB;
        const int npar = (par == 2) ? 0 : par + 1;
        if (has_next) PG8_SIDE(nxt, npar);
        if constexpr (Sched::GATHER) {
#pragma unroll
            for (int h = 0; h < 2; ++h)
#pragma unroll
                for (int i = 0; i < 2; ++i) nvA[h][i] = vA[h][i];
        }
        for (int t = 0; t < nt; t += 2) {
            const bool last = (t == nt - 2);
            if constexpr (Sched::GATHER) { if (last && has_next) S.a_off(nxt, sR, sC, nvA, lds + SIDE_OFF + (npar * NS + 1) * 1024); }
            if constexpr (Epi::RESCALE) { const int it = t >> 1; if (it >= 1 && (it <= 16 || (it & 3) == 0)) { E.template rescale<false>(acc, lds, it <= 16 ? it - 1 : 15 + ((it - 16) >> 2), wr, fr); if ((REPEAT_MASK >> 22) & 1) { PG8_SCHED; E.template rescale<true>(acc, lds, it <= 16 ? it - 1 : 15 + ((it - 16) >> 2), wr, fr); } } PG8_SCHED; }
            const char* a1 = cA + (size_t)(t + 1) * kstep;
            const char* a2 = last ? nAp : cA + (size_t)(t + 2) * kstep; const char* b2 = last ? nBp : cB + (size_t)(t + 2) * kstep;
            const char* a3 = a2 + kstep; const char* b3 = b2 + kstep;
            unsigned w2[2][2];
#pragma unroll
            for (int h = 0; h < 2; ++h)
#pragma unroll
                for (int i = 0; i < 2; ++i) w2[h][i] = (Sched::GATHER && last) ? nvA[h][i] : vA[h][i];
            if constexpr (SP2) {
            PG8_LDB(B0, 0, 0); PG8_LDB(B1, 0, 1); PG8_SCHED; PG8_LDA(At, 0, 0); PG8_STAGE(PG8_SA(1, 1), a1, vA[1]);
            PG8_WAIT_V(8); PG8_WAIT_L(0); PG8_BAR; if (!Sched::HALFSEL || cur.hsel != 2) { PG8_MMA(0, 0, At, B0); PG8_MMA(0, 1, At, B1); } PG8_BAR; PG8_SCHED;
            PG8_LDA(At, 0, 1); PG8_STAGE(PG8_SB(0, 0), b2, voffB); PG8_STAGE(PG8_SB(0, 1), b2 + hstepB, voffB); PG8_STAGE(PG8_SA(0, 0), a2, w2[0]);
            PG8_WAIT_V(8); PG8_WAIT_L(0); PG8_BAR; if (!Sched::HALFSEL || cur.hsel != 1) { PG8_MMA(1, 0, At, B0); PG8_MMA(1, 1, At, B1); } PG8_BAR; PG8_SCHED;
            PG8_LDB(B0, 1, 0); PG8_LDB(B1, 1, 1); PG8_SCHED; PG8_LDA(At, 1, 0); PG8_STAGE(PG8_SA(0, 1), a2, w2[1]);
            PG8_WAIT_V(8); PG8_WAIT_L(0); PG8_BAR; if (!Sched::HALFSEL || cur.hsel != 2) { PG8_MMA(0, 0, At, B0); PG8_MMA(0, 1, At, B1); } PG8_BAR; PG8_SCHED;
            PG8_LDA(At, 1, 1); PG8_STAGE(PG8_SB(1, 0), b3, voffB); PG8_STAGE(PG8_SB(1, 1), b3 + hstepB, voffB); PG8_STAGE(PG8_SA(1, 0), a3, w2[0]);
            PG8_WAIT_V(8); PG8_WAIT_L(0); PG8_BAR; if (!Sched::HALFSEL || cur.hsel != 1) { PG8_MMA(1, 0, At, B0); PG8_MMA(1, 1, At, B1); } PG8_BAR; PG8_SCHED;
            } else {
            PG8_LDB(B0, 0, 0); PG8_SCHED; PG8_LDA(At, 0, 0); PG8_STAGE(PG8_SA(1, 1), a1, vA[1]);
            PG8_WAIT_L(8); PG8_BAR; PG8_WAIT_L(0); PG8_MMA(0, 0, At, B0); PG8_BAR; PG8_SCHED;
            PG8_LDB(B1, 0, 1); PG8_STAGE(PG8_SB(0, 0), b2, voffB);
            PG8_BAR; PG8_WAIT_L(0); PG8_MMA(0, 1, At, B1); PG8_BAR;
            PG8_LDA(At, 0, 1); PG8_STAGE(PG8_SA(0, 0), a2, w2[0]);
            PG8_BAR; PG8_WAIT_L(0); PG8_MMA(1, 0, At, B0); PG8_BAR; PG8_SCHED;
            PG8_STAGE(PG8_SB(0, 1), b2 + hstepB, voffB);
            PG8_WAIT_V(6); PG8_BAR; PG8_MMA(1, 1, At, B1); PG8_BAR;
            PG8_LDB(B0, 1, 0); PG8_SCHED; PG8_LDA(At, 1, 0); PG8_STAGE(PG8_SA(0, 1), a2, w2[1]);
            PG8_WAIT_L(8); PG8_BAR; PG8_WAIT_L(0); PG8_MMA(0, 0, At, B0); PG8_BAR; PG8_SCHED;
            PG8_LDB(B1, 1, 1); PG8_STAGE(PG8_SB(1, 0), b3, voffB);
            PG8_BAR; PG8_WAIT_L(0); PG8_MMA(0, 1, At, B1); PG8_BAR;
            PG8_LDA(At, 1, 1); PG8_STAGE(PG8_SA(1, 0), a3, w2[0]);
            PG8_BAR; PG8_WAIT_L(0); PG8_MMA(1, 0, At, B0); PG8_BAR; PG8_SCHED;
            PG8_STAGE(PG8_SB(1, 1), b3 + hstepB, voffB);
            PG8_WAIT_V(6); PG8_BAR; PG8_MMA(1, 1, At, B1); PG8_BAR;
            }
        }
        if constexpr (ALIGN_EPI) { if (wr == 0) PG8_BAR; }
        if constexpr (F8) { PG8_SCHED; asm volatile("s_nop 15\n\ts_nop 15" ::: "memory"); PG8_SCHED; }
        if constexpr (Epi::RESCALE) E(acc, cur, wr, wc, fr, fq, lds); else if constexpr (NS > 0) E(acc, cur, wr, wc, fr, fq, lds + SIDE_OFF + par * NS * 1024); else E(acc, cur, wr, wc, fr, fq);
        if (!has_next) break;
        if constexpr (Epi::RESCALE) { if (nxt.pm != cur.pm) { PG8_SCHED; PG8_BAR; E.build(nxt, lds, tid); PG8_SCHED; } }
        if constexpr (NS > 0) E.init_acc(acc, lds + SIDE_OFF + npar * NS * 1024, wc, fq);
        else {
#pragma unroll
        for (int a = 0; a < 2; ++a)
#pragma unroll
            for (int b = 0; b < 2; ++b)
#pragma unroll
                for (int m = 0; m < 4; ++m)
#pragma unroll
                    for (int n = 0; n < 2; ++n) acc[a][b][m][n] = (f32x4){0.f, 0.f, 0.f, 0.f};
        }
        cur = nxt; cA = nAp; cB = nBp; ++ui; par = npar;
        if constexpr (Sched::GATHER) {
#pragma unroll
        for (int h = 0; h < 2; ++h)
#pragma unroll
            for (int i = 0; i < 2; ++i) vA[h][i] = nvA[h][i]; }
        if constexpr (ALIGN_EPI) { if (wr == 1) PG8_BAR; }
    }
    PG8_WAIT_V(0);
    if constexpr (!ALIGN_EPI) { if (wr == 0) PG8_BAR; }
    PG8_BAR;
#undef PG8_SA
#undef PG8_SB
#undef PG8_STAGE
#undef PG8_LDA
#undef PG8_LDB
#undef PG8_MMA
#undef PG8_WAIT_V
#undef PG8_WAIT_L
#undef PG8_BAR
#undef PG8_SCHED
}

struct EpiBf16 {
    static constexpr bool PERM = true; static constexpr bool RESCALE = false; static constexpr int NSIDE = 0;
    bf16* O; int ldc; int za0 = 0, za1 = 0, zb0 = 0, zb1 = 0;
    __device__ __forceinline__ void operator()(const f32x4 (&acc)[2][2][4][2], const Unit& u, int wr, int wc, int fr, int fq) const {
        const int row0 = u.pm * BM + wr * 64 + fr, col0 = u.pn * BM + wc * 32 + 8 * fq;
        const bool sz = (u.pn >= za0 && u.pn < za1) || (u.pn >= zb0 && u.pn < zb1);
#pragma unroll
        for (int ai = 0; ai < 2; ++ai)
#pragma unroll
            for (int m = 0; m < 4; ++m) { bf16* rowp = O + (size_t)(row0 + ai * HALF + m * 16) * ldc + col0;
#pragma unroll
                for (int bj = 0; bj < 2; ++bj) { f32x4 v0 = acc[ai][bj][m][0], v1 = acc[ai][bj][m][1];
                    if (sz) { v0 = (f32x4){siluf_(v0[0]), siluf_(v0[1]), siluf_(v0[2]), siluf_(v0[3])}; v1 = (f32x4){siluf_(v1[0]), siluf_(v1[1]), siluf_(v1[2]), siluf_(v1[3])}; }
                    u32x4 w; w.x = pk2(v0[0], v0[1]); w.y = pk2(v0[2], v0[3]); w.z = pk2(v1[0], v1[1]); w.w = pk2(v1[2], v1[3]);
                    *(u32x4*)(rowp + bj * HALF) = w; } }
    }
};
struct EpiResF32 {
    static constexpr bool PERM = false; static constexpr bool RESCALE = true; static constexpr int NSIDE = 0;
    static constexpr int TAB = 131072;
    const float* base; bf16* out; int ldc; const float* SSQG; const float* SSQ;
    __device__ __forceinline__ void build(const Unit& u, LAS unsigned char* lds, int tid) const {
        if (tid < 256) {
            const int row = u.pm * BM + tid; float r[20], q[20];
            const f32x4* g4 = (const f32x4*)(SSQG + (size_t)row * 64);
#pragma unroll
            for (int hv = 0; hv < 16; ++hv) { const f32x4 v = g4[hv]; const float ms = ((v[0] + v[1]) + (v[2] + v[3])) * (1.0f / 128.0f) + EPS; q[hv] = sqrtf(ms); r[hv] = 1.0f / q[hv]; }
            const f32x4* s4 = (const f32x4*)(SSQ + (size_t)row * 32);
#pragma unroll
            for (int g = 0; g < 4; ++g) { const f32x4 v0 = s4[2 * g], v1 = s4[2 * g + 1]; const float ms = ((v0[0] + v0[1]) + (v0[2] + v0[3]) + (v1[0] + v1[1]) + (v1[2] + v1[3])) * (1.0f / 512.0f) + EPS; q[16 + g] = sqrtf(ms); r[16 + g] = 1.0f / q[16 + g]; }
            LAS float* tab = (LAS float*)(lds + TAB) + tid * 20;
#pragma unroll
            for (int s5 = 0; s5 < 5; ++s5) { f32x4 o;
#pragma unroll
                for (int j = 0; j < 4; ++j) { const int sg = 4 * s5 + j; o[j] = sg < 19 ? r[sg] * q[sg < 19 ? sg + 1 : 19] : r[19]; }
                *(LAS f32x4*)(tab + 4 * s5) = o; }
        }
    }
    template <bool ONES> __device__ __forceinline__ void rescale(f32x4 (&acc)[2][2][4][2], LAS unsigned char* lds, int sg, int wr, int fr) const {
        int fo = (wr * 64 + fr) * 80 + sg * 4; asm volatile("" : "+v"(fo));
        const LAS unsigned char* tab = lds + TAB + fo;
#pragma unroll
        for (int ai = 0; ai < 2; ++ai)
#pragma unroll
            for (int m = 0; m < 4; ++m) { float rho = *(const LAS float*)(tab + (ai * HALF + m * 16) * 80); if (ONES) rho = __builtin_fmaf(rho, 0.0f, 1.0f);
#pragma unroll
                for (int bj = 0; bj < 2; ++bj)
#pragma unroll
                    for (int n = 0; n < 2; ++n) acc[ai][bj][m][n] *= rho; }
    }
    __device__ __forceinline__ void operator()(const f32x4 (&acc)[2][2][4][2], const Unit& u, int wr, int wc, int fr, int fq, LAS unsigned char* lds) const {
        const int row0 = u.pm * BM + wr * 64 + fr, col0 = u.pn * BM + wc * 32 + 4 * fq;
        const LAS float* tab = (const LAS float*)(lds + TAB) + (wr * 64 + fr) * 20 + 19;
#pragma unroll
        for (int ai = 0; ai < 2; ++ai) { f32x4 xb[4][2][2]; float rho[4];
#pragma unroll
            for (int m = 0; m < 4; ++m) { const size_t off = (size_t)(row0 + ai * HALF + m * 16) * ldc + col0; rho[m] = tab[(ai * HALF + m * 16) * 20];
#pragma unroll
                for (int bj = 0; bj < 2; ++bj)
#pragma unroll
                    for (int n = 0; n < 2; ++n) xb[m][bj][n] = *(const f32x4*)(base + off + bj * HALF + n * 16); }
            __builtin_amdgcn_sched_barrier(0);
#pragma unroll
            for (int m = 0; m < 4; ++m) { const size_t off = (size_t)(row0 + ai * HALF + m * 16) * ldc + col0;
#pragma unroll
                for (int bj = 0; bj < 2; ++bj)
#pragma unroll
                    for (int n = 0; n < 2; ++n) h4_st(out + off + bj * HALF + n * 16, xb[m][bj][n] + acc[ai][bj][m][n] * rho[m]); }
            __builtin_amdgcn_sched_barrier(0); }
    }
};
struct EpiMoe1 {
    static constexpr bool PERM = true; static constexpr bool RESCALE = false; static constexpr int NSIDE = 2;
    unsigned char* ACT; const float* b1; const int* toks;
    __device__ __forceinline__ const void* side_src(const Unit& u, int k, int tid) const {
        return k == 0 ? (const void*)(b1 + (size_t)u.aux * (2 * FF) + (tid < 128 ? 0 : FF - 128) + u.pn * HALF + tid) : (const void*)(toks + u.pm * BM + tid); }
    __device__ __forceinline__ void init_acc(f32x4 (&acc)[2][2][4][2], const LAS unsigned char* side, int wc, int fq) const {
        const LAS float* bs = (const LAS float*)side + wc * 32 + 8 * fq;
#pragma unroll
        for (int n = 0; n < 2; ++n) { const f32x4 bg = *(const LAS f32x4*)(bs + 4 * n), bl = *(const LAS f32x4*)(bs + 128 + 4 * n) + 1.0f;
#pragma unroll
            for (int ai = 0; ai < 2; ++ai)
#pragma unroll
                for (int m = 0; m < 4; ++m) { acc[ai][0][m][n] = bg; acc[ai][1][m][n] = bl; } }
    }
    __device__ __forceinline__ void operator()(const f32x4 (&acc)[2][2][4][2], const Unit& u, int wr, int wc, int fr, int fq, const LAS unsigned char* side) const {
        const int row0 = u.pm * BM + wr * 64 + fr, colg = u.pn * HALF + wc * 32 + 8 * fq;
#pragma unroll
        for (int ai = 0; ai < 2; ++ai) { if (u.hsel == 2 - ai) continue;
#pragma unroll
            for (int m = 0; m < 4; ++m) { unsigned char* rowp = ACT + (size_t)(row0 + ai * HALF + m * 16) * FF + colg;
                float o[8];
#pragma unroll
                for (int n = 0; n < 2; ++n)
#pragma unroll
                    for (int j = 0; j < 4; ++j) { const float g = fminf(acc[ai][0][m][n][j], 7.0f); const float l1 = fminf(fmaxf(acc[ai][1][m][n][j], -6.0f), 8.0f);
                        o[n * 4 + j] = g * sigmoidf_(1.702f * g) * l1; }
                int p0 = 0, p1 = 0; p0 = __builtin_amdgcn_cvt_pk_fp8_f32(o[0], o[1], p0, false); p0 = __builtin_amdgcn_cvt_pk_fp8_f32(o[2], o[3], p0, true); p1 = __builtin_amdgcn_cvt_pk_fp8_f32(o[4], o[5], p1, false); p1 = __builtin_amdgcn_cvt_pk_fp8_f32(o[6], o[7], p1, true);
                *(u32x2*)rowp = (u32x2){(unsigned)p0, (unsigned)p1}; } }
    }
};
struct EpiMoe2 {
    static constexpr bool PERM = true; static constexpr bool RESCALE = false; static constexpr int NSIDE = 2;
    unsigned char* Y2; const float* b2; const float* gslot;
    __device__ __forceinline__ const void* side_src(const Unit& u, int k, int tid) const { return k == 0 ? (const void*)(b2 + (size_t)u.aux * D + u.pn * BM + tid) : (const void*)(gslot + u.pm * BM + tid); }
    __device__ __forceinline__ void init_acc(f32x4 (&acc)[2][2][4][2], const LAS unsigned char* side, int wc, int fq) const {
        const LAS float* bs = (const LAS float*)side + wc * 32 + 8 * fq;
#pragma unroll
        for (int bj = 0; bj < 2; ++bj)
#pragma unroll
            for (int n = 0; n < 2; ++n) { const f32x4 bv = *(const LAS f32x4*)(bs + bj * HALF + 4 * n);
#pragma unroll
                for (int ai = 0; ai < 2; ++ai)
#pragma unroll
                    for (int m = 0; m < 4; ++m) acc[ai][bj][m][n] = bv; }
    }
    __device__ __forceinline__ void operator()(const f32x4 (&acc)[2][2][4][2], const Unit& u, int wr, int wc, int fr, int fq, const LAS unsigned char* side) const {
        const int row0 = u.pm * BM + wr * 64 + fr, col0 = u.pn * BM + wc * 32 + 8 * fq;
        const LAS float* gs = (const LAS float*)(side + 1024) + wr * 64 + fr;
#pragma unroll
        for (int ai = 0; ai < 2; ++ai) { if (u.hsel == 2 - ai) continue;
#pragma unroll
            for (int m = 0; m < 4; ++m) { const int row = row0 + ai * HALF + m * 16; const float g = gs[ai * HALF + m * 16]; unsigned char* rowp = Y2 + (size_t)row * D + col0;
#pragma unroll
                for (int bj = 0; bj < 2; ++bj) { const f32x4 v0 = acc[ai][bj][m][0] * g, v1 = acc[ai][bj][m][1] * g;
                    int p0 = 0, p1 = 0; p0 = __builtin_amdgcn_cvt_pk_fp8_f32(v0[0], v0[1], p0, false); p0 = __builtin_amdgcn_cvt_pk_fp8_f32(v0[2], v0[3], p0, true); p1 = __builtin_amdgcn_cvt_pk_fp8_f32(v1[0], v1[1], p1, false); p1 = __builtin_amdgcn_cvt_pk_fp8_f32(v1[2], v1[3], p1, true);
                    *(u32x2*)(rowp + bj * HALF) = (u32x2){(unsigned)p0, (unsigned)p1}; } } }
    }
};
struct EpiGate {
    static constexpr bool PERM = false; static constexpr bool RESCALE = false; static constexpr int NSIDE = 0;
    bf16* H; const bf16* PP;
    __device__ __forceinline__ void operator()(const f32x4 (&acc)[2][2][4][2], const Unit& u, int wr, int wc, int fr, int fq) const {
        const int row0 = u.pm * BM + wr * 64 + fr, col0 = u.pn * BM + wc * 32 + 4 * fq;
#pragma unroll
        for (int ai = 0; ai < 2; ++ai) { u32x2 hb[4][2][2], pb[4][2][2];
#pragma unroll
            for (int m = 0; m < 4; ++m) { const size_t off = (size_t)(row0 + ai * HALF + m * 16) * D + col0;
#pragma unroll
                for (int bj = 0; bj < 2; ++bj)
#pragma unroll
                    for (int n = 0; n < 2; ++n) { const size_t o = off + bj * HALF + n * 16; hb[m][bj][n] = *(const u32x2*)(H + o); pb[m][bj][n] = *(const u32x2*)(PP + o); } }
            __builtin_amdgcn_sched_barrier(0);
#pragma unroll
            for (int m = 0; m < 4; ++m) { const size_t off = (size_t)(row0 + ai * HALF + m * 16) * D + col0;
#pragma unroll
                for (int bj = 0; bj < 2; ++bj)
#pragma unroll
                    for (int n = 0; n < 2; ++n) { const size_t o = off + bj * HALF + n * 16; const u32x2 hh = hb[m][bj][n], p = pb[m][bj][n]; const f32x4 a = acc[ai][bj][m][n];
                        f32x4 r; r[0] = bflo(hh.x) + bflo(p.x) * sigmoidf_(a[0]); r[1] = bfhi(hh.x) + bfhi(p.x) * sigmoidf_(a[1]); r[2] = bflo(hh.y) + bflo(p.y) * sigmoidf_(a[2]); r[3] = bfhi(hh.y) + bfhi(p.y) * sigmoidf_(a[3]);
                        h4_st(H + o, r); } }
            __builtin_amdgcn_sched_barrier(0); }
    }
};
}

#define XB_TMO      128
#define XB_XCNT(j)  (256  + 64 * (j))
#define XB_XSUB(j)  (1280 + 64 * (j))
#define XB_XGEN(j)  (2304 + 64 * (j))
#define XB_TOP      3328
#define XB_TOPGEN   3392
#define XCD_BAR_WORDS 3456
#define XB_SPIN_CAP (1u << 18)
__device__ __forceinline__ unsigned xb_ld(unsigned* p)              { return __hip_atomic_load(p, __ATOMIC_RELAXED, __HIP_MEMORY_SCOPE_AGENT); }
__device__ __forceinline__ unsigned xb_add(unsigned* p, unsigned v) { return __hip_atomic_fetch_add(p, v, __ATOMIC_RELAXED, __HIP_MEMORY_SCOPE_AGENT); }
__device__ __forceinline__ unsigned xb_xcc_id() { return (unsigned)__builtin_amdgcn_s_getreg((3 << 11) | 20) & 0xFu; }
#define XB_SPIN(cond, bar) do { unsigned _sp = 0; while (cond) { __builtin_amdgcn_s_sleep(1); \
    if ((++_sp & 255u) == 0u) { if (xb_ld(&(bar)[XB_TMO])) break; if (_sp > XB_SPIN_CAP) { atomicAdd(&(bar)[XB_TMO], 1u); break; } } } } while (0)
struct XcdBarrier { unsigned* bar; unsigned x; volatile LAS unsigned* st; };
__device__ __forceinline__ XcdBarrier xcd_barrier_post(unsigned* bar, volatile LAS unsigned* st) {
    XcdBarrier b; b.bar = bar; b.x = xb_xcc_id(); b.st = st;
    if (threadIdx.x == 0) (void)xb_add(&bar[XB_XCNT(b.x)], 1u);
    return b;
}
__device__ __forceinline__ void xcd_barrier_complete(unsigned* bar, unsigned x, unsigned& nloc, unsigned& nx) {
    const unsigned G = gridDim.x * gridDim.y * gridDim.z;
    unsigned sum, cnt, mine, sp = 0u;
    for (;;) {
        sum = 0u; cnt = 0u; mine = 0u;
#pragma unroll
        for (unsigned j = 0; j < 16; ++j) { const unsigned c = xb_ld(&bar[XB_XCNT(j)]); sum += c; cnt += (c > 0u) ? 1u : 0u; mine = (j == x) ? c : mine; }
        if (sum == G) break;
        __builtin_amdgcn_s_sleep(1);
        if ((++sp & 255u) == 0u) { if (xb_ld(&bar[XB_TMO])) break; if (sp > XB_SPIN_CAP) { atomicAdd(&bar[XB_TMO], 1u); break; } }
    }
    nloc = mine > 0u ? mine : 1u; nx = cnt > 0u ? cnt : 1u;
}
__device__ __forceinline__ void xcd_barrier(const XcdBarrier& b) {
    asm volatile("s_waitcnt vmcnt(0)" ::: "memory");
    __syncthreads();
    if (threadIdx.x == 0) {
        unsigned* bar = b.bar;
        __builtin_amdgcn_s_waitcnt(0);
        unsigned nloc = b.st[0], nx = b.st[1];
        if (nloc == 0u) { xcd_barrier_complete(bar, b.x, nloc, nx); b.st[0] = nloc; b.st[1] = nx; }
        const unsigned old = xb_add(&bar[XB_XSUB(b.x)], 1u);
        const unsigned gen = old / nloc;
        if (old + 1u == (gen + 1u) * nloc) {
            __builtin_amdgcn_fence(__ATOMIC_RELEASE, "agent");
            asm volatile("s_waitcnt vmcnt(0)" ::: "memory");
            const unsigned og = xb_add(&bar[XB_TOP], 1u);
            const unsigned tg = og / nx;
            if (og + 1u == (tg + 1u) * nx) xb_add(&bar[XB_TOPGEN], 1u);
            else XB_SPIN(xb_ld(&bar[XB_TOPGEN]) == tg, bar);
            __builtin_amdgcn_fence(__ATOMIC_ACQUIRE, "agent");
            xb_add(&bar[XB_XGEN(b.x)], 1u);
            asm volatile("s_waitcnt vmcnt(0)" ::: "memory");
        } else {
            XB_SPIN(xb_ld(&bar[XB_XGEN(b.x)]) == gen, bar);
            __builtin_amdgcn_fence(__ATOMIC_ACQUIRE, "agent");
            asm volatile("s_waitcnt vmcnt(0)" ::: "memory");
        }
    }
    __syncthreads();
}

struct Args { const float* in[26]; float* out; unsigned char* ws; int ph_lo, ph_hi; };
enum { I_X = 0, I_P, I_MIXN, I_WIN, I_GCONV, I_GALOG, I_GDTB, I_GNORM, I_SCONV, I_SCONVB, I_SALOG, I_SDTB, I_SD, I_SNORM, I_WOUT, I_FFNN, I_WR, I_BR, I_W1, I_B1, I_W2, I_B2, I_PLEN, I_WG, I_WP, I_FINN };

struct TrItem { const float* W; int N, k0, n0, kind, e; };
constexpr int TI_IN = (D / 64) * (INCOLS / 64), TI_OUT = (DMIX / 64) * (D / 64), TI_G = (D / 64) * (D / 64), TI_PJ = (PLE / 64) * (D / 64), TI_1 = (D / 64) * (2 * FF / 64), TI_2 = (FF / 64) * (D / 64);
constexpr int TI_NA = TI_IN + TI_PJ, TI_NB = TI_OUT + TI_G;
template <int POOL> __device__ __forceinline__ TrItem tr_decode(const Args& a, int it) {
    TrItem t; int r = it; t.e = 0;
    if constexpr (POOL == 0) {
        if (r < TI_IN) { const int nb = INCOLS / 64; t.W = a.in[I_WIN]; t.N = INCOLS; t.k0 = (r / nb) * 64; t.n0 = (r % nb) * 64; t.kind = 0; return t; } r -= TI_IN;
        { const int nb = D / 64; t.W = a.in[I_WP]; t.N = D; t.k0 = (r / nb) * 64; t.n0 = (r % nb) * 64; t.kind = 3; return t; }
    }
    r += TI_IN;
    if (r < TI_IN) { const int nb = INCOLS / 64; t.W = a.in[I_WIN]; t.N = INCOLS; t.k0 = (r / nb) * 64; t.n0 = (r % nb) * 64; t.kind = 0; return t; } r -= TI_IN;
    if (r < TI_OUT) { const int nb = D / 64; t.W = a.in[I_WOUT]; t.N = D; t.k0 = (r / nb) * 64; t.n0 = (r % nb) * 64; t.kind = 1; return t; } r -= TI_OUT;
    if (r < TI_G) { const int nb = D / 64; t.W = a.in[I_WG]; t.N = D; t.k0 = (r / nb) * 64; t.n0 = (r % nb) * 64; t.kind = 2; return t; } r -= TI_G;
    if (r < NE * TI_1) { const int e = r / TI_1, q = r % TI_1, nb = 2 * FF / 64; t.W = a.in[I_W1] + (size_t)e * D * 2 * FF; t.N = 2 * FF; t.k0 = ((q / (2 * nb)) * 2 + (q & 1)) * 64; t.n0 = ((q >> 1) % nb) * 64; t.kind = 4; t.e = e; return t; } r -= NE * TI_1;
    { const int e = r / TI_2, q = r % TI_2, nb = D / 64; t.W = a.in[I_W2] + (size_t)e * FF * D; t.N = D; t.k0 = ((q / (2 * nb)) * 2 + (q & 1)) * 64; t.n0 = ((q >> 1) % nb) * 64; t.kind = 5; t.e = e; return t; }
}
__device__ __forceinline__ void tr_load(const TrItem& t, int lane, f32x4 (&v)[16], f32x4 (&mw)[2], const float* gnw, const float* snw) {
    mw[0] = (f32x4){1.f, 1.f, 1.f, 1.f}; mw[1] = mw[0];
    if (t.kind == 1) { const int k = t.k0 + 8 * (lane & 7); const float* nwp = (k < D) ? gnw + (k & 127) : snw + (k - D); mw[0] = *(const f32x4*)nwp; mw[1] = *(const f32x4*)(nwp + 4); }
#pragma unroll
    for (int i = 0; i < 16; ++i) { const int r = i * 4 + (lane >> 4), c4 = lane & 15; v[i] = __builtin_nontemporal_load((const f32x4*)(t.W + (size_t)(t.k0 + r) * t.N + t.n0 + 4 * c4)); }
}
__device__ __forceinline__ void tr_finish(const TrItem& t, const f32x4 (&v)[16], unsigned char* ws, LAS float* scr, int lane, const f32x4 (&mw)[2]) {
#pragma unroll
    for (int i = 0; i < 16; ++i) { const int r = i * 4 + (lane >> 4), c4 = lane & 15; *(LAS f32x4*)(scr + r * 68 + 4 * c4) = v[i]; }
    LDS_WAIT();
    if (t.kind == 2 || t.kind >= 4) {
        const int c = lane & 3;
#pragma unroll
        for (int j = 0; j < 4; ++j) { const int nl = (lane >> 2) + 16 * j, n = t.n0 + nl; const LAS float* s = scr + (16 * c) * 68 + nl; int p[4];
#pragma unroll
            for (int q = 0; q < 4; ++q) { int w = 0; w = __builtin_amdgcn_cvt_pk_fp8_f32(s[(4 * q) * 68] * pg8::WMUL, s[(4 * q + 1) * 68] * pg8::WMUL, w, false); w = __builtin_amdgcn_cvt_pk_fp8_f32(s[(4 * q + 2) * 68] * pg8::WMUL, s[(4 * q + 3) * 68] * pg8::WMUL, w, true); p[q] = w; }
            unsigned char* d;
            if (t.kind == 2) d = ws + WS_WGATET + (size_t)n * D;
            else if (t.kind == 4) { const int row = (n < FF) ? ((n >> 7) * 256 + (n & 127)) : ((((n - FF) >> 7) * 256) + 128 + ((n - FF) & 127)); d = ws + WS_W1T + ((size_t)t.e * (2 * FF) + row) * D; }
            else d = ws + WS_W2T + ((size_t)t.e * D + n) * FF;
            *(u32x4*)(d + t.k0 + 16 * c) = (u32x4){(unsigned)p[0], (unsigned)p[1], (unsigned)p[2], (unsigned)p[3]}; }
    } else {
        const int c = lane & 7;
        const f32x4 m0 = mw[0], m1 = mw[1];
#pragma unroll
        for (int j = 0; j < 8; ++j) { const int nl = (lane >> 3) + 8 * j, n = t.n0 + nl; const LAS float* s = scr + (8 * c) * 68 + nl;
            u32x4 o; o.x = pk2(s[0 * 68] * m0[0], s[1 * 68] * m0[1]); o.y = pk2(s[2 * 68] * m0[2], s[3 * 68] * m0[3]); o.z = pk2(s[4 * 68] * m1[0], s[5 * 68] * m1[1]); o.w = pk2(s[6 * 68] * m1[2], s[7 * 68] * m1[3]);
            bf16* p;
            if (t.kind == 0) { bf16* WinT = (bf16*)(ws + WS_WINT); bf16* WsmT = (bf16*)(ws + WS_WSMT);
                p = (n < 6144) ? WinT + (size_t)n * D : (n < 6176) ? WsmT + (size_t)(n - 6144) * D : (n < 11296) ? WinT + (size_t)(n - 32) * D : WsmT + (size_t)(32 + n - 11296) * D; }
            else if (t.kind == 1) p = (bf16*)(ws + WS_WOUTT) + (size_t)n * DMIX;
            else p = (bf16*)(ws + WS_WPROJT) + (size_t)n * PLE;
            *(u32x4*)(p + t.k0 + 8 * c) = o; }
    }
    LDS_WAIT();
}

struct F8Item { const float* W; int N, k0, n0, kind, e; };
constexpr int FI_1 = (D / 128) * (2 * FF / 128), FI_2 = (FF / 128) * (D / 128), FI_G = (D / 128) * (D / 128), FI_N = NE * FI_1 + NE * FI_2;
__device__ __forceinline__ F8Item f8_decode(const Args& a, int it) {
    F8Item t; int r = it;
    if (r < NE * FI_1) { const int e = r / FI_1, q = r % FI_1, nb = 2 * FF / 128; t.W = a.in[I_W1] + (size_t)e * D * 2 * FF; t.N = 2 * FF; t.k0 = (q / nb) * 128; t.n0 = (q % nb) * 128; t.kind = 4; t.e = e; return t; } r -= NE * FI_1;
    if (r < NE * FI_2) { const int e = r / FI_2, q = r % FI_2, nb = D / 128; t.W = a.in[I_W2] + (size_t)e * FF * D; t.N = D; t.k0 = (q / nb) * 128; t.n0 = (q % nb) * 128; t.kind = 5; t.e = e; return t; } r -= NE * FI_2;
    { const int nb = D / 128; t.W = a.in[I_WG]; t.N = D; t.k0 = (r / nb) * 128; t.n0 = (r % nb) * 128; t.kind = 2; t.e = 0; return t; }
}
__device__ __forceinline__ const GAS char* pin_sgpr(const void* q) { const unsigned long long b = (unsigned long long)q;
    return (const GAS char*)(((unsigned long long)(unsigned)__builtin_amdgcn_readfirstlane((int)(b >> 32)) << 32) | (unsigned)__builtin_amdgcn_readfirstlane((int)b)); }
__device__ __forceinline__ void f8_load(const F8Item& t, int sub, int lane, f32x4 (&v)[16]) {
    const float* p0 = t.W + (size_t)(t.k0 + 32 * sub) * t.N + t.n0; const unsigned rs = (unsigned)t.N * 4u, v0 = (unsigned)(lane & 31) * 16u + (unsigned)(lane >> 5) * 16u * rs;
    const unsigned vo[4] = {v0, v0 + rs, v0 + 2u * rs, v0 + 3u * rs};
#pragma unroll
    for (int q = 0; q < 4; ++q) { const GAS char* p = pin_sgpr(p0 + (size_t)(4 * q) * t.N);
#pragma unroll
        for (int j = 0; j < 4; ++j) v[4 * q + j] = __builtin_nontemporal_load((const GAS f32x4*)(p + vo[j])); }
}
__device__ __forceinline__ unsigned f8_pack4(f32x4 v) { int w = 0; w = __builtin_amdgcn_cvt_pk_fp8_f32(v[0] * pg8::WMUL, v[1] * pg8::WMUL, w, false); w = __builtin_amdgcn_cvt_pk_fp8_f32(v[2] * pg8::WMUL, v[3] * pg8::WMUL, w, true); return (unsigned)w; }
__device__ __forceinline__ void f8_pack_store(const f32x4 (&v)[16], int sub, int lane, LAS unsigned char* scr) {
    asm volatile("" : "+v"(lane));
    const int c = lane & 31, ch = 2 * sub + (lane >> 5);
    LAS unsigned char* base = scr + (4 * c) * 128 + 16 * (ch ^ (c & 7));
#pragma unroll
    for (int g = 0; g < 4; ++g) {
        const unsigned A = f8_pack4(v[4 * g]), B = f8_pack4(v[4 * g + 1]), C = f8_pack4(v[4 * g + 2]), Dd = f8_pack4(v[4 * g + 3]);
        const unsigned P = __builtin_amdgcn_perm(B, A, 0x05010400u), Q = __builtin_amdgcn_perm(B, A, 0x07030602u), R = __builtin_amdgcn_perm(Dd, C, 0x05010400u), S = __builtin_amdgcn_perm(Dd, C, 0x07030602u);
        *(LAS unsigned*)(base + 4 * g) = __builtin_amdgcn_perm(R, P, 0x05040100u); *(LAS unsigned*)(base + 128 + 4 * g) = __builtin_amdgcn_perm(R, P, 0x07060302u);
        *(LAS unsigned*)(base + 256 + 4 * g) = __builtin_amdgcn_perm(S, Q, 0x05040100u); *(LAS unsigned*)(base + 384 + 4 * g) = __builtin_amdgcn_perm(S, Q, 0x07060302u); }
}
template <bool NOSTORE = false> __device__ __forceinline__ void f8_flush(const F8Item& t, unsigned char* ws, LAS unsigned char* scr, int lane) {
    asm volatile("" : "+v"(lane));
    LDS_WAIT();
    const int q = lane & 7;
#pragma unroll
    for (int i = 0; i < 16; ++i) { const int r = (lane >> 3) + 8 * i; const u32x4 v = *(const LAS u32x4*)(scr + r * 128 + 16 * (q ^ ((r >> 2) & 7))); const int n = t.n0 + r;
        unsigned char* d;
        if (t.kind == 2) d = ws + WS_WGATET + (size_t)n * D;
        else if (t.kind == 4) { const int row = (n < FF) ? ((n >> 7) * 256 + (n & 127)) : ((((n - FF) >> 7) * 256) + 128 + ((n - FF) & 127)); d = ws + WS_W1T + ((size_t)t.e * (2 * FF) + row) * D; }
        else d = ws + WS_W2T + ((size_t)t.e * D + n) * FF;
        if constexpr (!NOSTORE) *(u32x4*)(d + t.k0 + 16 * q) = v; else asm volatile("" :: "v"(v), "v"(d)); }
    LDS_WAIT();
}
template <bool NOSTORE = false> __device__ __forceinline__ void f8_pool(const Args& a, LAS unsigned char* lds, int gw, int NGW, int lane_, int wave) {
    int lane = lane_; asm volatile("" : "+v"(lane));
    unsigned char* ws = a.ws; const int cw = wave & 3; const bool storer = wave >= 4;
    LAS unsigned char* tile0 = lds + cw * 32768;
    volatile LAS unsigned* fl = (volatile LAS unsigned*)(lds + 131072 + cw * 16);
    __syncthreads();
    if (wave < 4 && lane < 2) fl[lane] = 0u;
    __syncthreads();
    const int v0 = gw - wave + cw, v1 = v0 + 4;
#define F8_ITEM(j) ((((j) & 1) ? v1 : v0) + ((j) >> 1) * NGW)
#define F8_TILE(j) (tile0 + ((j) & 1) * 16384)
    if (!storer) {
        f32x4 b0[16], b1[16], b2[16]; int j = 0;
        bool vA = F8_ITEM(0) < FI_N, vB = F8_ITEM(1) < FI_N, vC = F8_ITEM(2) < FI_N, vD;
        if (vA) { const F8Item t = f8_decode(a, F8_ITEM(0)); f8_load(t, 0, lane, b0); f8_load(t, 1, lane, b1); }
#define F8_STEP(CUR, LD, SUBC, VL, JL, SUBL, JC) do { if (VL) { const F8Item tl = f8_decode(a, F8_ITEM(JL)); f8_load(tl, SUBL, lane, LD); } f8_pack_store(CUR, SUBC, lane, F8_TILE(JC)); } while (0)
#define F8_WAITD(jj) do { if ((jj) >= 2) { while (fl[1] < (unsigned)((jj) - 1)) __builtin_amdgcn_s_sleep(4); } asm volatile("" ::: "memory"); } while (0)
#define F8_SIGF(jj) do { LDS_WAIT(); if (lane == 0) fl[0] = (unsigned)((jj) + 1); } while (0)
#pragma unroll 1
        while (vA) {
            F8_WAITD(j); F8_STEP(b0, b2, 0, true, j, 2, j); F8_STEP(b1, b0, 1, true, j, 3, j); F8_STEP(b2, b1, 2, vB, j + 1, 0, j); F8_STEP(b0, b2, 3, vB, j + 1, 1, j); F8_SIGF(j);
            if (!vB) break;
            F8_WAITD(j + 1); F8_STEP(b1, b0, 0, true, j + 1, 2, j + 1); F8_STEP(b2, b1, 1, true, j + 1, 3, j + 1); F8_STEP(b0, b2, 2, vC, j + 2, 0, j + 1); F8_STEP(b1, b0, 3, vC, j + 2, 1, j + 1); F8_SIGF(j + 1);
            if (!vC) break;
            vD = F8_ITEM(j + 3) < FI_N;
            F8_WAITD(j + 2); F8_STEP(b2, b1, 0, true, j + 2, 2, j + 2); F8_STEP(b0, b2, 1, true, j + 2, 3, j + 2); F8_STEP(b1, b0, 2, vD, j + 3, 0, j + 2); F8_STEP(b2, b1, 3, vD, j + 3, 1, j + 2); F8_SIGF(j + 2);
            j += 3; vA = vD; vB = F8_ITEM(j + 1) < FI_N; vC = F8_ITEM(j + 2) < FI_N;
        }
#undef F8_STEP
#undef F8_WAITD
#undef F8_SIGF
    } else {
#pragma unroll 1
        for (int j = 0; F8_ITEM(j) < FI_N; ++j) {
            while (fl[0] < (unsigned)(j + 1)) __builtin_amdgcn_s_sleep(4);
            asm volatile("" ::: "memory");
            f8_flush<NOSTORE>(f8_decode(a, F8_ITEM(j)), ws, F8_TILE(j), lane);
            if (lane == 0) fl[1] = (unsigned)(j + 1);
        }
    }
#undef F8_ITEM
#undef F8_TILE
}
__device__ __forceinline__ void stream_probe_vgpr(const Args& a, int gw, int NGW, int lane_) {
    int lane = lane_; asm volatile("" : "+v"(lane));
    f32x4 b0[16], b1[16], b2[16]; f32x4 acc = {0.f, 0.f, 0.f, 0.f};
#define SP_ACC(B) do { _Pragma("unroll") for (int i = 0; i < 16; ++i) acc += B[i]; } while (0)
#pragma unroll 1
    for (int it = gw; it < FI_N; it += NGW) { const F8Item t = f8_decode(a, it);
        f8_load(t, 0, lane, b0); f8_load(t, 1, lane, b1); f8_load(t, 2, lane, b2); SP_ACC(b0); f8_load(t, 3, lane, b0); SP_ACC(b1); SP_ACC(b2); SP_ACC(b0); }
#undef SP_ACC
    if (acc[0] + acc[1] + acc[2] + acc[3] == 123.456f) *(float*)(a.ws + WS_CTL + 4096) = 1.f;
}
__device__ __forceinline__ void stream_probe_dma(const Args& a, LAS unsigned char* lds, int gw, int NGW, int lane_, int wave) {
    int lane = lane_; asm volatile("" : "+v"(lane));
    LAS unsigned char* scr = lds + wave * 16384;
#pragma unroll 1
    for (int it = gw; it < FI_N; it += NGW) { const F8Item t = f8_decode(a, it);
#pragma unroll
        for (int sub = 0; sub < 4; ++sub) { const float* p0 = t.W + (size_t)(t.k0 + 32 * sub) * t.N + t.n0; const unsigned rs = (unsigned)t.N * 4u, v0 = (unsigned)(lane & 31) * 16u + (unsigned)(lane >> 5) * 16u * rs;
#pragma unroll
            for (int i = 0; i < 16; ++i) __builtin_amdgcn_global_load_lds((const unsigned*)((const char*)p0 + (size_t)i * rs + v0), (LAS unsigned*)(scr + i * 1024), 16, 0, 0);
            asm volatile("s_waitcnt vmcnt(48)" ::: "memory"); } }
    asm volatile("s_waitcnt vmcnt(0)" ::: "memory");
}
template <int POOL> __device__ __forceinline__ void tr_pool(const Args& a, LAS unsigned char* lds, int gw, int NGW, int lane_, int wave) {
    int lane = lane_; asm volatile("" : "+v"(lane));
    unsigned char* ws = a.ws; constexpr int NIT = POOL == 0 ? TI_NA : TI_NB;
    LAS float* scr = (LAS float*)(lds + wave * 17408);
    f32x4 va[16], vb[16], ma[2], mb[2]; int it = gw; const float* gnw = a.in[I_GNORM]; const float* snw = a.in[I_SNORM];
    TrItem ta, tb; if (it < NIT) { ta = tr_decode<POOL>(a, it); tr_load(ta, lane, va, ma, gnw, snw); launder(va); launder(ma); }
#pragma unroll 1
    while (it < NIT) {
        const int it1 = it + NGW, it2 = it + 2 * NGW;
        if (it1 < NIT) { tb = tr_decode<POOL>(a, it1); tr_load(tb, lane, vb, mb, gnw, snw); }
        tr_finish(ta, va, ws, scr, lane, ma);
        if (it1 >= NIT) break;
        launder(vb); launder(mb);
        if (it2 < NIT) { ta = tr_decode<POOL>(a, it2); tr_load(ta, lane, va, ma, gnw, snw); }
        tr_finish(tb, vb, ws, scr, lane, mb);
        launder(va); launder(ma);
        it = it2;
    }
}
__device__ __forceinline__ void phase_prologue(const Args& a, LAS unsigned char* lds, int gw, int NGW, int lane, int wave) {
    unsigned char* ws = a.ws;
    tr_pool<0>(a, lds, gw, NGW, lane, wave);
    { const float* x = a.in[I_X]; const float* nw = a.in[I_MIXN]; bf16* U = (bf16*)(ws + WS_U);
      f32x4 w8[8];
#pragma unroll
      for (int j = 0; j < 8; ++j) w8[j] = ((const f32x4*)nw)[lane + 64 * j];
      for (int m = gw; m < M; m += 2 * NGW) {
          const int m2 = (m + NGW < M) ? m + NGW : m;
          const f32x4* xr = (const f32x4*)(x + (size_t)m * D); const f32x4* xr2 = (const f32x4*)(x + (size_t)m2 * D); f32x4 v[8], v2[8]; float s = 0.f, s2 = 0.f;
#pragma unroll
          for (int j = 0; j < 8; ++j) { v[j] = xr[lane + 64 * j]; v2[j] = xr2[lane + 64 * j]; }
#pragma unroll
          for (int j = 0; j < 8; ++j) { s += (v[j][0] * v[j][0] + v[j][1] * v[j][1]) + (v[j][2] * v[j][2] + v[j][3] * v[j][3]); s2 += (v2[j][0] * v2[j][0] + v2[j][1] * v2[j][1]) + (v2[j][2] * v2[j][2] + v2[j][3] * v2[j][3]); }
          const float r = 1.0f / sqrtf(wave_sum(s) * (1.0f / D) + EPS), r2 = 1.0f / sqrtf(wave_sum(s2) * (1.0f / D) + EPS);
          u32x2* o = (u32x2*)(U + (size_t)m * D); u32x2* o2 = (u32x2*)(U + (size_t)m2 * D);
#pragma unroll
          for (int j = 0; j < 8; ++j) { const f32x4 w = w8[j]; u32x2 q; q.x = pk2(v[j][0] * r * w[0], v[j][1] * r * w[1]); q.y = pk2(v[j][2] * r * w[2], v[j][3] * r * w[3]); o[lane + 64 * j] = q;
              u32x2 q2; q2.x = pk2(v2[j][0] * r2 * w[0], v2[j][1] * r2 * w[1]); q2.y = pk2(v2[j][2] * r2 * w[2], v2[j][3] * r2 * w[3]); o2[lane + 64 * j] = q2; }
      } }
    { const f32x4* p = (const f32x4*)a.in[I_P]; u32x2* o = (u32x2*)(ws + WS_PBF); const int n4 = M * PLE / 4;
      const int st = NGW * 64;
      for (int i = gw * 64 + lane; i < n4; i += 4 * st) { f32x4 v[4];
#pragma unroll
          for (int q4 = 0; q4 < 4; ++q4) v[q4] = (i + q4 * st < n4) ? p[i + q4 * st] : (f32x4){0.f, 0.f, 0.f, 0.f};
#pragma unroll
          for (int q4 = 0; q4 < 4; ++q4) if (i + q4 * st < n4) { u32x2 q; q.x = pk2(v[q4][0], v[q4][1]); q.y = pk2(v[q4][2], v[q4][3]); o[i + q4 * st] = q; } } }
    { const float* wr = a.in[I_WR]; bf16* hi = (bf16*)(ws + WS_WRT); bf16* lo = hi + NE * D;
      for (int i = gw * 64 + lane; i < NE * D; i += NGW * 64) { const int e = i / D, k = i % D; const float v = wr[(size_t)k * NE + e]; const unsigned h = f2bf(v); hi[i] = (bf16)h; lo[i] = (bf16)f2bf(v - bf2f(h)); } }
}

__device__ __forceinline__ void small_gemm(const bf16* U, const bf16* WsmT, float* PSM, int vcu, int G, int wave, int lane) {
    for (int blk = vcu; blk < M / 64; blk += G) {
        const int row0 = blk * 64 + (wave >> 1) * 16, cb = (wave & 1) * 2;
        const bf16* ap = U + (size_t)(row0 + (lane & 15)) * D + 8 * (lane >> 4);
        const bf16* bp0 = WsmT + (size_t)(cb * 16 + (lane & 15)) * D + 8 * (lane >> 4);
        const bf16* bp1 = bp0 + (size_t)16 * D;
        f32x4 c0 = {0.f, 0.f, 0.f, 0.f}, c1 = {0.f, 0.f, 0.f, 0.f};
#pragma unroll 8
        for (int ks = 0; ks < D / 32; ++ks) { const bf16x8 av = *(const bf16x8*)(ap + ks * 32); c0 = mfma16(av, *(const bf16x8*)(bp0 + ks * 32), c0); c1 = mfma16(av, *(const bf16x8*)(bp1 + ks * 32), c1); }
#pragma unroll
        for (int r = 0; r < 4; ++r) { float* o = PSM + (size_t)(row0 + 4 * (lane >> 4) + r) * NSM + cb * 16 + (lane & 15); o[0] = c0[r]; o[16] = c1[r]; }
    }
}

template <int OFF0, int OFF1>
__device__ __forceinline__ bf16x8 tr_frag(unsigned addr) {
    union { bf16x8 v; u32x2 h[2]; } r;
    asm volatile("ds_read_b64_tr_b16 %0, %2 offset:%3\n\tds_read_b64_tr_b16 %1, %2 offset:%4\n\ts_waitcnt lgkmcnt(0)" : "=&v"(r.h[0]), "=&v"(r.h[1]) : "v"(addr), "i"(OFF0), "i"(OFF1) : "memory");
    return r.v;
}
template <int KS_STRIDE, int T_STRIDE>
__device__ __forceinline__ void tr_frag4(unsigned addr, bf16x8 (&f)[4]) {
    union { bf16x8 v; u32x2 h[2]; } r[4];
    asm volatile("ds_read_b64_tr_b16 %0, %8 offset:%9\n\tds_read_b64_tr_b16 %1, %8 offset:%10\n\tds_read_b64_tr_b16 %2, %8 offset:%11\n\tds_read_b64_tr_b16 %3, %8 offset:%12\n\t"
                 "ds_read_b64_tr_b16 %4, %8 offset:%13\n\tds_read_b64_tr_b16 %5, %8 offset:%14\n\tds_read_b64_tr_b16 %6, %8 offset:%15\n\tds_read_b64_tr_b16 %7, %8 offset:%16\n\ts_waitcnt lgkmcnt(0)"
                 : "=&v"(r[0].h[0]), "=&v"(r[0].h[1]), "=&v"(r[1].h[0]), "=&v"(r[1].h[1]), "=&v"(r[2].h[0]), "=&v"(r[2].h[1]), "=&v"(r[3].h[0]), "=&v"(r[3].h[1])
                 : "v"(addr), "i"(0), "i"(T_STRIDE), "i"(KS_STRIDE), "i"(KS_STRIDE + T_STRIDE), "i"(2 * KS_STRIDE), "i"(2 * KS_STRIDE + T_STRIDE), "i"(3 * KS_STRIDE), "i"(3 * KS_STRIDE + T_STRIDE) : "memory");
#pragma unroll
    for (int i = 0; i < 4; ++i) f[i] = r[i].v;
}
template <int O0, int O1, int O2, int O3>
__device__ __forceinline__ void tr_frag2(unsigned addr, bf16x8& f0, bf16x8& f1) {
    union { bf16x8 v; u32x2 h[2]; } r0, r1;
    asm volatile("ds_read_b64_tr_b16 %0, %4 offset:%5\n\tds_read_b64_tr_b16 %1, %4 offset:%6\n\tds_read_b64_tr_b16 %2, %4 offset:%7\n\tds_read_b64_tr_b16 %3, %4 offset:%8\n\ts_waitcnt lgkmcnt(0)"
                 : "=&v"(r0.h[0]), "=&v"(r0.h[1]), "=&v"(r1.h[0]), "=&v"(r1.h[1]) : "v"(addr), "i"(O0), "i"(O1), "i"(O2), "i"(O3) : "memory");
    f0 = r0.v; f1 = r1.v;
}
__device__ __forceinline__ unsigned lds_addr(const LAS unsigned char* p) { return (unsigned)(uintptr_t)p; }


struct ConvItem { const bf16* src; bf16* outp; const float* cw; const float* biasp; int wcol, cwN, ldo, t0; bool first, active; float qsc; int kb; };
__device__ __forceinline__ ConvItem conv_item(const Args& a, int item, int tid) {
    unsigned char* ws = a.ws; ConvItem c;
    const bf16* PROJ = (const bf16*)(ws + WS_PROJ); bf16* QKVC = (bf16*)(ws + WS_QKVC); bf16* XBCC = (bf16*)(ws + WS_XBCC);
    const int kb = ((item & 3) + (item >> 9)) & 3  , strip = item >> 2; c.kb = kb; c.t0 = strip * 32; c.first = (c.t0 % SEQ) == 0; c.active = !(kb == 3 && tid >= 256); int pcol; c.biasp = nullptr;
    if (kb < 2) { pcol = kb * 2048 + 4 * tid; c.wcol = pcol; c.cw = a.in[I_GCONV]; c.cwN = 4096; c.outp = QKVC + pcol; c.ldo = 4096; }
    else if (kb == 2) { pcol = C_X + 4 * tid; c.wcol = 4 * tid; c.cw = a.in[I_SCONV]; c.cwN = 3072; c.outp = XBCC + c.wcol; c.ldo = 3072; c.biasp = a.in[I_SCONVB] + c.wcol; }
    else { pcol = C_B + 4 * (tid & 255); c.wcol = 2048 + 4 * (tid & 255); c.cw = a.in[I_SCONV]; c.cwN = 3072; c.outp = XBCC + c.wcol; c.ldo = 3072; c.biasp = a.in[I_SCONVB] + c.wcol; }
    c.src = PROJ + (size_t)c.t0 * NPROJ + pcol; c.qsc = (kb == 0) ? ((tid < 256) ? 0.08838834764831845f : 1.0f) : 0.f;
    return c;
}
__device__ __forceinline__ void conv_loadw(const ConvItem& c, f32x4 (&cwb)[5]) {
#pragma unroll
    for (int k = 0; k < 5; ++k) cwb[k] = (f32x4){0.f, 0.f, 0.f, 0.f};
    if (c.active) {
#pragma unroll
        for (int k = 0; k < 4; ++k) cwb[k] = *(const f32x4*)(c.cw + k * c.cwN + c.wcol);
        if (c.biasp) cwb[4] = *(const f32x4*)c.biasp; }
}
__device__ __forceinline__ void conv_load(const ConvItem& c, u32x2 (&raw)[35]) {
#pragma unroll
    for (int r = 0; r < 35; ++r) { raw[r] = (u32x2){0u, 0u}; if (c.active && !(c.first && r < 3)) raw[r] = *(const u32x2*)(c.src + (long)(r - 3) * NPROJ); }
}
__device__ __forceinline__ void conv_compute(const ConvItem& c, const u32x2 (&raw)[35], const f32x4 (&cwb)[5]) {
    if (!c.active) return;
    const f32x4 w0 = cwb[0], w1 = cwb[1], w2 = cwb[2], w3 = cwb[3], bb = cwb[4];
    f32x4 xa = {bflo(raw[0].x), bfhi(raw[0].x), bflo(raw[0].y), bfhi(raw[0].y)}, xb = {bflo(raw[1].x), bfhi(raw[1].x), bflo(raw[1].y), bfhi(raw[1].y)}, xc = {bflo(raw[2].x), bfhi(raw[2].x), bflo(raw[2].y), bfhi(raw[2].y)};
#pragma unroll
    for (int r = 3; r < 35; ++r) { const f32x4 xd = {bflo(raw[r].x), bfhi(raw[r].x), bflo(raw[r].y), bfhi(raw[r].y)};
        f32x4 o = w0 * xa + w1 * xb + w2 * xc + w3 * xd + bb; xa = xb; xb = xc; xc = xd;
        o = (f32x4){siluf_(o[0]), siluf_(o[1]), siluf_(o[2]), siluf_(o[3])};
        if (c.kb == 0) { float ss = (o[0] * o[0] + o[1] * o[1]) + (o[2] * o[2] + o[3] * o[3]);
            ss += __shfl_xor(ss, 1); ss += __shfl_xor(ss, 2); ss += __shfl_xor(ss, 4); ss += __shfl_xor(ss, 8); ss += __shfl_xor(ss, 16);
            const float rn = c.qsc * __builtin_amdgcn_rsqf(ss + EPS); o = o * rn; }
        u32x2 q; q.x = pk2(o[0], o[1]); q.y = pk2(o[2], o[3]); *(u32x2*)(c.outp + (size_t)(c.t0 + r - 3) * c.ldo) = q; }
}
__device__ __forceinline__ void phase_conv(const Args& a, int vcu, int G, int tid, int lane) {
    constexpr int NIT = 512 * 4;
    u32x2 ra[35], rb[35]; f32x4 w[5]; int item = vcu, kbw = -1;
    ConvItem ca, cb; if (item < NIT) { ca = conv_item(a, item, tid); conv_load(ca, ra); conv_loadw(ca, w); kbw = ca.kb; launder(ra); launder(w); }
#pragma unroll 1
    while (item < NIT) {
        const int i1 = item + G, i2 = item + 2 * G;
        if (i1 < NIT) { cb = conv_item(a, i1, tid); conv_load(cb, rb); }
        conv_compute(ca, ra, w);
        if (i1 >= NIT) break;
        if (cb.kb != kbw) { conv_loadw(cb, w); kbw = cb.kb; }
        launder(rb); launder(w);
        if (i2 < NIT) { ca = conv_item(a, i2, tid); conv_load(ca, ra); }
        conv_compute(cb, rb, w);
        if (i2 < NIT && ca.kb != kbw) { conv_loadw(ca, w); kbw = ca.kb; }
        launder(ra); launder(w);
        item = i2;
    }
}

__device__ __forceinline__ void phase_ssd_scalars(const Args& a, int vcu, int G, int wave, int lane) {
    unsigned char* ws = a.ws; const float* PSM = (const float*)(ws + WS_PSM); f32x4* SSDT = (f32x4*)(ws + WS_SSDT);
    for (int job = vcu; job < NB * 16 * 2; job += G) { const int t0 = (job >> 1) * 128, hhalf = job & 1;
#pragma unroll
        for (int hh = 0; hh < 2; ++hh) { const int h = 16 * hhalf + 2 * wave + hh; const float dtb = a.in[I_SDTB][h], ea = -__expf(a.in[I_SALOG][h]);
            const float d0 = softplusf_(PSM[(size_t)(t0 + 2 * lane) * NSM + 32 + h] + dtb), d1 = softplusf_(PSM[(size_t)(t0 + 2 * lane + 1) * NSM + 32 + h] + dtb);
            const float a0 = ea * d0, a1 = ea * d1; float sc = a0 + a1;
#pragma unroll
            for (int o = 1; o < 64; o <<= 1) { const float n = __shfl_up(sc, o); if (lane >= o) sc += n; }
            const float alast = __shfl(sc, 63);
            SSDT[(size_t)(t0 + 2 * lane) * 32 + h] = (f32x4){d0, sc - a1, d0 * __expf(alast - (sc - a1)), 0.f};
            SSDT[(size_t)(t0 + 2 * lane + 1) * 32 + h] = (f32x4){d1, sc, d1 * __expf(alast - sc), 0.f}; } }
}

constexpr int G2_QL = 0, G2_KL = 17408, G2_VL = 34816, G2_MX = 69632, G2_LD = 143360, G2_SM = 153600;
template <class Epi>
__device__ __forceinline__ void mm64(const LAS unsigned char* Aimg, const LAS unsigned char* Bimg, int rb, int lane, Epi epi) {
    const int r16 = lane & 15, kq = lane >> 4, qq = (lane & 15) >> 2, pp = lane & 3;
    bf16x8 af[2];
#pragma unroll
    for (int ks = 0; ks < 2; ++ks) af[ks] = *(const LAS bf16x8*)(Aimg + (16 * rb + r16) * 144 + kq * 16 + ks * 64);
    const unsigned ba = lds_addr(Bimg + (8 * kq + qq) * 144 + (4 * pp) * 2);
#pragma unroll
    for (int cbk = 0; cbk < 4; ++cbk) {
        bf16x8 b0, b1;
        if (cbk == 0) tr_frag2<0, 576, 4608, 4608 + 576>(ba, b0, b1); else if (cbk == 1) tr_frag2<32, 32 + 576, 4608 + 32, 4608 + 32 + 576>(ba, b0, b1);
        else if (cbk == 2) tr_frag2<64, 64 + 576, 4608 + 64, 4608 + 64 + 576>(ba, b0, b1); else tr_frag2<96, 96 + 576, 4608 + 96, 4608 + 96 + 576>(ba, b0, b1);
        f32x4 c = {0.f, 0.f, 0.f, 0.f}; c = mfma16(b0, af[0], c); c = mfma16(b1, af[1], c);
        epi(16 * rb + r16, 16 * cbk + 4 * kq, c);
    }
}
__device__ __forceinline__ void st4bf(LAS unsigned char* img, int r, int c0, f32x4 v) { u32x2 w; w.x = pk2(v[0], v[1]); w.y = pk2(v[2], v[3]); *(LAS u32x2*)(img + r * 144 + c0 * 2) = w; }

template <int k> __device__ __forceinline__ void g2_addr(int tz, int t0, int hq, const bf16* QKVC, const bf16*& gp, int& lo) {
    if constexpr (k < 4) { const int id = tz + 512 * (k & 1), row = id >> 4, cc = id & 15; gp = QKVC + (size_t)(t0 + row) * 4096 + (k < 2 ? 0 : 1024) + hq * 128 + cc * 8; lo = (k < 2 ? G2_QL : G2_KL) + row * 272 + cc * 16; }
    else { const int id = tz + 512 * (k - 4), row = id >> 5, cc = id & 31; gp = QKVC + (size_t)(t0 + row) * 4096 + 2048 + hq * 256 + cc * 8; lo = G2_VL + (cc >> 4) * 17408 + row * 272 + (cc & 15) * 16; }
}
#define G2_FOR_K(X) X(0) X(1) X(2) X(3) X(4) X(5) X(6) X(7)
__device__ __forceinline__ void phase_gdn_pre(const Args& a, LAS unsigned char* lds, int vcu, int G, int tid, int wave, int lane) {
    unsigned char* ws = a.ws;
    const bf16* QKVC = (const bf16*)(ws + WS_QKVC); const float* PSM = (const float*)(ws + WS_PSM);
    bf16* GW = (bf16*)(ws + WS_GW); bf16* GUT = (bf16*)(ws + WS_GUT); bf16* GATT = (bf16*)(ws + WS_GATT); float* GGL = (float*)(ws + WS_GGL); float* GCS = (float*)(ws + WS_GCS);
    LAS float* sm = (LAS float*)(lds + G2_SM); LAS float* gcs = sm; LAS float* beta = sm + 128;
    const int r16 = lane & 15, kq = lane >> 4, qq = (lane & 15) >> 2, pp = lane & 3;
    u32x4 R[8]; float araw = 0.f, braw = 0.f, galog = 0.f, gdtb = 0.f;
    { const int unit = vcu; if (unit < NB * 32 * 8) { const int hq = unit & 7, c = (unit >> 3) & 31, b = unit >> 8, t0 = b * SEQ + c * 64;
#define G2_LD(k) { const bf16* gp; int lo; g2_addr<k>(tid, t0, hq, QKVC, gp, lo); R[k] = *(const u32x4*)gp; }
        G2_FOR_K(G2_LD)
        if (tid >= 128 && tid < 256) { const int e = (tid - 128) >> 6, hv = 2 * hq + e; araw = PSM[(size_t)(t0 + lane) * NSM + 16 + hv]; braw = PSM[(size_t)(t0 + lane) * NSM + hv]; galog = a.in[I_GALOG][hv]; gdtb = a.in[I_GDTB][hv]; } } }
    for (int unit = vcu; unit < NB * 32 * 8; unit += G) {
        const int hq = unit & 7, c = (unit >> 3) & 31, b = unit >> 8;
        const int t0 = b * SEQ + c * 64;
        const size_t chb = (size_t)(b * 32 + c) * 16 + 2 * hq;
        { int tz = tid; asm volatile("" : "+v"(tz));
#define G2_ST(k) { const bf16* gp; int lo; g2_addr<k>(tz, t0, hq, QKVC, gp, lo); *(LAS u32x4*)(lds + lo) = R[k]; }
          G2_FOR_K(G2_ST)
#undef G2_ST
        }
        if (tid >= 128 && tid < 256) { const int e = (tid - 128) >> 6, hv = 2 * hq + e;
            float g = -__expf(galog) * softplusf_(araw + gdtb);
#pragma unroll
            for (int o = 1; o < 64; o <<= 1) { const float n = __shfl_up(g, o); if (lane >= o) g += n; }
            gcs[e * 64 + lane] = g; beta[e * 64 + lane] = sigmoidf_(braw); GCS[(chb + e) * 64 + lane] = g; if (lane == 63) GGL[chb + e] = __expf(g); }
        for (int i = tid; i < 2 * 2304; i += 512) { const int e = i / 2304, o = i % 2304; ((LAS unsigned*)(lds + G2_MX + e * 36864 + 9216))[o] = 0u; }
        __syncthreads();
        { const int un = unit + G; if (un < NB * 32 * 8) { const int hq2 = un & 7, c2 = (un >> 3) & 31, b2 = un >> 8, t2 = b2 * SEQ + c2 * 64; int tz = tid; asm volatile("" : "+v"(tz));
#define G2_LD2(k) { const bf16* gp; int lo; g2_addr<k>(tz, t2, hq2, QKVC, gp, lo); R[k] = *(const u32x4*)gp; }
            G2_FOR_K(G2_LD2)
#undef G2_LD2
            if (tid >= 128 && tid < 256) { const int e = (tid - 128) >> 6, hv = 2 * hq2 + e; araw = PSM[(size_t)(t2 + lane) * NSM + 16 + hv]; braw = PSM[(size_t)(t2 + lane) * NSM + hv]; galog = a.in[I_GALOG][hv]; gdtb = a.in[I_GDTB][hv]; } } }
        { const bool isq = wave >= 4; const int ni = isq ? 3 - (wave & 3) : (wave & 3);
          const LAS unsigned char* bbase = lds + (isq ? G2_QL : G2_KL) + (16 * ni + r16) * 272 + kq * 16;
          bf16x8 bf[4];
#pragma unroll
          for (int ks = 0; ks < 4; ++ks) bf[ks] = *(const LAS bf16x8*)(bbase + ks * 64);
          const int i = 16 * ni + r16;
#pragma unroll
          for (int mj = 0; mj < 4; ++mj) {
              f32x4 cacc = {0.f, 0.f, 0.f, 0.f};
              if (mj <= ni) { const LAS unsigned char* abase = lds + G2_KL + (16 * mj + r16) * 272 + kq * 16;
#pragma unroll
                  for (int ks = 0; ks < 4; ++ks) cacc = mfma16(*(const LAS bf16x8*)(abase + ks * 64), bf[ks], cacc); }
              const int j0 = 16 * mj + 4 * kq;
#pragma unroll
              for (int e = 0; e < 2; ++e) { const float gi = gcs[e * 64 + i], bi = beta[e * 64 + i]; const f32x4 gj = *(const LAS f32x4*)(gcs + e * 64 + j0);
                  f32x4 o;
#pragma unroll
                  for (int r = 0; r < 4; ++r) { const float dec = __expf(fminf(gi - gj[r], 0.f)); const float vl = cacc[r] * dec * (isq ? 1.0f : bi); o[r] = (isq ? (i >= j0 + r) : (i > j0 + r)) ? vl : 0.f; }
                  if (!isq) { if (mj == ni) *(LAS f32x4*)(lds + G2_LD + e * 5120 + ((ni * 16 + r16) * 20 + 4 * kq) * 4) = o;
                      st4bf(lds + G2_MX + e * 36864, i, j0, (mj < ni) ? o : (f32x4){0.f, 0.f, 0.f, 0.f}); }
                  else { u32x2 w; w.x = pk2(o[0], o[1]); w.y = pk2(o[2], o[3]); *(u32x2*)(GATT + (chb + e) * 4096 + (size_t)i * 64 + j0) = w; } }
          } }
        __syncthreads();
        if (wave < 2) { const int e = wave, blk = lane >> 4, jj = lane & 15; float x[16]; int lz = jj;
            const LAS float* Lb = (const LAS float*)(lds + G2_LD + e * 5120) + blk * 320;
#pragma unroll
            for (int hb = 0; hb < 2; ++hb) { const int i0 = hb ? 12 : 0, i1 = hb ? 16 : 12; f32x4 L4[12][4];
#pragma unroll
                for (int i = i0; i < i1; ++i)
#pragma unroll
                    for (int q = 0; q < (i + 3) / 4; ++q) L4[i - i0][q] = *(const LAS f32x4*)(Lb + i * 20 + 4 * q);
                __builtin_amdgcn_sched_barrier(0);
#pragma unroll
                for (int i = i0; i < i1; ++i) { asm volatile("" : "+v"(lz)); float sacc = 0.f;
#pragma unroll
                    for (int q = 0; q < (i + 3) / 4; ++q) { const f32x4 l4 = L4[i - i0][q];
#pragma unroll
                        for (int t = 0; t < 4; ++t) if (4 * q + t < i) sacc += l4[t] * x[4 * q + t]; }
                    x[i] = ((i == lz) ? 1.0f : 0.0f) - sacc; }
                __builtin_amdgcn_sched_barrier(0); }
            LAS unsigned char* di = lds + G2_MX + e * 36864 + 9216;
#pragma unroll
            for (int i = 0; i < 16; ++i) *(LAS bf16*)(di + (16 * blk + i) * 144 + (16 * blk + jj) * 2) = (bf16)f2bf(x[i]); }
        __syncthreads();
        { const int e = wave >> 2, rb = wave & 3; LAS unsigned char* mx = lds + G2_MX + e * 36864;
          mm64(mx + 9216, mx, rb, lane, [=](int r, int c0, f32x4 v) { st4bf(mx + 18432, r, c0, v); f32x4 m; for (int k = 0; k < 4; ++k) m[k] = ((r == c0 + k) ? 1.0f : 0.0f) - v[k]; st4bf(mx + 27648, r, c0, m); });
          __syncthreads();
          mm64(mx + 18432, mx + 18432, rb, lane, [=](int r, int c0, f32x4 v) { f32x4 m; for (int k = 0; k < 4; ++k) m[k] = ((r == c0 + k) ? 1.0f : 0.0f) + v[k]; st4bf(mx, r, c0, m); });
          __syncthreads();
          mm64(mx + 27648, mx, rb, lane, [=](int r, int c0, f32x4 v) { st4bf(mx + 18432, r, c0, v); });
          __syncthreads();
          mm64(mx + 18432, mx + 9216, rb, lane, [=](int r, int c0, f32x4 v) { const f32x4 b4 = *(const LAS f32x4*)(beta + e * 64 + c0), g4 = *(const LAS f32x4*)(gcs + e * 64 + c0); f32x4 tu, tw;
              for (int k = 0; k < 4; ++k) { tu[k] = v[k] * b4[k]; tw[k] = tu[k] * __expf(g4[k]); } st4bf(mx, r, c0, tu); st4bf(mx + 27648, r, c0, tw); });
          __syncthreads(); }
        { const int e = wave >> 2, kind = (wave >> 1) & 1, hf = wave & 1;
          const LAS unsigned char* mx = lds + G2_MX + e * 36864;
          if (kind == 0) {
#pragma unroll 1
              for (int nd = 0; nd < 8; ++nd) { bf16x8 v0, v1;
                  tr_frag2<0, 4 * 272, 32 * 272, 36 * 272>(lds_addr(lds + G2_VL + e * 17408 + (8 * kq + qq) * 272 + (16 * nd + 4 * pp) * 2), v0, v1);
#pragma unroll
                  for (int m2 = 0; m2 < 2; ++m2) { const int mi = 2 * hf + m2; const LAS unsigned char* ab = mx + (16 * mi + r16) * 144 + kq * 16;
                      f32x4 cc = {0.f, 0.f, 0.f, 0.f}; cc = mfma16(*(const LAS bf16x8*)(ab), v0, cc); cc = mfma16(*(const LAS bf16x8*)(ab + 64), v1, cc);
                      u32x2 w; w.x = pk2(cc[0], cc[1]); w.y = pk2(cc[2], cc[3]);
                      *(u32x2*)(GUT + (chb + e) * 8192 + (size_t)(16 * nd + r16) * 64 + 16 * mi + 4 * kq) = w; } }
          } else {
#pragma unroll 1
              for (int m4 = 0; m4 < 4; ++m4) { const int md = 4 * hf + m4; bf16x8 k0, k1;
                  tr_frag2<0, 4 * 272, 32 * 272, 36 * 272>(lds_addr(lds + G2_KL + (8 * kq + qq) * 272 + (16 * md + 4 * pp) * 2), k0, k1);
#pragma unroll
                  for (int ni = 0; ni < 4; ++ni) { const LAS unsigned char* bb = mx + 27648 + (16 * ni + r16) * 144 + kq * 16;
                      f32x4 cc = {0.f, 0.f, 0.f, 0.f}; cc = mfma16(k0, *(const LAS bf16x8*)(bb), cc); cc = mfma16(k1, *(const LAS bf16x8*)(bb + 64), cc);
                      u32x2 w; w.x = pk2(cc[0], cc[1]); w.y = pk2(cc[2], cc[3]);
                      *(u32x2*)(GW + (chb + e) * 8192 + (size_t)(16 * ni + r16) * 128 + 16 * md + 4 * kq) = w; } }
          } }
        __syncthreads();
    }
}
#undef G2_LD

constexpr int GS_ST = 0, GS_VN = 17408, GS_VN2 = 26624, GS_BUF = 35840, GS_BUFSZ = 61440, GS_W = 0, GS_Q = 17408, GS_K = 34816, GS_A = 52224;
struct GsTile { u32x4 r[7]; };
struct GsLane { u32x2 uT[2]; f32x4 gc; float g63, gcl; u32x2 z[2]; };
__device__ __forceinline__ void launder(GsLane& L) { launder(L.uT); launder(L.gc); launder(L.g63); launder(L.gcl); launder(L.z); }
__device__ __forceinline__ void gs_load_tile(GsTile& T, const bf16* GW, const bf16* QKVC, const bf16* GATT, size_t ch, int trow0, int hq, int tz) {
#pragma unroll
    for (int k = 0; k < 2; ++k) { const int id = tz + 512 * k, row = id >> 4, cc = id & 15;
        T.r[k] = *(const u32x4*)(GW + ch * 8192 + (size_t)row * 128 + cc * 8);
        T.r[2 + k] = *(const u32x4*)(QKVC + (size_t)(trow0 + row) * 4096 + hq * 128 + cc * 8);
        T.r[4 + k] = *(const u32x4*)(QKVC + (size_t)(trow0 + row) * 4096 + 1024 + hq * 128 + cc * 8); }
    { const int row = tz >> 3, cc = tz & 7; T.r[6] = *(const u32x4*)(GATT + ch * 4096 + (size_t)row * 64 + cc * 8); }
}
__device__ __forceinline__ void gs_store_tile(const GsTile& T, LAS unsigned char* buf, int tz) {
#pragma unroll
    for (int k = 0; k < 2; ++k) { const int id = tz + 512 * k, row = id >> 4, cc = id & 15;
        *(LAS u32x4*)(buf + GS_W + row * 272 + cc * 16) = T.r[k]; *(LAS u32x4*)(buf + GS_Q + row * 272 + cc * 16) = T.r[2 + k]; *(LAS u32x4*)(buf + GS_K + row * 272 + cc * 16) = T.r[4 + k]; }
    { const int row = tz >> 3, cc = tz & 7; *(LAS u32x4*)(buf + GS_A + row * 144 + cc * 16) = T.r[6]; }
}
__device__ __forceinline__ void gs_load_lane(GsLane& L, const bf16* GUT, const float* GGL, const float* GCS, size_t ch, int half, int wave, int lane, const unsigned short* zp) {
    const int ti = wave >> 1, tjp = wave & 1, r16 = lane & 15, kq = lane >> 4;
#pragma unroll
    for (int t = 0; t < 2; ++t) L.z[t] = *(const u32x2*)(zp + 16 * t);
    L.gcl = GCS[ch * 64 + 16 * ti + r16];
#pragma unroll
    for (int t = 0; t < 2; ++t) L.uT[t] = *(const u32x2*)(GUT + ch * 8192 + (size_t)(half * 64 + 16 * (2 * tjp + t) + r16) * 64 + 16 * ti + 4 * kq);
    L.gc = *(const f32x4*)(GCS + ch * 64 + 16 * ti + 4 * kq);
    L.g63 = GCS[ch * 64 + 63];
}
__device__ __forceinline__ void phase_gdn_scan(const Args& a, LAS unsigned char* lds, int vcu, int G, int tid, int wave, int lane) {
    unsigned char* ws = a.ws;
    const bf16* GW = (const bf16*)(ws + WS_GW); const bf16* QKVC = (const bf16*)(ws + WS_QKVC); const bf16* GUT = (const bf16*)(ws + WS_GUT); const bf16* GATT = (const bf16*)(ws + WS_GATT); const float* GGL = (const float*)(ws + WS_GGL); const float* GCS = (const float*)(ws + WS_GCS);
    bf16* OMIX = (bf16*)(ws + WS_OMIX); float* SSQG = (float*)(ws + WS_SSQG); const bf16* PROJ = (const bf16*)(ws + WS_PROJ);
    const int ti = wave >> 1, tjp = wave & 1, r16 = lane & 15, kq = lane >> 4, qq = (lane & 15) >> 2, pp = lane & 3;
    for (int unit = vcu; unit < NB * 16 * 2; unit += G) {
        const int half = unit & 1, hv = (unit >> 1) & 15, b = unit >> 5, hq = hv >> 1;
        const int ocol0 = hv * 128 + half * 64;
        for (int i = tid; i < 17408 / 4; i += 512) ((LAS unsigned*)(lds + GS_ST))[i] = 0u;
        f32x4 Sacc[4];
#pragma unroll
        for (int t = 0; t < 4; ++t) Sacc[t] = (f32x4){0.f, 0.f, 0.f, 0.f};
        const size_t chb = (size_t)(b * 32) * 16 + hv;
        GsTile TA, TB; GsLane L, LA, LB;
        const unsigned short* zbase = (const unsigned short*)PROJ + (size_t)(b * SEQ + 16 * ti + r16) * NPROJ + C_GZ + ocol0 + 32 * tjp + 4 * kq;
        gs_load_tile(TA, GW, QKVC, GATT, chb, b * SEQ, hq, tid); gs_load_lane(LA, GUT, GGL, GCS, chb, half, wave, lane, zbase);
        gs_load_tile(TB, GW, QKVC, GATT, chb + 16, b * SEQ + 64, hq, tid); gs_load_lane(LB, GUT, GGL, GCS, chb + 16, half, wave, lane, zbase + (size_t)64 * NPROJ);
        gs_store_tile(TA, lds + GS_BUF, tid); L = LA; launder(L);
        __syncthreads();
#pragma unroll 1
        for (int c2 = 0; c2 < 32; c2 += 2) {
#pragma unroll
          for (int hstep = 0; hstep < 2; ++hstep) {
            const int c = c2 + hstep;
            const int trow0 = b * SEQ + c * 64;
            LAS unsigned char* buf = lds + GS_BUF + hstep * GS_BUFSZ;
            int tz = tid; asm volatile("" : "+v"(tz));
            { const int cn = (c + 2 < 32) ? c + 2 : 31;
              if (hstep == 0) { gs_load_tile(TA, GW, QKVC, GATT, chb + (size_t)cn * 16, b * SEQ + cn * 64, hq, tz); gs_load_lane(LA, GUT, GGL, GCS, chb + (size_t)cn * 16, half, wave, lane, zbase + (size_t)cn * 64 * NPROJ); }
              else { gs_load_tile(TB, GW, QKVC, GATT, chb + (size_t)cn * 16, b * SEQ + cn * 64, hq, tz); gs_load_lane(LB, GUT, GGL, GCS, chb + (size_t)cn * 16, half, wave, lane, zbase + (size_t)cn * 64 * NPROJ); } }
            f32x4 ws2[2], qs[2];
            { bf16x8 aW[4], aQ[4];
#pragma unroll
              for (int ks = 0; ks < 4; ++ks) { aW[ks] = *(const LAS bf16x8*)(buf + GS_W + (16 * ti + r16) * 272 + kq * 16 + ks * 64); aQ[ks] = *(const LAS bf16x8*)(buf + GS_Q + (16 * ti + r16) * 272 + kq * 16 + ks * 64); }
#pragma unroll
              for (int t = 0; t < 2; ++t) { ws2[t] = (f32x4){0.f, 0.f, 0.f, 0.f}; qs[t] = (f32x4){0.f, 0.f, 0.f, 0.f};
                  const LAS unsigned char* sb = lds + GS_ST + (16 * (2 * tjp + t) + r16) * 272 + kq * 16;
#pragma unroll
                  for (int ks = 0; ks < 4; ++ks) { const bf16x8 bs = *(const LAS bf16x8*)(sb + ks * 64); ws2[t] = mfma16(aW[ks], bs, ws2[t]); qs[t] = mfma16(bs, aQ[ks], qs[t]); } } }
            const float lgl = L.g63, glv = __expf(L.g63);
            const f32x4 eg = {__expf(L.gc[0]), __expf(L.gc[1]), __expf(L.gc[2]), __expf(L.gc[3])};
            const f32x4 ek = {__expf(lgl - L.gc[0]), __expf(lgl - L.gc[1]), __expf(lgl - L.gc[2]), __expf(lgl - L.gc[3])};
#pragma unroll
            for (int t = 0; t < 2; ++t) { const float v0 = bflo(L.uT[t].x) - ws2[t][0], v1 = bfhi(L.uT[t].x) - ws2[t][1], v2 = bflo(L.uT[t].y) - ws2[t][2], v3 = bfhi(L.uT[t].y) - ws2[t][3];
                u32x2 w; w.x = pk2(v0, v1); w.y = pk2(v2, v3);
                *(LAS u32x2*)(lds + GS_VN + (16 * (2 * tjp + t) + r16) * 144 + (16 * ti + 4 * kq) * 2) = w;
                u32x2 w2; w2.x = pk2(v0 * ek[0], v1 * ek[1]); w2.y = pk2(v2 * ek[2], v3 * ek[3]);
                *(LAS u32x2*)(lds + GS_VN2 + (16 * (2 * tjp + t) + r16) * 144 + (16 * ti + 4 * kq) * 2) = w2; }
            __syncthreads();
            { bf16x8 aT[2];
#pragma unroll
              for (int ks = 0; ks < 2; ++ks) aT[ks] = *(const LAS bf16x8*)(buf + GS_A + (16 * ti + r16) * 144 + kq * 16 + ks * 64);
              float sq = 0.f; const float egl = __expf(L.gcl);
#pragma unroll
              for (int t = 0; t < 2; ++t) { const LAS unsigned char* vb = lds + GS_VN + (16 * (2 * tjp + t) + r16) * 144 + kq * 16;
                  f32x4 o = qs[t] * egl;
#pragma unroll
                  for (int ks = 0; ks < 2; ++ks) o = mfma16(*(const LAS bf16x8*)(vb + ks * 64), aT[ks], o);
                  sq += (o[0] * o[0] + o[1] * o[1]) + (o[2] * o[2] + o[3] * o[3]);
                  const u32x2 zz = L.z[t]; u32x2 w; w.x = pk2(o[0] * bflo(zz.x), o[1] * bfhi(zz.x)); w.y = pk2(o[2] * bflo(zz.y), o[3] * bfhi(zz.y));
                  *(u32x2*)(OMIX + (size_t)(trow0 + 16 * ti + r16) * DMIX + ocol0 + 16 * (2 * tjp + t) + 4 * kq) = w; }
              sq += __shfl_xor(sq, 16); sq += __shfl_xor(sq, 32);
              if (kq == 0) SSQG[((size_t)(trow0 + 16 * ti + r16) * 16 + hv) * 4 + half * 2 + tjp] = sq; }
            { const unsigned ka = lds_addr(buf + GS_K + (8 * kq + qq) * 272 + (16 * wave + 4 * pp) * 2);
              const bf16x8 k0 = tr_frag<0, 4 * 272>(ka), k1 = tr_frag<32 * 272, 36 * 272>(ka);
#pragma unroll
              for (int tj = 0; tj < 4; ++tj) { const LAS unsigned char* vb = lds + GS_VN2 + (16 * tj + r16) * 144 + kq * 16;
                  f32x4 sv = Sacc[tj] * glv;
                  sv = mfma16(k0, *(const LAS bf16x8*)(vb), sv); sv = mfma16(k1, *(const LAS bf16x8*)(vb + 64), sv);
                  Sacc[tj] = sv;
                  u32x2 w; w.x = pk2(sv[0], sv[1]); w.y = pk2(sv[2], sv[3]);
                  *(LAS u32x2*)(lds + GS_ST + (16 * tj + r16) * 272 + (16 * wave + 4 * kq) * 2) = w; } }
            if (hstep == 0) { gs_store_tile(TB, lds + GS_BUF + GS_BUFSZ, tz); L = LB; } else { gs_store_tile(TA, lds + GS_BUF, tz); L = LA; }
            launder(L);
            __syncthreads();
          }
        }
    }
}

constexpr int SS_C = 0, SS_B = 34816, SS_X = 69632, SS_XD = 88064, SS_PV = 106496, SS_Z = 123904, SS_SM = 142336;
template <int k>
__device__ __forceinline__ void ssd_chunk_addr(int tz, int t0, int h, int g, const bf16* XBCC, const bf16* PROJ, const bf16*& gp, int& lo) {
    if constexpr (k < 8) { const int id = tz + 512 * (k & 3), row = id >> 4, cc = id & 15; gp = XBCC + (size_t)(t0 + row) * 3072 + (k < 4 ? 2048 : 2560) + g * 128 + cc * 8; lo = (k < 4 ? SS_B : SS_C) + row * 272 + cc * 16; }
    else if constexpr (k < 10) { const int id = tz + 512 * (k - 8), row = id >> 3, cc = id & 7; gp = XBCC + (size_t)(t0 + row) * 3072 + h * 64 + cc * 8; lo = SS_X + row * 144 + cc * 16; }
    else { const int id = tz + 512 * (k - 10), row = id >> 3, cc = id & 7; gp = PROJ + (size_t)(t0 + row) * NPROJ + C_SZ + h * 64 + cc * 8; lo = SS_Z + row * 144 + cc * 16; }
}
#define SSD_FOR_K(X) X(0) X(1) X(2) X(3) X(4) X(5) X(6) X(7) X(8) X(9) X(10) X(11)
__device__ __forceinline__ void phase_ssd(const Args& a, LAS unsigned char* lds, int vcu, int G, int tid, int wave, int lane) {
    unsigned char* ws = a.ws;
    const bf16* PROJ = (const bf16*)(ws + WS_PROJ); const bf16* XBCC = (const bf16*)(ws + WS_XBCC); const float* PSM = (const float*)(ws + WS_PSM);
    bf16* YG = (bf16*)(ws + WS_OMIX) + D; float* SSQ = (float*)(ws + WS_SSQ); const f32x4* SSDT = (const f32x4*)(ws + WS_SSDT);
    LAS float* dts = (LAS float*)(lds + SS_SM); LAS float* acs = dts + 128; LAS float* dds = dts + 256;
    const int r16 = lane & 15, kq = lane >> 4, qq = (lane & 15) >> 2, pp = lane & 3;
    for (int unit = vcu; unit < NB * 32; unit += G) {
        const int h = unit & 31, b = unit >> 5, g = h >> 3;
        const float dskip = a.in[I_SD][h];
        f32x4 pacc[4];
#pragma unroll
        for (int t = 0; t < 4; ++t) pacc[t] = (f32x4){0.f, 0.f, 0.f, 0.f};
        for (int i = tid; i < 17408 / 4; i += 512) ((LAS unsigned*)(lds + SS_PV))[i] = 0u;
        u32x4 R[12]; f32x3 sc4 = {0.f, 0.f, 0.f}; float ddx0 = 0.f, ddx1 = 0.f;
        { const int t0 = b * SEQ;
#define SSD_LD(k) { const bf16* gp; int lo; ssd_chunk_addr<k>(tid, t0, h, g, XBCC, PROJ, gp, lo); R[k] = *(const u32x4*)gp; }
          SSD_FOR_K(SSD_LD)
#undef SSD_LD
          if (tid < 128) sc4 = *(const f32x3*)(SSDT + (size_t)(t0 + tid) * 32 + h);
          ddx0 = ((const float*)(SSDT + (size_t)(t0 + (tid >> 3)) * 32 + h))[2]; ddx1 = ((const float*)(SSDT + (size_t)(t0 + 64 + (tid >> 3)) * 32 + h))[2]; }
#pragma unroll 1
        for (int c = 0; c < 16; ++c) {
            const int t0 = b * SEQ + c * 128;
            int tz = tid; asm volatile("" : "+v"(tz));
#define SSD_ST(k) { const bf16* gp; int lo; ssd_chunk_addr<k>(tz, t0, h, g, XBCC, PROJ, gp, lo); *(LAS u32x4*)(lds + lo) = R[k]; }
            SSD_FOR_K(SSD_ST)
#undef SSD_ST
            if (tid < 128) { dts[tid] = sc4[0]; acs[tid] = sc4[1]; dds[tid] = sc4[2]; }
            { const float dd2[2] = {ddx0, ddx1};
#pragma unroll
              for (int k = 0; k < 2; ++k) { const int id = tz + 512 * k, row = id >> 3, cc = id & 7; const u32x4 v = R[8 + k]; const float dd = dd2[k];
                  u32x4 o; o.x = pk2(bflo(v.x) * dd, bfhi(v.x) * dd); o.y = pk2(bflo(v.y) * dd, bfhi(v.y) * dd); o.z = pk2(bflo(v.z) * dd, bfhi(v.z) * dd); o.w = pk2(bflo(v.w) * dd, bfhi(v.w) * dd);
                  *(LAS u32x4*)(lds + SS_XD + row * 144 + cc * 16) = o; } }
            __syncthreads();
            if (c + 1 < 16) { const int t1 = t0 + 128;
#define SSD_LD(k) { const bf16* gp; int lo; ssd_chunk_addr<k>(tz, t1, h, g, XBCC, PROJ, gp, lo); R[k] = *(const u32x4*)gp; }
                SSD_FOR_K(SSD_LD)
#undef SSD_LD
                if (tid < 128) sc4 = *(const f32x3*)(SSDT + (size_t)(t1 + tid) * 32 + h);
                ddx0 = ((const float*)(SSDT + (size_t)(t1 + (tid >> 3)) * 32 + h))[2]; ddx1 = ((const float*)(SSDT + (size_t)(t1 + 64 + (tid >> 3)) * 32 + h))[2]; }
            { const int w = (wave < 4) ? wave : 11 - wave;
              bf16x8 cf[4];
              { const LAS unsigned char* cbp = lds + SS_C + (16 * w + r16) * 272 + kq * 16;
#pragma unroll
                for (int ks = 0; ks < 4; ++ks) cf[ks] = *(const LAS bf16x8*)(cbp + ks * 64); }
              f32x4 yd[4], yo[4];
#pragma unroll
              for (int pj = 0; pj < 4; ++pj) { yd[pj] = (f32x4){0.f, 0.f, 0.f, 0.f}; yo[pj] = (f32x4){0.f, 0.f, 0.f, 0.f}; }
              const int lq = 16 * w + r16; const float acl = acs[lq];
#pragma unroll
              for (int q = 0; q < 4; ++q) {
                  if (2 * q <= w) {
                      float gv[8];
#pragma unroll
                      for (int s2 = 0; s2 < 2; ++s2) { const int sb = 2 * q + s2; f32x4 gt = {0.f, 0.f, 0.f, 0.f};
                          if (sb <= w) { const LAS unsigned char* abp = lds + SS_B + (16 * sb + r16) * 272 + kq * 16;
#pragma unroll
                              for (int ks = 0; ks < 4; ++ks) gt = mfma16(*(const LAS bf16x8*)(abp + ks * 64), cf[ks], gt); }
                          const f32x4 as4 = *(const LAS f32x4*)(acs + 16 * sb + 4 * kq), dt4 = *(const LAS f32x4*)(dts + 16 * sb + 4 * kq);
#pragma unroll
                          for (int r = 0; r < 4; ++r) { const int s = 16 * sb + 4 * kq + r; const float val = gt[r] * __expf(fminf(acl - as4[r], 0.f)) * dt4[r]; gv[s2 * 4 + r] = (lq >= s) ? val : 0.f; } }
                      union { bf16x8 v; unsigned u[4]; } af; af.u[0] = pk2(gv[0], gv[1]); af.u[1] = pk2(gv[2], gv[3]); af.u[2] = pk2(gv[4], gv[5]); af.u[3] = pk2(gv[6], gv[7]);
                      const unsigned xa = lds_addr(lds + SS_X + (32 * q + 4 * kq + qq) * 144 + (4 * pp) * 2);
                      bf16x8 bx[4]; tr_frag4<32, 16 * 144>(xa, bx);
#pragma unroll
                      for (int pj = 0; pj < 4; ++pj) yd[pj] = mfma16(bx[pj], af.v, yd[pj]);
                  }
              }
#pragma unroll
              for (int pj = 0; pj < 4; ++pj) { const LAS unsigned char* pb = lds + SS_PV + (16 * pj + r16) * 272 + kq * 16;
#pragma unroll
                  for (int ks = 0; ks < 4; ++ks) yo[pj] = mfma16(*(const LAS bf16x8*)(pb + ks * 64), cf[ks], yo[pj]); }
              float ssq = 0.f;
              const int lrow = 16 * w + r16; const float el = __expf(acs[lrow]);
#pragma unroll
              for (int pj = 0; pj < 4; ++pj) { const int p0 = 16 * pj + 4 * kq;
                  const u32x2 xv = *(const LAS u32x2*)(lds + SS_X + lrow * 144 + p0 * 2); LAS u32x2* zp = (LAS u32x2*)(lds + SS_Z + lrow * 144 + p0 * 2); const u32x2 zv = *zp;
                  const float y0 = yd[pj][0] + el * yo[pj][0] + dskip * bflo(xv.x), y1 = yd[pj][1] + el * yo[pj][1] + dskip * bfhi(xv.x), y2 = yd[pj][2] + el * yo[pj][2] + dskip * bflo(xv.y), y3 = yd[pj][3] + el * yo[pj][3] + dskip * bfhi(xv.y);
                  const float z0 = y0 * bflo(zv.x), z1 = y1 * bfhi(zv.x), z2 = y2 * bflo(zv.y), z3 = y3 * bfhi(zv.y);
                  ssq += (z0 * z0 + z1 * z1) + (z2 * z2 + z3 * z3);
                  u32x2 wv; wv.x = pk2(z0, z1); wv.y = pk2(z2, z3); *zp = wv; }
              ssq += __shfl_xor(ssq, 16); ssq += __shfl_xor(ssq, 32);
              if (kq == 0) SSQ[(size_t)(t0 + lrow) * 32 + h] = ssq;
              LDS_WAIT();
#pragma unroll
              for (int k = 0; k < 2; ++k) { const int id = lane + 64 * k, row = id >> 3, cc = id & 7; const u32x4 v = *(const LAS u32x4*)(lds + SS_Z + (16 * w + row) * 144 + cc * 16);
                  *(u32x4*)(YG + (size_t)(t0 + 16 * w + row) * DMIX + h * 64 + cc * 8) = v; }
              const float cdec = __expf(acs[127]);
              bf16x8 bt[4];
              tr_frag4<32 * 272, 4 * 272>(lds_addr(lds + SS_B + (8 * kq + qq) * 272 + (16 * w + 4 * pp) * 2), bt);
#pragma unroll
              for (int pj = 0; pj < 4; ++pj) { bf16x8 xf[4]; tr_frag4<32 * 144, 4 * 144>(lds_addr(lds + SS_XD + (8 * kq + qq) * 144 + (16 * pj + 4 * pp) * 2), xf);
                  f32x4 s = pacc[pj] * cdec;
#pragma unroll
                  for (int ks = 0; ks < 4; ++ks) s = mfma16(bt[ks], xf[ks], s);
                  pacc[pj] = s; }
              __syncthreads();
#pragma unroll
              for (int pj = 0; pj < 4; ++pj) { u32x2 wv; wv.x = pk2(pacc[pj][0], pacc[pj][1]); wv.y = pk2(pacc[pj][2], pacc[pj][3]);
                  *(LAS u32x2*)(lds + SS_PV + (16 * pj + r16) * 272 + (16 * w + 4 * kq) * 2) = wv; }
            }
            __syncthreads();
        }
    }
}

__device__ __forceinline__ void post_token(int m, int lane, const bf16* PROJ, const bf16* ORAW, const bf16* YG, const float* SSQ, bf16* OMIX, const float* gnw, const float* snw) {
    u32x4 ov[4], zv[4], yv[4];
#pragma unroll
    for (int q = 0; q < 4; ++q) { ov[q] = ((const u32x4*)(ORAW + (size_t)m * D))[lane + 64 * q]; zv[q] = ((const u32x4*)(PROJ + (size_t)m * NPROJ + C_GZ))[lane + 64 * q]; yv[q] = ((const u32x4*)(YG + (size_t)m * D))[lane + 64 * q]; }
    const f32x4 s0 = *(const f32x4*)(SSQ + (size_t)m * 32 + (lane >> 4) * 8), s1 = *(const f32x4*)(SSQ + (size_t)m * 32 + (lane >> 4) * 8 + 4);
    float rs = 1.0f / sqrtf(((s0[0] + s0[1]) + (s0[2] + s0[3]) + (s1[0] + s1[1]) + (s1[2] + s1[3])) * (1.0f / 512.0f) + EPS);
#pragma unroll
    for (int q = 0; q < 4; ++q) { const unsigned w4[4] = {ov[q].x, ov[q].y, ov[q].z, ov[q].w}; const unsigned z4[4] = {zv[q].x, zv[q].y, zv[q].z, zv[q].w}; float ss = 0.f;
#pragma unroll
        for (int k = 0; k < 4; ++k) ss += bflo(w4[k]) * bflo(w4[k]) + bfhi(w4[k]) * bfhi(w4[k]);
        ss += __shfl_xor(ss, 1); ss += __shfl_xor(ss, 2); ss += __shfl_xor(ss, 4); ss += __shfl_xor(ss, 8);
        const float r = 1.0f / sqrtf(ss * (1.0f / 128.0f) + EPS); const int d0 = (lane & 15) * 8; unsigned o4[4];
        const f32x4 g0 = *(const f32x4*)(gnw + d0), g1 = *(const f32x4*)(gnw + d0 + 4); const float gw8[8] = {g0[0], g0[1], g0[2], g0[3], g1[0], g1[1], g1[2], g1[3]};
#pragma unroll
        for (int k = 0; k < 4; ++k) o4[k] = pk2(bflo(w4[k]) * r * gw8[2 * k] * siluf_(bflo(z4[k])), bfhi(w4[k]) * r * gw8[2 * k + 1] * siluf_(bfhi(z4[k])));
        ((u32x4*)(OMIX + (size_t)m * DMIX))[lane + 64 * q] = (u32x4){o4[0], o4[1], o4[2], o4[3]}; }
#pragma unroll
    for (int q = 0; q < 4; ++q) { const float r = __shfl(rs, 16 * q); const unsigned w4[4] = {yv[q].x, yv[q].y, yv[q].z, yv[q].w}; const int c0 = (lane + 64 * q) * 8; unsigned o4[4];
        const f32x4 g0 = *(const f32x4*)(snw + c0), g1 = *(const f32x4*)(snw + c0 + 4); const float gw8[8] = {g0[0], g0[1], g0[2], g0[3], g1[0], g1[1], g1[2], g1[3]};
#pragma unroll
        for (int k = 0; k < 4; ++k) o4[k] = pk2(bflo(w4[k]) * r * gw8[2 * k], bfhi(w4[k]) * r * gw8[2 * k + 1]);
        ((u32x4*)(OMIX + (size_t)m * DMIX + D))[lane + 64 * q] = (u32x4){o4[0], o4[1], o4[2], o4[3]}; }
}
__device__ __forceinline__ void phase_post(const Args& a, int gw, int NGW, int lane) {
    unsigned char* ws = a.ws;
    const bf16* PROJ = (const bf16*)(ws + WS_PROJ); const bf16* ORAW = (const bf16*)(ws + WS_ORAW); const bf16* YG = (const bf16*)(ws + WS_YG); const float* SSQ = (const float*)(ws + WS_SSQ);
    bf16* OMIX = (bf16*)(ws + WS_OMIX);
    const float* gnw = a.in[I_GNORM]; const float* snw = a.in[I_SNORM];
    for (int m = gw; m < M; m += 2 * NGW) { post_token(m, lane, PROJ, ORAW, YG, SSQ, OMIX, gnw, snw); if (m + NGW < M) post_token(m + NGW, lane, PROJ, ORAW, YG, SSQ, OMIX, gnw, snw); }
}

constexpr int RT_R = 0, RT_LG = 1024, RT_HIST = 1024 + 64 * 33 * 4;
__device__ __forceinline__ void phase_router(const Args& a, LAS unsigned char* lds, unsigned* ctl, int vcu, int G, int tid, int wave, int lane) {
    unsigned char* ws = a.ws;
    const bf16* H = (const bf16*)(ws + WS_HB); const float* nw = a.in[I_FFNN]; unsigned char* U8 = ws + WS_U8;
    const bf16* WrH = (const bf16*)(ws + WS_WRT); const bf16* WrL = WrH + NE * D;
    int* TOPI = (int*)(ws + WS_TOPI); float* GATE = (float*)(ws + WS_GATE); int* TOKS = (int*)(ws + WS_TOKS); float* GSLOT = (float*)(ws + WS_GSLOT);
    LAS float* rr = (LAS float*)(lds + RT_R); LAS float* lg = (LAS float*)(lds + RT_LG); LAS unsigned* hist = (LAS unsigned*)(lds + RT_HIST);
    for (int i = vcu * 512 + tid; i < MAXSLOT; i += G * 512) { TOKS[i] = 0; GSLOT[i] = 0.f; }
    const int r16 = lane & 15, kq = lane >> 4;
    for (int blk = vcu; blk < M / 64; blk += G) {
        const int m0 = blk * 64;
        if (tid < 32) hist[tid] = 0u;
        for (int t = 0; t < 8; t += 4) { u32x2 xq[4][8];
#pragma unroll
            for (int q = 0; q < 4; ++q)
#pragma unroll
                for (int j = 0; j < 8; ++j) xq[q][j] = *(const u32x2*)(H + (size_t)(m0 + wave * 8 + t + q) * D + 4 * (lane + 64 * j));
#pragma unroll
            for (int q = 0; q < 4; ++q) { float s = 0.f;
#pragma unroll
                for (int j = 0; j < 8; ++j) { const float v0 = bflo(xq[q][j].x), v1 = bfhi(xq[q][j].x), v2 = bflo(xq[q][j].y), v3 = bfhi(xq[q][j].y); s += (v0 * v0 + v1 * v1) + (v2 * v2 + v3 * v3); }
                s = wave_sum(s); if (lane == 0) rr[wave * 8 + t + q] = 1.0f / sqrtf(s * (1.0f / D) + EPS); } }
        __syncthreads();
        { const int tb = wave >> 1, eb = wave & 1; const int tok = m0 + 16 * tb + r16; const float rt = rr[16 * tb + r16];
          const bf16* hp = H + (size_t)tok * D + 8 * kq; const float* np = nw + 8 * kq;
          const bf16* bh = WrH + (size_t)(16 * eb + r16) * D + 8 * kq; const bf16* bl = WrL + (size_t)(16 * eb + r16) * D + 8 * kq;
          f32x4 acc = {0.f, 0.f, 0.f, 0.f};
          constexpr int GK = 8;
#pragma unroll 1
          for (int k0 = 0; k0 < D / 32; k0 += GK) {
          u32x2 hq[GK][2]; f32x4 nq[GK][2]; bf16x8 whq[GK], wlq[GK];
#pragma unroll
          for (int g = 0; g < GK; ++g) { const int ks = k0 + g; hq[g][0] = *(const u32x2*)(hp + ks * 32); hq[g][1] = *(const u32x2*)(hp + ks * 32 + 4); nq[g][0] = *(const f32x4*)(np + ks * 32); nq[g][1] = *(const f32x4*)(np + ks * 32 + 4);
              whq[g] = *(const bf16x8*)(bh + ks * 32); wlq[g] = *(const bf16x8*)(bl + ks * 32); }
          __builtin_amdgcn_sched_barrier(0);
#pragma unroll
          for (int g = 0; g < GK; ++g) { const int ks = k0 + g;
              const f32x4 h0 = {bflo(hq[g][0].x), bfhi(hq[g][0].x), bflo(hq[g][0].y), bfhi(hq[g][0].y)}, h1 = {bflo(hq[g][1].x), bfhi(hq[g][1].x), bflo(hq[g][1].y), bfhi(hq[g][1].y)}; const f32x4 n0 = nq[g][0], n1 = nq[g][1];
              float v[8] = {h0[0] * n0[0], h0[1] * n0[1], h0[2] * n0[2], h0[3] * n0[3], h1[0] * n1[0], h1[1] * n1[1], h1[2] * n1[2], h1[3] * n1[3]};
              union { bf16x8 v8; unsigned u[4]; } ah, al; unsigned hb[8];
#pragma unroll
              for (int j = 0; j < 8; ++j) { v[j] *= rt; hb[j] = f2bf(v[j]); }
#pragma unroll
              for (int j = 0; j < 4; ++j) { ah.u[j] = hb[2 * j] | (hb[2 * j + 1] << 16); al.u[j] = pk2(v[2 * j] - bf2f(hb[2 * j]), v[2 * j + 1] - bf2f(hb[2 * j + 1])); }
              if (eb == 0) { int p0 = 0, p1 = 0; p0 = __builtin_amdgcn_cvt_pk_fp8_f32(v[0], v[1], p0, false); p0 = __builtin_amdgcn_cvt_pk_fp8_f32(v[2], v[3], p0, true); p1 = __builtin_amdgcn_cvt_pk_fp8_f32(v[4], v[5], p1, false); p1 = __builtin_amdgcn_cvt_pk_fp8_f32(v[6], v[7], p1, true);
                  *(u32x2*)(U8 + (size_t)tok * D + ks * 32 + 8 * kq) = (u32x2){(unsigned)p0, (unsigned)p1}; }
              const bf16x8 wh = whq[g], wl = wlq[g];
              acc = mfma16(ah.v8, wh, acc); acc = mfma16(al.v8, wh, acc); acc = mfma16(ah.v8, wl, acc);
          }
          __builtin_amdgcn_sched_barrier(0); }
          const float br = a.in[I_BR][16 * eb + r16];
#pragma unroll
          for (int r = 0; r < 4; ++r) lg[(16 * tb + 4 * kq + r) * 33 + 16 * eb + r16] = acc[r] + br; }
        __syncthreads();
        if (tid < 64) { const int m = m0 + tid; float v[32];
#pragma unroll
            for (int e = 0; e < 32; ++e) v[e] = lg[tid * 33 + e];
            int bi[4]; float bv[4];
#pragma unroll
            for (int k = 0; k < 4; ++k) { float best = -3.0e38f; int be = 0;
#pragma unroll
                for (int e = 0; e < 32; ++e) { const bool taken = (k > 0 && bi[0] == e) || (k > 1 && bi[1] == e) || (k > 2 && bi[2] == e); if (!taken && v[e] > best) { best = v[e]; be = e; } }
                bi[k] = be; bv[k] = best; }
            const float e0 = 1.0f, e1 = __expf(bv[1] - bv[0]), e2 = __expf(bv[2] - bv[0]), e3 = __expf(bv[3] - bv[0]); const float inv = 1.0f / (e0 + e1 + e2 + e3);
            *(int4*)(TOPI + (size_t)m * 4) = make_int4(bi[0], bi[1], bi[2], bi[3]);
            *(f32x4*)(GATE + (size_t)m * 4) = (f32x4){e0 * inv, e1 * inv, e2 * inv, e3 * inv};
#pragma unroll
            for (int k = 0; k < 4; ++k) __hip_atomic_fetch_add(&hist[bi[k]], 1u, __ATOMIC_RELAXED, __HIP_MEMORY_SCOPE_WORKGROUP); }
        __syncthreads();
        if (tid < 32) { const unsigned hcount = hist[tid]; if (hcount) atomicAdd(ctl + CW_CNT + tid, hcount); }
        __syncthreads();
    }
}

__device__ __forceinline__ void moe_bases(const unsigned* ctl, LAS int* base  , int tid) {
    if (tid < 64) {
        const int c = (tid < NE) ? (int)__hip_atomic_load(ctl + CW_CNT + tid, RLX_AGENT) : 0; const int p = (c + 255) & ~255; int incl = p;
#pragma unroll
        for (int d = 1; d < 32; d <<= 1) { const int v = __shfl_up(incl, d); if (tid >= d) incl += v; }
        if (tid < NE) base[tid] = incl - p;
        if (tid == NE - 1) base[NE] = incl; }
}
__device__ __forceinline__ void moe_tile_experts(const unsigned* ctl, LAS int* base, int tid) {
    LAS unsigned char* texp = (LAS unsigned char*)(base + 36);
    if (tid < MAXSLOT / 256) { int e = 0; for (int q = 1; q < NE; ++q) e += (base[q] <= tid * 256) ? 1 : 0;
        const int valid = (int)__hip_atomic_load(ctl + CW_CNT + e, RLX_AGENT) - (tid * 256 - base[e]);
        texp[tid] = (unsigned char)(e | ((valid <= 128) ? 0x80 : 0)); }
}
__device__ __forceinline__ void phase_slots(const Args& a, LAS unsigned char* lds, unsigned* ctl, int vcu, int G, int tid) {
    unsigned char* ws = a.ws;
    const int* TOPI = (const int*)(ws + WS_TOPI); const float* GATE = (const float*)(ws + WS_GATE); int* SLOT = (int*)(ws + WS_SLOT); int* TOKS = (int*)(ws + WS_TOKS); float* GSLOT = (float*)(ws + WS_GSLOT);
    LAS int* base = (LAS int*)lds; LAS unsigned* lcnt = (LAS unsigned*)(lds + 256); LAS unsigned* bbase = (LAS unsigned*)(lds + 512);
    moe_bases(ctl, base, tid);
    for (int blk = vcu; blk < M / 64; blk += G) {
        if (tid < 32) lcnt[tid] = 0u;
        __syncthreads();
        int e = 0; unsigned lr = 0;
        if (tid < 256) { e = TOPI[(size_t)blk * 256 + tid]; lr = __hip_atomic_fetch_add(&lcnt[e], 1u, __ATOMIC_RELAXED, __HIP_MEMORY_SCOPE_WORKGROUP); }
        __syncthreads();
        if (tid < 32) { const unsigned n = lcnt[tid]; bbase[tid] = n ? atomicAdd(ctl + CW_FILL + tid, n) : 0u; }
        __syncthreads();
        if (tid < 256) { const int slot = base[e] + (int)bbase[e] + (int)lr; SLOT[(size_t)blk * 256 + tid] = slot; TOKS[slot] = blk * 64 + (tid >> 2); GSLOT[slot] = GATE[(size_t)blk * 256 + tid]; }
        __syncthreads();
    }
}

template <bool GATHER_> struct MoeOrder {
    static constexpr bool GATHER = GATHER_, HALFSEL = true;
    const LAS int* base;
    int MT, nN, G, c, KB; const int* toks; const char* A; const char* Bt; size_t bexp;
    bool rowsplit = false;
    int tev;
    __device__ __forceinline__ bool decode(int i, int& mt, int& n, int& hs) const {
        hs = 0;
        if (rowsplit && (G & 7) == 0) {
            const int per = G >> 3, x = c & 7, cl = c >> 3, lo = (x * MT) >> 3, hi = ((x + 1) * MT) >> 3; const int T = (hi - lo) * nN, R = T / per, L = T - R * per; int j;
            if (i < R) j = i * per + cl;
            else if (i == R && L > 0) { if (2 * L <= per) { if (cl >= 2 * L) return false; j = R * per + (cl >> 1); hs = 1 + (cl & 1); } else { if (cl >= L) return false; j = R * per + cl; } }
            else return false;
            mt = lo + j / nN; n = j % nN; }
        else if ((G & 7) == 0 && (nN & 7) == 0) { const int npx = nN >> 3, per = G >> 3, x = c & 7, cl = c >> 3; const int T = MT * npx, R = T / per, L = T - R * per; int j;
            if (i < R) j = i * per + cl;
            else if (i == R && L > 0) {
                if (2 * L <= per) { if (cl >= 2 * L) return false; j = R * per + (cl >> 1); hs = 1 + (cl & 1); } else { if (cl >= L) return false; j = R * per + cl; } }
            else return false;
            mt = j / npx; n = x * npx + j % npx; }
        else { const long L = (long)i * G + c; if (L >= (long)MT * nN) return false; mt = (int)(L / nN); n = (int)(L % nN); }
        return true;
    }
    __device__ __forceinline__ void prime(int lane) { int mt = 0, n, hs; tev = decode(lane, mt, n, hs) ? (int)((const LAS unsigned char*)(base + 36))[mt] : 0; }
    __device__ bool next(int i, pg8::Unit& u) const {
        int mt, n, hs;
        if (i >= 64 || !decode(i, mt, n, hs)) return false;
        const int te = __builtin_amdgcn_readlane(tev, i); const int e = te & 31;
        if (te & 0x80) { if (hs == 2) return false; hs = 1; }
        u.pm = mt; u.pn = n; u.aux = e; u.hsel = hs;
        u.A = GATHER ? A : A + (size_t)mt * 256 * KB;
        u.B = Bt + (size_t)e * bexp + (size_t)n * 256 * KB;
        return true;
    }
    __device__ __forceinline__ void a_off(const pg8::Unit& u, const int (&sR)[2], const int (&sC)[2], unsigned (&v)[2][2], const LAS unsigned char* side = nullptr) const {
#pragma unroll
        for (int h = 0; h < 2; ++h)
#pragma unroll
            for (int i = 0; i < 2; ++i) { const int row = GATHER ? ((const LAS int*)side)[h * 128 + sR[i]] : (h * 128 + sR[i]); v[h][i] = (unsigned)(row * KB + sC[i] * 2); }
    }
};

__device__ __forceinline__ void combine_tokens(int m, int m2, int lane, bf16* H, const unsigned char* Y2, const int* SLOT, unsigned char* U3, const f32x4 (&w8)[8]) {
    const int4 sa = *(const int4*)(SLOT + (size_t)m * 4), sb = *(const int4*)(SLOT + (size_t)m2 * 4); const int s4[4] = {sa.x, sa.y, sa.z, sa.w}, t4[4] = {sb.x, sb.y, sb.z, sb.w};
    bf16* hr = H + (size_t)m * D; bf16* hr2 = H + (size_t)m2 * D; f32x4 v[8], v2[8]; unsigned ya[4][8], yb[4][8];
#pragma unroll
    for (int j = 0; j < 8; ++j) { v[j] = h4_ld(hr + 4 * (lane + 64 * j)); v2[j] = h4_ld(hr2 + 4 * (lane + 64 * j)); }
#pragma unroll
    for (int k = 0; k < 4; ++k) { const unsigned* yp = (const unsigned*)(Y2 + (size_t)s4[k] * D); const unsigned* yq = (const unsigned*)(Y2 + (size_t)t4[k] * D);
#pragma unroll
        for (int j = 0; j < 8; ++j) { ya[k][j] = yp[lane + 64 * j]; yb[k][j] = yq[lane + 64 * j]; } }
    float ss = 0.f, ss2 = 0.f;
#pragma unroll
    for (int k = 0; k < 4; ++k)
#pragma unroll
        for (int j = 0; j < 8; ++j) { const f32x2 lo = __builtin_amdgcn_cvt_pk_f32_fp8((int)ya[k][j], false), hi = __builtin_amdgcn_cvt_pk_f32_fp8((int)ya[k][j], true); v[j][0] += lo[0]; v[j][1] += lo[1]; v[j][2] += hi[0]; v[j][3] += hi[1];
            const f32x2 lo2 = __builtin_amdgcn_cvt_pk_f32_fp8((int)yb[k][j], false), hi2 = __builtin_amdgcn_cvt_pk_f32_fp8((int)yb[k][j], true); v2[j][0] += lo2[0]; v2[j][1] += lo2[1]; v2[j][2] += hi2[0]; v2[j][3] += hi2[1]; }
#pragma unroll
    for (int j = 0; j < 8; ++j) { h4_st(hr + 4 * (lane + 64 * j), v[j]); ss += (v[j][0] * v[j][0] + v[j][1] * v[j][1]) + (v[j][2] * v[j][2] + v[j][3] * v[j][3]);
        if (m2 != m) h4_st(hr2 + 4 * (lane + 64 * j), v2[j]); ss2 += (v2[j][0] * v2[j][0] + v2[j][1] * v2[j][1]) + (v2[j][2] * v2[j][2] + v2[j][3] * v2[j][3]); }
    const float r = 1.0f / sqrtf(wave_sum(ss) * (1.0f / D) + EPS), r2 = 1.0f / sqrtf(wave_sum(ss2) * (1.0f / D) + EPS);
    unsigned* o = (unsigned*)(U3 + (size_t)m * D); unsigned* o2 = (unsigned*)(U3 + (size_t)m2 * D);
#pragma unroll
    for (int j = 0; j < 8; ++j) { const f32x4 w = w8[j]; int p = 0; p = __builtin_amdgcn_cvt_pk_fp8_f32(v[j][0] * r * w[0], v[j][1] * r * w[1], p, false); p = __builtin_amdgcn_cvt_pk_fp8_f32(v[j][2] * r * w[2], v[j][3] * r * w[3], p, true); o[lane + 64 * j] = (unsigned)p;
        int p2 = 0; p2 = __builtin_amdgcn_cvt_pk_fp8_f32(v2[j][0] * r2 * w[0], v2[j][1] * r2 * w[1], p2, false); p2 = __builtin_amdgcn_cvt_pk_fp8_f32(v2[j][2] * r2 * w[2], v2[j][3] * r2 * w[3], p2, true); if (m2 != m) o2[lane + 64 * j] = (unsigned)p2; }
}
__device__ __forceinline__ void phase_combine(const Args& a, int gw, int NGW, int lane) {
    unsigned char* ws = a.ws;
    bf16* H = (bf16*)(ws + WS_HB); const unsigned char* Y2 = ws + WS_Y2; const int* SLOT = (const int*)(ws + WS_SLOT); unsigned char* U3 = ws + WS_U8; const float* nw = a.in[I_PLEN];
    f32x4 w8[8];
#pragma unroll
    for (int j = 0; j < 8; ++j) w8[j] = ((const f32x4*)nw)[lane + 64 * j];
    for (int m = gw; m < M; m += 2 * NGW) combine_tokens(m, (m + NGW < M) ? m + NGW : m, lane, H, Y2, SLOT, U3, w8);
}
__device__ __forceinline__ void phase_final(const Args& a, int gw, int NGW, int lane) {
    const bf16* HB = (const bf16*)(a.ws + WS_HB); float* H = a.out; const float* nw = a.in[I_FINN];
    f32x4 w8[8];
#pragma unroll
    for (int j = 0; j < 8; ++j) w8[j] = ((const f32x4*)nw)[lane + 64 * j];
    for (int m = gw; m < M; m += 2 * NGW) {
        const int m2 = (m + NGW < M) ? m + NGW : m;
        f32x4 v[8], v2[8]; float ss = 0.f, ss2 = 0.f;
#pragma unroll
        for (int j = 0; j < 8; ++j) { v[j] = h4_ld(HB + (size_t)m * D + 4 * (lane + 64 * j)); v2[j] = h4_ld(HB + (size_t)m2 * D + 4 * (lane + 64 * j)); }
#pragma unroll
        for (int j = 0; j < 8; ++j) { ss += (v[j][0] * v[j][0] + v[j][1] * v[j][1]) + (v[j][2] * v[j][2] + v[j][3] * v[j][3]); ss2 += (v2[j][0] * v2[j][0] + v2[j][1] * v2[j][1]) + (v2[j][2] * v2[j][2] + v2[j][3] * v2[j][3]); }
        const float r = 1.0f / sqrtf(wave_sum(ss) * (1.0f / D) + EPS), r2 = 1.0f / sqrtf(wave_sum(ss2) * (1.0f / D) + EPS);
        f32x4* hr = (f32x4*)(H + (size_t)m * D); f32x4* hr2 = (f32x4*)(H + (size_t)m2 * D);
#pragma unroll
        for (int j = 0; j < 8; ++j) { const f32x4 w = w8[j]; hr[lane + 64 * j] = (f32x4){v[j][0] * r * w[0], v[j][1] * r * w[1], v[j][2] * r * w[2], v[j][3] * r * w[3]};
            hr2[lane + 64 * j] = (f32x4){v2[j][0] * r2 * w[0], v2[j][1] * r2 * w[1], v2[j][2] * r2 * w[2], v2[j][3] * r2 * w[3]}; }
    }
}

constexpr int NPH = 13;
__global__ void __launch_bounds__(512, 2) mk_fwd(Args args) {
    extern __shared__ __attribute__((aligned(16))) unsigned char lds_raw[];
    LAS unsigned char* lds = (LAS unsigned char*)lds_raw;
    volatile LAS unsigned* MISC = (volatile LAS unsigned*)(lds + MISC_OFF);
    const int tid = threadIdx.x, lane = tid & 63, wave = __builtin_amdgcn_readfirstlane(tid >> 6);
    const int G = gridDim.x; const int bx = blockIdx.x; const int vcu = (G % 8 == 0) ? (bx % 8) * (G / 8) + bx / 8 : bx;
    const int gw = vcu * 8 + wave, NGW = G * 8;
    unsigned char* ws = args.ws; unsigned* ctl = (unsigned*)(ws + WS_CTL);
    for (int u = tid; u < (LDS_BYTES - MISC_OFF) / 4; u += 512) ((LAS unsigned*)(lds + MISC_OFF))[u] = 0u;
    __syncthreads();
    XcdBarrier bar; bar.bar = ctl + CW_BAR; bar.x = 0; bar.st = nullptr;
    if (MK_N_LAUNCHES == 1) bar = xcd_barrier_post(ctl + CW_BAR, MISC + 8);
    const int lo = args.ph_lo, hi = args.ph_hi;
#ifndef PHASE_MASK
#define PHASE_MASK 0xFFFF
#endif
#define IN(k) (((PHASE_MASK >> (k)) & 1) && lo <= (k) && (k) < hi)
#define SEAM(k) do { if (IN(k) && IN((k) + 1)) { if (MK_N_LAUNCHES == 1) xcd_barrier(bar); } } while (0)

#ifndef REPEAT_MASK
#define REPEAT_MASK 0
#endif
#define REP(k) ((REPEAT_MASK >> (k)) & 1)
#define PHASE(k, ...) do { if (IN(k)) { __VA_ARGS__ if (REP(k)) { if (MK_N_LAUNCHES == 1) xcd_barrier(bar); __VA_ARGS__ } } SEAM(k); } while (0)

    PHASE(0, { phase_prologue(args, lds, gw, NGW, lane, wave); });
    PHASE(1, {
        { const int cls = (bx >> 3) & 1;
          _Pragma("unroll") for (int slot = 0; slot < 2; ++slot) {
              if (cls == slot) { tr_pool<1>(args, lds, gw, NGW, lane, wave); __syncthreads(); f8_pool(args, lds, gw, NGW, lane, wave); __syncthreads(); if (REP(17)) { f8_pool(args, lds, gw, NGW, lane, wave); __syncthreads(); } if (REP(20)) { f8_pool<true>(args, lds, gw, NGW, lane, wave); __syncthreads(); } if (REP(18)) { stream_probe_vgpr(args, gw, NGW, lane); __syncthreads(); } if (REP(19)) { stream_probe_dma(args, lds, gw, NGW, lane, wave); __syncthreads(); } }
              pg8::StaticOrder S; S.init(ws + WS_U, ws + WS_WINT, M, NPROJ, D, G, bx); S.i0 = 6 * slot; S.i1 = slot == 1 ? (1 << 30) : 6;
              pg8::EpiBf16 E{(bf16*)(ws + WS_PROJ), NPROJ, C_GZ / 256, C_X / 256, C_SZ / 256, NPROJ / 256}; pg8::gemm_phase<pg8::EpiBf16, pg8::StaticOrder>(lds, D, S, E); } }
        { pg8::StaticOrder S; S.init(ws + WS_PBF, ws + WS_WPROJT, M, D, PLE, G, bx); pg8::EpiBf16 E{(bf16*)(ws + WS_PP), D}; pg8::gemm_phase<pg8::EpiBf16, pg8::StaticOrder>(lds, PLE, S, E); }
        small_gemm((const bf16*)(ws + WS_U), (const bf16*)(ws + WS_WSMT), (float*)(ws + WS_PSM), vcu, G, wave, lane);
    });
    PHASE(2, { phase_conv(args, vcu, G, tid, lane); phase_ssd_scalars(args, vcu, G, wave, lane); if (REP(15)) phase_conv(args, vcu, G, tid, lane); xcd_barrier(bar); phase_gdn_pre(args, lds, vcu, G, tid, wave, lane); if (REP(16)) { __syncthreads(); phase_gdn_pre(args, lds, vcu, G, tid, wave, lane); } });
    PHASE(3, { phase_gdn_scan(args, lds, vcu, G, tid, wave, lane); __syncthreads(); if (REP(13)) { phase_gdn_scan(args, lds, vcu, G, tid, wave, lane); __syncthreads(); } phase_ssd(args, lds, vcu, G, tid, wave, lane); if (REP(14)) { __syncthreads(); phase_ssd(args, lds, vcu, G, tid, wave, lane); } });

    PHASE(5, { pg8::StaticOrder S; S.init(ws + WS_OMIX, ws + WS_WOUTT, M, D, DMIX, G, bx); pg8::EpiResF32 E{args.in[I_X], (bf16*)(ws + WS_HB), D, (const float*)(ws + WS_SSQG), (const float*)(ws + WS_SSQ)}; pg8::gemm_phase<pg8::EpiResF32, pg8::StaticOrder>(lds, DMIX, S, E); });
    PHASE(6, { phase_router(args, lds, ctl, vcu, G, tid, wave, lane); });
    PHASE(7, { phase_slots(args, lds, ctl, vcu, G, tid); });
    PHASE(8, {
        LAS int* base = (LAS int*)(lds + MISC_OFF + 64);
        moe_bases(ctl, base, tid); __syncthreads(); moe_tile_experts(ctl, base, tid); __syncthreads();
        MoeOrder<true> S; S.base = base; S.MT = __builtin_amdgcn_readfirstlane(base[NE]) / 256; S.nN = 16; S.G = G; S.c = bx; S.KB = D; S.toks = (const int*)(ws + WS_TOKS); S.A = (const char*)(ws + WS_U8); S.Bt = (const char*)(ws + WS_W1T); S.bexp = (size_t)2 * FF * D;
        S.prime(lane); pg8::EpiMoe1 E{ws + WS_ACT, args.in[I_B1], (const int*)(ws + WS_TOKS)};
        pg8::gemm_phase<pg8::EpiMoe1, MoeOrder<true>, true, true, true>(lds, D, S, E);
    });
    PHASE(9, {
        LAS int* base = (LAS int*)(lds + MISC_OFF + 64);
        moe_bases(ctl, base, tid); __syncthreads(); moe_tile_experts(ctl, base, tid); __syncthreads();
        MoeOrder<false> S; S.base = base; S.MT = __builtin_amdgcn_readfirstlane(base[NE]) / 256; S.nN = 8; S.G = G; S.c = bx; S.KB = FF; S.toks = nullptr; S.rowsplit = true; S.A = (const char*)(ws + WS_ACT); S.Bt = (const char*)(ws + WS_W2T); S.bexp = (size_t)D * FF;
        S.prime(lane); pg8::EpiMoe2 E{ws + WS_Y2, args.in[I_B2], (const float*)(ws + WS_GSLOT)};
        pg8::gemm_phase<pg8::EpiMoe2, MoeOrder<false>, true, true, true>(lds, FF, S, E);
    });
    PHASE(10, { phase_combine(args, gw, NGW, lane); });
    PHASE(11, { pg8::StaticOrder S; S.init(ws + WS_U8, ws + WS_WGATET, M, D, D, G, bx, true); pg8::EpiGate E{(bf16*)(ws + WS_HB), (const bf16*)(ws + WS_PP)}; pg8::gemm_phase<pg8::EpiGate, pg8::StaticOrder, true, true, true>(lds, D, S, E); });
    PHASE(12, { phase_final(args, gw, NGW, lane); });
#undef PHASE
#undef REP
#undef IN
#undef SEAM
}

extern "C" void kernel_launch(void* const* d_in, const int* in_sizes, int n_in, void* d_out, int out_size, void* d_ws, size_t ws_size, hipStream_t stream) {
    static int grid = 0;
    if (grid == 0) {
        if (n_in != 26 || out_size != M * D || ws_size < WS_END) { fprintf(stderr, "kernel_launch: unexpected shapes (n_in %d out %d ws %zu)\n", n_in, out_size, ws_size); grid = -1; return; }
        int dev = 0, cus = 0, per_cu = 0;
        if (hipGetDevice(&dev) != hipSuccess || hipDeviceGetAttribute(&cus, hipDeviceAttributeMultiprocessorCount, dev) != hipSuccess) { grid = -1; return; }
        if (hipFuncSetAttribute((const void*)mk_fwd, hipFuncAttributeMaxDynamicSharedMemorySize, LDS_BYTES) != hipSuccess) { fprintf(stderr, "kernel_launch: hipFuncSetAttribute failed\n"); grid = -1; return; }
        if (hipOccupancyMaxActiveBlocksPerMultiprocessor(&per_cu, (const void*)mk_fwd, 512, LDS_BYTES) != hipSuccess || per_cu < 1) fprintf(stderr, "kernel_launch: occupancy query says %d\n", per_cu);
        (void)hipGetLastError();
        grid = cus;
    }
    if (grid < 0) return;
    (void)hipMemsetAsync((char*)d_ws + WS_CTL, 0, CTL_ZERO_BYTES, stream);
    Args a{};
    for (int i = 0; i < 26; ++i) a.in[i] = (const float*)d_in[i];
    a.out = (float*)d_out; a.ws = (unsigned char*)d_ws;
    if (MK_N_LAUNCHES == 1) { a.ph_lo = 0; a.ph_hi = NPH; hipLaunchKernelGGL(mk_fwd, dim3(grid), dim3(512), LDS_BYTES, stream, a); }
    else { for (int p = 0; p < NPH; ++p) { a.ph_lo = p; a.ph_hi = p + 1; hipLaunchKernelGGL(mk_fwd, dim3(grid), dim3(512), LDS_BYTES, stream, a); } }
}
```

```cpp
#include <hip/hip_runtime.h>
#include <cstdio>
#include <cstdint>

#ifndef MK_N_LAUNCHES
#define MK_N_LAUNCHES 1
#endif

#ifndef REPEAT_MASK
#define REPEAT_MASK 0
#endif
#define GAS __attribute__((address_space(1)))
#define LAS __attribute__((address_space(3)))
typedef unsigned short bf16;
typedef short bf16x8 __attribute__((ext_vector_type(8)));
typedef float f32x4 __attribute__((ext_vector_type(4)));
typedef float f32x3 __attribute__((ext_vector_type(3)));
typedef float f32x2 __attribute__((ext_vector_type(2)));
typedef unsigned u32x4 __attribute__((ext_vector_type(4)));
typedef unsigned u32x2 __attribute__((ext_vector_type(2)));

constexpr int M = 16384, SEQ = 2048, NB = 8, D = 2048;
constexpr int NPROJ = 11264, NSM = 64, INCOLS = 11328;
constexpr int DMIX = 4096, NE = 32, FF = 2048, PLE = 256;
constexpr int C_Q = 0, C_K = 1024, C_V = 2048, C_GZ = 4096, C_X = 6144, C_B = 8192, C_C = 8704, C_SZ = 9216;
constexpr int MAXSLOT = 73728;
constexpr float EPS = 1e-6f;

constexpr size_t MiB = 1u << 20;
constexpr size_t WS_CTL = 0, CTL_ZERO_BYTES = 1 * MiB;
constexpr size_t WS_WINT = 1 * MiB;
constexpr size_t WS_WSMT = 45 * MiB;
constexpr size_t WS_WOUTT = 46 * MiB;
constexpr size_t WS_WGATET = 62 * MiB;
constexpr size_t WS_WPROJT = 70 * MiB;
constexpr size_t WS_WRT = 71 * MiB;
constexpr size_t WS_W1T = 72 * MiB;
constexpr size_t WS_W2T = 584 * MiB;
constexpr size_t WS_U = 840 * MiB;
constexpr size_t WS_PBF = 904 * MiB;
constexpr size_t WS_PP = 912 * MiB;
constexpr size_t WS_PROJ = 976 * MiB;
constexpr size_t WS_PSM = 1328 * MiB;
constexpr size_t WS_GW = 1332 * MiB;
constexpr size_t WS_GQD = 1396 * MiB;
constexpr size_t WS_GKDT = 1460 * MiB;
constexpr size_t WS_GUT = 1524 * MiB;
constexpr size_t WS_GATT = 1588 * MiB;
constexpr size_t WS_GGL = 1620 * MiB;
constexpr size_t WS_ORAW = 1621 * MiB;
constexpr size_t WS_YG = 1685 * MiB;
constexpr size_t WS_SSQG = WS_ORAW;
constexpr size_t WS_SSQ = 1749 * MiB;
constexpr size_t WS_OMIX = 1751 * MiB;
constexpr size_t WS_TOPI = 1879 * MiB;
constexpr size_t WS_GATE = 1880 * MiB;
constexpr size_t WS_SLOT = 1881 * MiB;
constexpr size_t WS_TOKS = 1882 * MiB;
constexpr size_t WS_GSLOT = 1882 * MiB + 512 * 1024;
constexpr size_t WS_ACT = 1883 * MiB;
constexpr size_t WS_Y2 = 2171 * MiB;
constexpr size_t WS_QKVC = 2459 * MiB;
constexpr size_t WS_XBCC = 2587 * MiB;
constexpr size_t WS_GCS = 2683 * MiB;
constexpr size_t WS_U8 = 2684 * MiB;
constexpr size_t WS_HB = 2716 * MiB;
constexpr size_t WS_SSDT = 2780 * MiB;
constexpr size_t WS_END = 2788 * MiB;
constexpr int CW_TMO = 0, CW_CODE = 1;
constexpr int CW_CNT = 1024;
constexpr int CW_FILL = 1024 + 64;
constexpr int CW_BAR = 4096;

constexpr int LDS_BYTES = 163840;
constexpr int MISC_OFF = 163840 - 512;
constexpr int SCR_BYTES = MISC_OFF;

#define LDS_WAIT() asm volatile("s_waitcnt lgkmcnt(0)" ::: "memory")
#define VM_WAIT() asm volatile("s_waitcnt vmcnt(0)" ::: "memory")
#define RLX_AGENT __ATOMIC_RELAXED, __HIP_MEMORY_SCOPE_AGENT

typedef __bf16 bf16x2_t __attribute__((ext_vector_type(2)));
__device__ __forceinline__ unsigned f2bf(float f) { return (unsigned)__builtin_bit_cast(unsigned short, (__bf16)f); }
__device__ __forceinline__ unsigned pk2(float lo, float hi) { f32x2 v = {lo, hi}; return __builtin_bit_cast(unsigned, __builtin_convertvector(v, bf16x2_t)); }
__device__ __forceinline__ float bf2f(unsigned b) { return __builtin_bit_cast(float, b << 16); }
__device__ __forceinline__ float bflo(unsigned w) { return __builtin_bit_cast(float, w << 16); }
__device__ __forceinline__ float bfhi(unsigned w) { return __builtin_bit_cast(float, w & 0xffff0000u); }
__device__ __forceinline__ f32x4 h4_ld(const bf16* p) { const u32x2 w = *(const u32x2*)p; return (f32x4){bflo(w.x), bfhi(w.x), bflo(w.y), bfhi(w.y)}; }
__device__ __forceinline__ float sigmoidf_(float x) { return __builtin_amdgcn_rcpf(1.0f + __expf(-x)); }
__device__ __forceinline__ float siluf_(float x) { return x * __builtin_amdgcn_rcpf(1.0f + __expf(-x)); }
__device__ __forceinline__ float softplusf_(float x) { return fmaxf(x, 0.f) + log1pf(__expf(-fabsf(x))); }
__device__ __forceinline__ float wave_sum(float v) {
#pragma unroll
    for (int o = 1; o < 64; o <<= 1) v += __shfl_xor(v, o);
    return v;
}
__device__ __forceinline__ void h4_st(bf16* p, f32x4 v) { u32x2 w; w.x = pk2(v[0], v[1]); w.y = pk2(v[2], v[3]); *(u32x2*)p = w; }
__device__ __forceinline__ f32x4 mfma16(bf16x8 a, bf16x8 b, f32x4 c) { return __builtin_amdgcn_mfma_f32_16x16x32_bf16(a, b, c, 0, 0, 0); }

template <class T> __device__ __forceinline__ void launder(T& r) { asm volatile("" : "+v"(r)); }
template <class T, int N> __device__ __forceinline__ void launder(T (&r)[N]) {
#pragma unroll
    for (int i = 0; i < N; ++i) asm volatile("" : "+v"(r[i])); }

namespace pg8 {
constexpr int BM = 256, BK = 64, HALF = 128, HTB = HALF * BK * 2, STAGE_BYTES = 8 * HTB, NXCD = 8, WGM = 8;
__host__ __device__ __forceinline__ int lds_byte(int r, int c) { const int st = (r >> 4) * 2 + (c >> 5), rr = r & 15, cc = c & 31, ob = rr * 64 + cc * 2; return st * 1024 + (ob ^ (((ob >> 9) & 1) << 5)); }
__host__ __device__ __forceinline__ void stage_rc(int b, int& R, int& C) { const int st = b / 1024, sb = b % 1024, swz = sb ^ (((sb >> 9) & 1) << 5); R = (st >> 1) * 16 + swz / 64; C = (st & 1) * 32 + (swz % 64) / 2; }
__host__ __device__ __forceinline__ int perm32(int rho) { const int n = rho >> 4, i = rho & 15; return 8 * (i >> 2) + 4 * n + (i & 3); }

struct Unit { int pm, pn, aux, hsel; const char* A; const char* B; };

struct StaticOrder {
    static constexpr bool GATHER = false, HALFSEL = false;
    int nM, nN, nwg, G, c, KB, i0 = 0, i1 = 1 << 30; const char* A; const char* Bt;
    __device__ void init(const void* A_, const void* Bt_, int Mrows, int N, int K_, int G_, int c_, bool f8 = false) { A = (const char*)A_; Bt = (const char*)Bt_; nM = Mrows / BM; nN = N / BM; nwg = nM * nN; G = G_; c = c_; KB = f8 ? K_ : 2 * K_; }
    __device__ bool next(int i, Unit& u) const {
        i += i0; if (i >= i1) return false;
        const long L = (long)i * G + c; if (L >= nwg) return false;
        int wgid = (int)L; { const int q = nwg / NXCD, r = nwg % NXCD, xcd = wgid % NXCD, off = wgid / NXCD; wgid = (xcd < r ? xcd * (q + 1) : r * (q + 1) + (xcd - r) * q) + off; }
        const int nig = WGM * nN, gid = wgid / nig, fm = gid * WGM, gsz = (nM - fm) < WGM ? (nM - fm) : WGM;
        u.pm = fm + ((wgid % nig) % gsz); u.pn = (wgid % nig) / gsz; u.aux = 0; u.hsel = 0;
        u.A = A + (size_t)u.pm * BM * KB; u.B = Bt + (size_t)u.pn * BM * KB; return true;
    }
    __device__ __forceinline__ void a_off(const Unit&, const int (&sR)[2], const int (&sC)[2], unsigned (&v)[2][2], const LAS unsigned char* = nullptr) const {
#pragma unroll
        for (int h = 0; h < 2; ++h)
#pragma unroll
            for (int i = 0; i < 2; ++i) v[h][i] = (unsigned)((h * HALF + sR[i]) * KB + sC[i] * 2);
    }
};

typedef int v8i __attribute__((ext_vector_type(8)));
constexpr int WSCL = 0x79797979;
constexpr float WMUL = 64.0f;
__device__ __forceinline__ const GAS char* pin64(const void* q) { const unsigned long long b = (unsigned long long)q;
    return (const GAS char*)(((unsigned long long)(unsigned)__builtin_amdgcn_readfirstlane((int)(b >> 32)) << 32) | (unsigned)__builtin_amdgcn_readfirstlane((int)b)); }
template <class Epi, class Sched, bool ALIGN_EPI = true, bool SP2 = true, bool F8 = false>
__device__ __forceinline__ void gemm_phase(LAS unsigned char* lds, const int K, const Sched& S, const Epi& E) {
    int tid_ = threadIdx.x; asm volatile("" : "+v"(tid_));
    const int tid = tid_, wid = __builtin_amdgcn_readfirstlane(tid >> 6), lane = tid & 63, wr = wid >> 2, wc = wid & 3, fr = lane & 15, fq = lane >> 4;
    const int KB = F8 ? K : 2 * K;
    const int nt = KB / (BK * 2);
    int sR[2], sC[2]; unsigned voffB[2];
#pragma unroll
    for (int i = 0; i < 2; ++i) { int R, C; stage_rc(tid * 16 + i * 8192, R, C); sR[i] = R; sC[i] = C; const int Rb = Epi::PERM ? ((R & ~31) + perm32(R & 31)) : R; voffB[i] = (unsigned)(Rb * KB + C * 2); }
    const size_t kstep = (size_t)(BK * 2);
    const size_t hstepB = (size_t)HALF * KB;
    const unsigned ldsw = (unsigned)wid * 1024u;
    const int aoff = F8 ? lds_byte(wr * 64 + fr, fq * 16) : lds_byte(wr * 64 + fr, fq * 8), boff = F8 ? lds_byte(wc * 32 + fr, fq * 16) : lds_byte(wc * 32 + fr, fq * 8);
    constexpr int FR2 = F8 ? 16 : 1024;
#define PG8_SA(b, h) (((b) * 2 + (h)) * HTB)
#define PG8_SB(b, h) ((4 + (b) * 2 + (h)) * HTB)
#define PG8_STAGE(bufoff, gbase, voff) do { const GAS char* _g = pin64(gbase); _Pragma("unroll") for (int _i = 0; _i < 2; ++_i) \
        __builtin_amdgcn_global_load_lds((const GAS unsigned*)(_g + (voff)[_i]), (LAS unsigned*)(lds + (bufoff) + ldsw + _i * 8192), 16, 0, 0); } while (0)
#define PG8_LDA(dst, b, h) do { _Pragma("unroll") for (int m = 0; m < 4; ++m) { dst[m].hv[0] = *(const LAS bf16x8*)(lds + PG8_SA(b, h) + aoff + m * 2048); dst[m].hv[1] = *(const LAS bf16x8*)(lds + PG8_SA(b, h) + aoff + FR2 + m * 2048); } } while (0)
#define PG8_LDB(dst, b, h) do { _Pragma("unroll") for (int n = 0; n < 2; ++n) { dst[n].hv[0] = *(const LAS bf16x8*)(lds + PG8_SB(b, h) + boff + n * 2048); dst[n].hv[1] = *(const LAS bf16x8*)(lds + PG8_SB(b, h) + boff + FR2 + n * 2048); } } while (0)
#define PG8_MMA(ai, bj, At, Bt) do { __builtin_amdgcn_s_setprio(1); _Pragma("unroll") for (int m = 0; m < 4; ++m) _Pragma("unroll") for (int n = 0; n < 2; ++n) { \
        if constexpr (F8) { asm volatile("v_mfma_scale_f32_16x16x128_f8f6f4 %0, %1, %2, %0, %3, %4 op_sel_hi:[0,0,0]" : "+v"(acc[ai][bj][m][n]) : "v"(Bt[n].v), "v"(At[m].v), "v"(wscl), "v"(ascl)); } \
        else { _Pragma("unroll") for (int k = 0; k < 2; ++k) acc[ai][bj][m][n] = __builtin_amdgcn_mfma_f32_16x16x32_bf16(Bt[n].hv[k], At[m].hv[k], acc[ai][bj][m][n], 0, 0, 0); } } __builtin_amdgcn_s_setprio(0); } while (0)
#define PG8_WAIT_V(n) asm volatile("s_waitcnt vmcnt(" #n ")" ::: "memory")
#define PG8_WAIT_L(n) asm volatile("s_waitcnt lgkmcnt(" #n ")" ::: "memory")
#define PG8_BAR __builtin_amdgcn_s_barrier()
#define PG8_SCHED __builtin_amdgcn_sched_barrier(0)
    Unit cur, nxt; int ui = 0;
    if (!S.next(0, cur)) return;
    unsigned vA[2][2], nvA[2][2];
    constexpr int NS = Epi::NSIDE; constexpr int SIDE_OFF = 131072;
    int par = 0;
#define PG8_SIDE(u, pr) do { if constexpr (NS > 0) { if (wid < 4) { _Pragma("unroll") for (int _k = 0; _k < NS; ++_k) \
        __builtin_amdgcn_global_load_lds((const GAS unsigned*)E.side_src(u, _k, tid), (LAS unsigned*)(lds + SIDE_OFF + ((pr) * NS + _k) * 1024 + wid * 256), 4, 0, 0); } } } while (0)
    PG8_SIDE(cur, 0);
    if constexpr (NS > 0) { asm volatile("s_waitcnt vmcnt(0)" ::: "memory"); __builtin_amdgcn_s_barrier(); }
    S.a_off(cur, sR, sC, vA, lds + SIDE_OFF + 1024);
    if constexpr (Epi::RESCALE) { E.build(cur, lds, tid); if ((REPEAT_MASK >> 21) & 1) { PG8_SCHED; E.build(cur, lds, tid); } PG8_SCHED; }
    f32x4 acc[2][2][4][2];
    if constexpr (NS > 0) E.init_acc(acc, lds + SIDE_OFF, wc, fq);
    else {
#pragma unroll
    for (int a = 0; a < 2; ++a)
#pragma unroll
        for (int b = 0; b < 2; ++b)
#pragma unroll
            for (int m = 0; m < 4; ++m)
#pragma unroll
                for (int n = 0; n < 2; ++n) acc[a][b][m][n] = (f32x4){0.f, 0.f, 0.f, 0.f};
    }
    union Frag { bf16x8 hv[2]; v8i v; };
    Frag At[4], B0[2], B1[2];
    int wscl = WSCL, ascl = 0x7f7f7f7f; if constexpr (F8) { asm volatile("" : "+v"(wscl), "+v"(ascl)); }
    const char* cA = cur.A; const char* cB = cur.B;
    if constexpr (SP2) {
        PG8_STAGE(PG8_SB(0, 0), cB, voffB); PG8_STAGE(PG8_SB(0, 1), cB + hstepB, voffB); PG8_STAGE(PG8_SA(0, 0), cA, vA[0]); PG8_STAGE(PG8_SA(0, 1), cA, vA[1]);
        if (wr == 1) PG8_BAR;
        PG8_WAIT_V(2); PG8_BAR;
        PG8_STAGE(PG8_SB(1, 0), cB + kstep, voffB); PG8_STAGE(PG8_SA(1, 0), cA + kstep, vA[0]); PG8_STAGE(PG8_SB(1, 1), cB + hstepB + kstep, voffB);
        PG8_WAIT_V(6); PG8_BAR;
    } else {
        PG8_STAGE(PG8_SB(0, 0), cB, voffB); PG8_STAGE(PG8_SA(0, 0), cA, vA[0]); PG8_STAGE(PG8_SB(0, 1), cB + hstepB, voffB); PG8_STAGE(PG8_SA(0, 1), cA, vA[1]);
        if (wr == 1) PG8_BAR;
        PG8_WAIT_V(4); PG8_BAR;
        PG8_STAGE(PG8_SB(1, 0), cB + kstep, voffB); PG8_STAGE(PG8_SA(1, 0), cA + kstep, vA[0]); PG8_STAGE(PG8_SB(1, 1), cB + hstepB + kstep, voffB);
        PG8_WAIT_V(6); PG8_BAR;
    }
    for (;;) {
        const bool has_next = S.next(ui + 1, nxt);
        const char* nAp = has_next ? nxt.A : cA; const char* nBp = has_next ? nxt.B : cB;
        const int npar = (par == 2) ? 0 : par + 1;
        if (has_next) PG8_SIDE(nxt, npar);
        if constexpr (Sched::GATHER) {
#pragma unroll
            for (int h = 0; h < 2; ++h)
#pragma unroll
                for (int i = 0; i < 2; ++i) nvA[h][i] = vA[h][i];
        }
        for (int t = 0; t < nt; t += 2) {
            const bool last = (t == nt - 2);
            if constexpr (Sched::GATHER) { if (last && has_next) S.a_off(nxt, sR, sC, nvA, lds + SIDE_OFF + (npar * NS + 1) * 1024); }
            if constexpr (Epi::RESCALE) { const int it = t >> 1; if (it >= 1 && (it <= 16 || (it & 3) == 0)) { E.template rescale<false>(acc, lds, it <= 16 ? it - 1 : 15 + ((it - 16) >> 2), wr, fr); if ((REPEAT_MASK >> 22) & 1) { PG8_SCHED; E.template rescale<true>(acc, lds, it <= 16 ? it - 1 : 15 + ((it - 16) >> 2), wr, fr); } } PG8_SCHED; }
            const char* a1 = cA + (size_t)(t + 1) * kstep;
            const char* a2 = last ? nAp : cA + (size_t)(t + 2) * kstep; const char* b2 = last ? nBp : cB + (size_t)(t + 2) * kstep;
            const char* a3 = a2 + kstep; const char* b3 = b2 + kstep;
            unsigned w2[2][2];
#pragma unroll
            for (int h = 0; h < 2; ++h)
#pragma unroll
                for (int i = 0; i < 2; ++i) w2[h][i] = (Sched::GATHER && last) ? nvA[h][i] : vA[h][i];
            if constexpr (SP2) {
            PG8_LDB(B0, 0, 0); PG8_LDB(B1, 0, 1); PG8_SCHED; PG8_LDA(At, 0, 0); PG8_STAGE(PG8_SA(1, 1), a1, vA[1]);
            PG8_WAIT_V(8); PG8_WAIT_L(0); PG8_BAR; if (!Sched::HALFSEL || cur.hsel != 2) { PG8_MMA(0, 0, At, B0); PG8_MMA(0, 1, At, B1); } PG8_BAR; PG8_SCHED;
            PG8_LDA(At, 0, 1); PG8_STAGE(PG8_SB(0, 0), b2, voffB); PG8_STAGE(PG8_SB(0, 1), b2 + hstepB, voffB); PG8_STAGE(PG8_SA(0, 0), a2, w2[0]);
            PG8_WAIT_V(8); PG8_WAIT_L(0); PG8_BAR; if (!Sched::HALFSEL || cur.hsel != 1) { PG8_MMA(1, 0, At, B0); PG8_MMA(1, 1, At, B1); } PG8_BAR; PG8_SCHED;
            PG8_LDB(B0, 1, 0); PG8_LDB(B1, 1, 1); PG8_SCHED; PG8_LDA(At, 1, 0); PG8_STAGE(PG8_SA(0, 1), a2, w2[1]);
            PG8_WAIT_V(8); PG8_WAIT_L(0); PG8_BAR; if (!Sched::HALFSEL || cur.hsel != 2) { PG8_MMA(0, 0, At, B0); PG8_MMA(0, 1, At, B1); } PG8_BAR; PG8_SCHED;
            PG8_LDA(At, 1, 1); PG8_STAGE(PG8_SB(1, 0), b3, voffB); PG8_STAGE(PG8_SB(1, 1), b3 + hstepB, voffB); PG8_STAGE(PG8_SA(1, 0), a3, w2[0]);
            PG8_WAIT_V(8); PG8_WAIT_L(0); PG8_BAR; if (!Sched::HALFSEL || cur.hsel != 1) { PG8_MMA(1, 0, At, B0); PG8_MMA(1, 1, At, B1); } PG8_BAR; PG8_SCHED;
            } else {
            PG8_LDB(B0, 0, 0); PG8_SCHED; PG8_LDA(At, 0, 0); PG8_STAGE(PG8_SA(1, 1), a1, vA[1]);
            PG8_WAIT_L(8); PG8_BAR; PG8_WAIT_L(0); PG8_MMA(0, 0, At, B0); PG8_BAR; PG8_SCHED;
            PG8_LDB(B1, 0, 1); PG8_STAGE(PG8_SB(0, 0), b2, voffB);
            PG8_BAR; PG8_WAIT_L(0); PG8_MMA(0, 1, At, B1); PG8_BAR;
            PG8_LDA(At, 0, 1); PG8_STAGE(PG8_SA(0, 0), a2, w2[0]);
            PG8_BAR; PG8_WAIT_L(0); PG8_MMA(1, 0, At, B0); PG8_BAR; PG8_SCHED;
            PG8_STAGE(PG8_SB(0, 1), b2 + hstepB, voffB);
            PG8_WAIT_V(6); PG8_BAR; PG8_MMA(1, 1, At, B1); PG8_BAR;
            PG8_LDB(B0, 1, 0); PG8_SCHED; PG8_LDA(At, 1, 0); PG8_STAGE(PG8_SA(0, 1), a2, w2[1]);
            PG8_WAIT_L(8); PG8_BAR; PG8_WAIT_L(0); PG8_MMA(0, 0, At, B0); PG8_BAR; PG8_SCHED;
            PG8_LDB(B1, 1, 1); PG8_STAGE(PG8_SB(1, 0), b3, voffB);
            PG8_BAR; PG8_WAIT_L(0); PG8_MMA(0, 1, At, B1); PG8_BAR;
            PG8_LDA(At, 1, 1); PG8_STAGE(PG8_SA(1, 0), a3, w2[0]);
            PG8_BAR; PG8_WAIT_L(0); PG8_MMA(1, 0, At, B0); PG8_BAR; PG8_SCHED;
            PG8_STAGE(PG8_SB(1, 1), b3 + hstepB, voffB);
            PG8_WAIT_V(6); PG8_BAR; PG8_MMA(1, 1, At, B1); PG8_BAR;
            }
        }
        if constexpr (ALIGN_EPI) { if (wr == 0) PG8_BAR; }
        if constexpr (F8) { PG8_SCHED; asm volatile("s_nop 15\n\ts_nop 15" ::: "memory"); PG8_SCHED; }
        if constexpr (Epi::RESCALE) E(acc, cur, wr, wc, fr, fq, lds); else if constexpr (NS > 0) E(acc, cur, wr, wc, fr, fq, lds + SIDE_OFF + par * NS * 1024); else E(acc, cur, wr, wc, fr, fq);
        if (!has_next) break;
        if constexpr (Epi::RESCALE) { if (nxt.pm != cur.pm) { PG8_SCHED; PG8_BAR; E.build(nxt, lds, tid); PG8_SCHED; } }
        if constexpr (NS > 0) E.init_acc(acc, lds + SIDE_OFF + npar * NS * 1024, wc, fq);
        else {
#pragma unroll
        for (int a = 0; a < 2; ++a)
#pragma unroll
            for (int b = 0; b < 2; ++b)
#pragma unroll
                for (int m = 0; m < 4; ++m)
#pragma unroll
                    for (int n = 0; n < 2; ++n) acc[a][b][m][n] = (f32x4){0.f, 0.f, 0.f, 0.f};
        }
        cur = nxt; cA = nAp; cB = nBp; ++ui; par = npar;
        if constexpr (Sched::GATHER) {
#pragma unroll
        for (int h = 0; h < 2; ++h)
#pragma unroll
            for (int i = 0; i < 2; ++i) vA[h][i] = nvA[h][i]; }
        if constexpr (ALIGN_EPI) { if (wr == 1) PG8_BAR; }
    }
    PG8_WAIT_V(0);
    if constexpr (!ALIGN_EPI) { if (wr == 0) PG8_BAR; }
    PG8_BAR;
#undef PG8_SA
#undef PG8_SB
#undef PG8_STAGE
#undef PG8_LDA
#undef PG8_LDB
#undef PG8_MMA
#undef PG8_WAIT_V
#undef PG8_WAIT_L
#undef PG8_BAR
#undef PG8_SCHED
}

struct EpiBf16 {
    static constexpr bool PERM = true; static constexpr bool RESCALE = false; static constexpr int NSIDE = 0;
    bf16* O; int ldc; int za0 = 0, za1 = 0, zb0 = 0, zb1 = 0;
    __device__ __forceinline__ void operator()(const f32x4 (&acc)[2][2][4][2], const Unit& u, int wr, int wc, int fr, int fq) const {
        const int row0 = u.pm * BM + wr * 64 + fr, col0 = u.pn * BM + wc * 32 + 8 * fq;
        const bool sz = (u.pn >= za0 && u.pn < za1) || (u.pn >= zb0 && u.pn < zb1);
#pragma unroll
        for (int ai = 0; ai < 2; ++ai)
#pragma unroll
            for (int m = 0; m < 4; ++m) { bf16* rowp = O + (size_t)(row0 + ai * HALF + m * 16) * ldc + col0;
#pragma unroll
                for (int bj = 0; bj < 2; ++bj) { f32x4 v0 = acc[ai][bj][m][0], v1 = acc[ai][bj][m][1];
                    if (sz) { v0 = (f32x4){siluf_(v0[0]), siluf_(v0[1]), siluf_(v0[2]), siluf_(v0[3])}; v1 = (f32x4){siluf_(v1[0]), siluf_(v1[1]), siluf_(v1[2]), siluf_(v1[3])}; }
                    u32x4 w; w.x = pk2(v0[0], v0[1]); w.y = pk2(v0[2], v0[3]); w.z = pk2(v1[0], v1[1]); w.w = pk2(v1[2], v1[3]);
                    *(u32x4*)(rowp + bj * HALF) = w; } }
    }
};
struct EpiResF32 {
    static constexpr bool PERM = false; static constexpr bool RESCALE = true; static constexpr int NSIDE = 0;
    static constexpr int TAB = 131072;
    const float* base; bf16* out; int ldc; const float* SSQG; const float* SSQ;
    __device__ __forceinline__ void build(const Unit& u, LAS unsigned char* lds, int tid) const {
        if (tid < 256) {
            const int row = u.pm * BM + tid; float r[20], q[20];
            const f32x4* g4 = (const f32x4*)(SSQG + (size_t)row * 64);
#pragma unroll
            for (int hv = 0; hv < 16; ++hv) { const f32x4 v = g4[hv]; const float ms = ((v[0] + v[1]) + (v[2] + v[3])) * (1.0f / 128.0f) + EPS; q[hv] = sqrtf(ms); r[hv] = 1.0f / q[hv]; }
            const f32x4* s4 = (const f32x4*)(SSQ + (size_t)row * 32);
#pragma unroll
            for (int g = 0; g < 4; ++g) { const f32x4 v0 = s4[2 * g], v1 = s4[2 * g + 1]; const float ms = ((v0[0] + v0[1]) + (v0[2] + v0[3]) + (v1[0] + v1[1]) + (v1[2] + v1[3])) * (1.0f / 512.0f) + EPS; q[16 + g] = sqrtf(ms); r[16 + g] = 1.0f / q[16 + g]; }
            LAS float* tab = (LAS float*)(lds + TAB) + tid * 20;
#pragma unroll
            for (int s5 = 0; s5 < 5; ++s5) { f32x4 o;
#pragma unroll
                for (int j = 0; j < 4; ++j) { const int sg = 4 * s5 + j; o[j] = sg < 19 ? r[sg] * q[sg < 19 ? sg + 1 : 19] : r[19]; }
                *(LAS f32x4*)(tab + 4 * s5) = o; }
        }
    }
    template <bool ONES> __device__ __forceinline__ void rescale(f32x4 (&acc)[2][2][4][2], LAS unsigned char* lds, int sg, int wr, int fr) const {
        int fo = (wr * 64 + fr) * 80 + sg * 4; asm volatile("" : "+v"(fo));
        const LAS unsigned char* tab = lds + TAB + fo;
#pragma unroll
        for (int ai = 0; ai < 2; ++ai)
#pragma unroll
            for (int m = 0; m < 4; ++m) { float rho = *(const LAS float*)(tab + (ai * HALF + m * 16) * 80); if (ONES) rho = __builtin_fmaf(rho, 0.0f, 1.0f);
#pragma unroll
                for (int bj = 0; bj < 2; ++bj)
#pragma unroll
                    for (int n = 0; n < 2; ++n) acc[ai][bj][m][n] *= rho; }
    }
    __device__ __forceinline__ void operator()(const f32x4 (&acc)[2][2][4][2], const Unit& u, int wr, int wc, int fr, int fq, LAS unsigned char* lds) const {
        const int row0 = u.pm * BM + wr * 64 + fr, col0 = u.pn * BM + wc * 32 + 4 * fq;
        const LAS float* tab = (const LAS float*)(lds + TAB) + (wr * 64 + fr) * 20 + 19;
#pragma unroll
        for (int ai = 0; ai < 2; ++ai) { f32x4 xb[4][2][2]; float rho[4];
#pragma unroll
            for (int m = 0; m < 4; ++m) { const size_t off = (size_t)(row0 + ai * HALF + m * 16) * ldc + col0; rho[m] = tab[(ai * HALF + m * 16) * 20];
#pragma unroll
                for (int bj = 0; bj < 2; ++bj)
#pragma unroll
                    for (int n = 0; n < 2; ++n) xb[m][bj][n] = *(const f32x4*)(base + off + bj * HALF + n * 16); }
            __builtin_amdgcn_sched_barrier(0);
#pragma unroll
            for (int m = 0; m < 4; ++m) { const size_t off = (size_t)(row0 + ai * HALF + m * 16) * ldc + col0;
#pragma unroll
                for (int bj = 0; bj < 2; ++bj)
#pragma unroll
                    for (int n = 0; n < 2; ++n) h4_st(out + off + bj * HALF + n * 16, xb[m][bj][n] + acc[ai][bj][m][n] * rho[m]); }
            __builtin_amdgcn_sched_barrier(0); }
    }
};
struct EpiMoe1 {
    static constexpr bool PERM = true; static constexpr bool RESCALE = false; static constexpr int NSIDE = 2;
    unsigned char* ACT; const float* b1; const int* toks;
    __device__ __forceinline__ const void* side_src(const Unit& u, int k, int tid) const {
        return k == 0 ? (const void*)(b1 + (size_t)u.aux * (2 * FF) + (tid < 128 ? 0 : FF - 128) + u.pn * HALF + tid) : (const void*)(toks + u.pm * BM + tid); }
    __device__ __forceinline__ void init_acc(f32x4 (&acc)[2][2][4][2], const LAS unsigned char* side, int wc, int fq) const {
        const LAS float* bs = (const LAS float*)side + wc * 32 + 8 * fq;
#pragma unroll
        for (int n = 0; n < 2; ++n) { const f32x4 bg = *(const LAS f32x4*)(bs + 4 * n), bl = *(const LAS f32x4*)(bs + 128 + 4 * n) + 1.0f;
#pragma unroll
            for (int ai = 0; ai < 2; ++ai)
#pragma unroll
                for (int m = 0; m < 4; ++m) { acc[ai][0][m][n] = bg; acc[ai][1][m][n] = bl; } }
    }
    __device__ __forceinline__ void operator()(const f32x4 (&acc)[2][2][4][2], const Unit& u, int wr, int wc, int fr, int fq, const LAS unsigned char* side) const {
        const int row0 = u.pm * BM + wr * 64 + fr, colg = u.pn * HALF + wc * 32 + 8 * fq;
#pragma unroll
        for (int ai = 0; ai < 2; ++ai) { if (u.hsel == 2 - ai) continue;
#pragma unroll
            for (int m = 0; m < 4; ++m) { unsigned char* rowp = ACT + (size_t)(row0 + ai * HALF + m * 16) * FF + colg;
                float o[8];
#pragma unroll
                for (int n = 0; n < 2; ++n)
#pragma unroll
                    for (int j = 0; j < 4; ++j) { const float g = fminf(acc[ai][0][m][n][j], 7.0f); const float l1 = fminf(fmaxf(acc[ai][1][m][n][j], -6.0f), 8.0f);
                        o[n * 4 + j] = g * sigmoidf_(1.702f * g) * l1; }
                int p0 = 0, p1 = 0; p0 = __builtin_amdgcn_cvt_pk_fp8_f32(o[0], o[1], p0, false); p0 = __builtin_amdgcn_cvt_pk_fp8_f32(o[2], o[3], p0, true); p1 = __builtin_amdgcn_cvt_pk_fp8_f32(o[4], o[5], p1, false); p1 = __builtin_amdgcn_cvt_pk_fp8_f32(o[6], o[7], p1, true);
                *(u32x2*)rowp = (u32x2){(unsigned)p0, (unsigned)p1}; } }
    }
};
struct EpiMoe2 {
    static constexpr bool PERM = true; static constexpr bool RESCALE = false; static constexpr int NSIDE = 2;
    unsigned char* Y2; const float* b2; const float* gslot;
    __device__ __forceinline__ const void* side_src(const Unit& u, int k, int tid) const { return k == 0 ? (const void*)(b2 + (size_t)u.aux * D + u.pn * BM + tid) : (const void*)(gslot + u.pm * BM + tid); }
    __device__ __forceinline__ void init_acc(f32x4 (&acc)[2][2][4][2], const LAS unsigned char* side, int wc, int fq) const {
        const LAS float* bs = (const LAS float*)side + wc * 32 + 8 * fq;
#pragma unroll
        for (int bj = 0; bj < 2; ++bj)
#pragma unroll
            for (int n = 0; n < 2; ++n) { const f32x4 bv = *(const LAS f32x4*)(bs + bj * HALF + 4 * n);
#pragma unroll
                for (int ai = 0; ai < 2; ++ai)
#pragma unroll
                    for (int m = 0; m < 4; ++m) acc[ai][bj][m][n] = bv; }
    }
    __device__ __forceinline__ void operator()(const f32x4 (&acc)[2][2][4][2], const Unit& u, int wr, int wc, int fr, int fq, const LAS unsigned char* side) const {
        const int row0 = u.pm * BM + wr * 64 + fr, col0 = u.pn * BM + wc * 32 + 8 * fq;
        const LAS float* gs = (const LAS float*)(side + 1024) + wr * 64 + fr;
#pragma unroll
        for (int ai = 0; ai < 2; ++ai) { if (u.hsel == 2 - ai) continue;
#pragma unroll
            for (int m = 0; m < 4; ++m) { const int row = row0 + ai * HALF + m * 16; const float g = gs[ai * HALF + m * 16]; unsigned char* rowp = Y2 + (size_t)row * D + col0;
#pragma unroll
                for (int bj = 0; bj < 2; ++bj) { const f32x4 v0 = acc[ai][bj][m][0] * g, v1 = acc[ai][bj][m][1] * g;
                    int p0 = 0, p1 = 0; p0 = __builtin_amdgcn_cvt_pk_fp8_f32(v0[0], v0[1], p0, false); p0 = __builtin_amdgcn_cvt_pk_fp8_f32(v0[2], v0[3], p0, true); p1 = __builtin_amdgcn_cvt_pk_fp8_f32(v1[0], v1[1], p1, false); p1 = __builtin_amdgcn_cvt_pk_fp8_f32(v1[2], v1[3], p1, true);
                    *(u32x2*)(rowp + bj * HALF) = (u32x2){(unsigned)p0, (unsigned)p1}; } } }
    }
};
struct EpiGate {
    static constexpr bool PERM = false; static constexpr bool RESCALE = false; static constexpr int NSIDE = 0;
    bf16* H; const bf16* PP;
    __device__ __forceinline__ void operator()(const f32x4 (&acc)[2][2][4][2], const Unit& u, int wr, int wc, int fr, int fq) const {
        const int row0 = u.pm * BM + wr * 64 + fr, col0 = u.pn * BM + wc * 32 + 4 * fq;
#pragma unroll
        for (int ai = 0; ai < 2; ++ai) { u32x2 hb[4][2][2], pb[4][2][2];
#pragma unroll
            for (int m = 0; m < 4; ++m) { const size_t off = (size_t)(row0 + ai * HALF + m * 16) * D + col0;
#pragma unroll
                for (int bj = 0; bj < 2; ++bj)
#pragma unroll
                    for (int n = 0; n < 2; ++n) { const size_t o = off + bj * HALF + n * 16; hb[m][bj][n] = *(const u32x2*)(H + o); pb[m][bj][n] = *(const u32x2*)(PP + o); } }
            __builtin_amdgcn_sched_barrier(0);
#pragma unroll
            for (int m = 0; m < 4; ++m) { const size_t off = (size_t)(row0 + ai * HALF + m * 16) * D + col0;
#pragma unroll
                for (int bj = 0; bj < 2; ++bj)
#pragma unroll
                    for (int n = 0; n < 2; ++n) { const size_t o = off + bj * HALF + n * 16; const u32x2 hh = hb[m][bj][n], p = pb[m][bj][n]; const f32x4 a = acc[ai][bj][m][n];
                        f32x4 r; r[0] = bflo(hh.x) + bflo(p.x) * sigmoidf_(a[0]); r[1] = bfhi(hh.x) + bfhi(p.x) * sigmoidf_(a[1]); r[2] = bflo(hh.y) + bflo(p.y) * sigmoidf_(a[2]); r[3] = bfhi(hh.y) + bfhi(p.y) * sigmoidf_(a[3]);
                        h4_st(H + o, r); } }
            __builtin_amdgcn_sched_barrier(0); }
    }
};
}

#define XB_TMO      128
#define XB_XCNT(j)  (256  + 64 * (j))
#define XB_XSUB(j)  (1280 + 64 * (j))
#define XB_XGEN(j)  (2304 + 64 * (j))
#define XB_TOP      3328
#define XB_TOPGEN   3392
#define XCD_BAR_WORDS 3456
#define XB_SPIN_CAP (1u << 18)
__device__ __forceinline__ unsigned xb_ld(unsigned* p)              { return __hip_atomic_load(p, __ATOMIC_RELAXED, __HIP_MEMORY_SCOPE_AGENT); }
__device__ __forceinline__ unsigned xb_add(unsigned* p, unsigned v) { return __hip_atomic_fetch_add(p, v, __ATOMIC_RELAXED, __HIP_MEMORY_SCOPE_AGENT); }
__device__ __forceinline__ unsigned xb_xcc_id() { return (unsigned)__builtin_amdgcn_s_getreg((3 << 11) | 20) & 0xFu; }
#define XB_SPIN(cond, bar) do { unsigned _sp = 0; while (cond) { __builtin_amdgcn_s_sleep(1); \
    if ((++_sp & 255u) == 0u) { if (xb_ld(&(bar)[XB_TMO])) break; if (_sp > XB_SPIN_CAP) { atomicAdd(&(bar)[XB_TMO], 1u); break; } } } } while (0)
struct XcdBarrier { unsigned* bar; unsigned x; volatile LAS unsigned* st; };
__device__ __forceinline__ XcdBarrier xcd_barrier_post(unsigned* bar, volatile LAS unsigned* st) {
    XcdBarrier b; b.bar = bar; b.x = xb_xcc_id(); b.st = st;
    if (threadIdx.x == 0) (void)xb_add(&bar[XB_XCNT(b.x)], 1u);
    return b;
}
__device__ __forceinline__ void xcd_barrier_complete(unsigned* bar, unsigned x, unsigned& nloc, unsigned& nx) {
    const unsigned G = gridDim.x * gridDim.y * gridDim.z;
    unsigned sum, cnt, mine, sp = 0u;
    for (;;) {
        sum = 0u; cnt = 0u; mine = 0u;
#pragma unroll
        for (unsigned j = 0; j < 16; ++j) { const unsigned c = xb_ld(&bar[XB_XCNT(j)]); sum += c; cnt += (c > 0u) ? 1u : 0u; mine = (j == x) ? c : mine; }
        if (sum == G) break;
        __builtin_amdgcn_s_sleep(1);
        if ((++sp & 255u) == 0u) { if (xb_ld(&bar[XB_TMO])) break; if (sp > XB_SPIN_CAP) { atomicAdd(&bar[XB_TMO], 1u); break; } }
    }
    nloc = mine > 0u ? mine : 1u; nx = cnt > 0u ? cnt : 1u;
}
__device__ __forceinline__ void xcd_barrier(const XcdBarrier& b) {
    asm volatile("s_waitcnt vmcnt(0)" ::: "memory");
    __syncthreads();
    if (threadIdx.x == 0) {
        unsigned* bar = b.bar;
        __builtin_amdgcn_s_waitcnt(0);
        unsigned nloc = b.st[0], nx = b.st[1];
        if (nloc == 0u) { xcd_barrier_complete(bar, b.x, nloc, nx); b.st[0] = nloc; b.st[1] = nx; }
        const unsigned old = xb_add(&bar[XB_XSUB(b.x)], 1u);
        const unsigned gen = old / nloc;
        if (old + 1u == (gen + 1u) * nloc) {
            __builtin_amdgcn_fence(__ATOMIC_RELEASE, "agent");
            asm volatile("s_waitcnt vmcnt(0)" ::: "memory");
            const unsigned og = xb_add(&bar[XB_TOP], 1u);
            const unsigned tg = og / nx;
            if (og + 1u == (tg + 1u) * nx) xb_add(&bar[XB_TOPGEN], 1u);
            else XB_SPIN(xb_ld(&bar[XB_TOPGEN]) == tg, bar);
            __builtin_amdgcn_fence(__ATOMIC_ACQUIRE, "agent");
            xb_add(&bar[XB_XGEN(b.x)], 1u);
            asm volatile("s_waitcnt vmcnt(0)" ::: "memory");
        } else {
            XB_SPIN(xb_ld(&bar[XB_XGEN(b.x)]) == gen, bar);
            __builtin_amdgcn_fence(__ATOMIC_ACQUIRE, "agent");
            asm volatile("s_waitcnt vmcnt(0)" ::: "memory");
        }
    }
    __syncthreads();
}

struct Args { const float* in[26]; float* out; unsigned char* ws; int ph_lo, ph_hi; };
enum { I_X = 0, I_P, I_MIXN, I_WIN, I_GCONV, I_GALOG, I_GDTB, I_GNORM, I_SCONV, I_SCONVB, I_SALOG, I_SDTB, I_SD, I_SNORM, I_WOUT, I_FFNN, I_WR, I_BR, I_W1, I_B1, I_W2, I_B2, I_PLEN, I_WG, I_WP, I_FINN };

struct TrItem { const float* W; int N, k0, n0, kind, e; };
constexpr int TI_IN = (D / 64) * (INCOLS / 64), TI_OUT = (DMIX / 64) * (D / 64), TI_G = (D / 64) * (D / 64), TI_PJ = (PLE / 64) * (D / 64), TI_1 = (D / 64) * (2 * FF / 64), TI_2 = (FF / 64) * (D / 64);
constexpr int TI_NA = TI_IN + TI_PJ, TI_NB = TI_OUT + TI_G;
template <int POOL> __device__ __forceinline__ TrItem tr_decode(const Args& a, int it) {
    TrItem t; int r = it; t.e = 0;
    if constexpr (POOL == 0) {
        if (r < TI_IN) { const int nb = INCOLS / 64; t.W = a.in[I_WIN]; t.N = INCOLS; t.k0 = (r / nb) * 64; t.n0 = (r % nb) * 64; t.kind = 0; return t; } r -= TI_IN;
        { const int nb = D / 64; t.W = a.in[I_WP]; t.N = D; t.k0 = (r / nb) * 64; t.n0 = (r % nb) * 64; t.kind = 3; return t; }
    }
    r += TI_IN;
    if (r < TI_IN) { const int nb = INCOLS / 64; t.W = a.in[I_WIN]; t.N = INCOLS; t.k0 = (r / nb) * 64; t.n0 = (r % nb) * 64; t.kind = 0; return t; } r -= TI_IN;
    if (r < TI_OUT) { const int nb = D / 64; t.W = a.in[I_WOUT]; t.N = D; t.k0 = (r / nb) * 64; t.n0 = (r % nb) * 64; t.kind = 1; return t; } r -= TI_OUT;
    if (r < TI_G) { const int nb = D / 64; t.W = a.in[I_WG]; t.N = D; t.k0 = (r / nb) * 64; t.n0 = (r % nb) * 64; t.kind = 2; return t; } r -= TI_G;
    if (r < NE * TI_1) { const int e = r / TI_1, q = r % TI_1, nb = 2 * FF / 64; t.W = a.in[I_W1] + (size_t)e * D * 2 * FF; t.N = 2 * FF; t.k0 = ((q / (2 * nb)) * 2 + (q & 1)) * 64; t.n0 = ((q >> 1) % nb) * 64; t.kind = 4; t.e = e; return t; } r -= NE * TI_1;
    { const int e = r / TI_2, q = r % TI_2, nb = D / 64; t.W = a.in[I_W2] + (size_t)e * FF * D; t.N = D; t.k0 = ((q / (2 * nb)) * 2 + (q & 1)) * 64; t.n0 = ((q >> 1) % nb) * 64; t.kind = 5; t.e = e; return t; }
}
__device__ __forceinline__ void tr_load(const TrItem& t, int lane, f32x4 (&v)[16], f32x4 (&mw)[2], const float* gnw, const float* snw) {
    mw[0] = (f32x4){1.f, 1.f, 1.f, 1.f}; mw[1] = mw[0];
    if (t.kind == 1) { const int k = t.k0 + 8 * (lane & 7); const float* nwp = (k < D) ? gnw + (k & 127) : snw + (k - D); mw[0] = *(const f32x4*)nwp; mw[1] = *(const f32x4*)(nwp + 4); }
#pragma unroll
    for (int i = 0; i < 16; ++i) { const int r = i * 4 + (lane >> 4), c4 = lane & 15; v[i] = __builtin_nontemporal_load((const f32x4*)(t.W + (size_t)(t.k0 + r) * t.N + t.n0 + 4 * c4)); }
}
__device__ __forceinline__ void tr_finish(const TrItem& t, const f32x4 (&v)[16], unsigned char* ws, LAS float* scr, int lane, const f32x4 (&mw)[2]) {
#pragma unroll
    for (int i = 0; i < 16; ++i) { const int r = i * 4 + (lane >> 4), c4 = lane & 15; *(LAS f32x4*)(scr + r * 68 + 4 * c4) = v[i]; }
    LDS_WAIT();
    if (t.kind == 2 || t.kind >= 4) {
        const int c = lane & 3;
#pragma unroll
        for (int j = 0; j < 4; ++j) { const int nl = (lane >> 2) + 16 * j, n = t.n0 + nl; const LAS float* s = scr + (16 * c) * 68 + nl; int p[4];
#pragma unroll
            for (int q = 0; q < 4; ++q) { int w = 0; w = __builtin_amdgcn_cvt_pk_fp8_f32(s[(4 * q) * 68] * pg8::WMUL, s[(4 * q + 1) * 68] * pg8::WMUL, w, false); w = __builtin_amdgcn_cvt_pk_fp8_f32(s[(4 * q + 2) * 68] * pg8::WMUL, s[(4 * q + 3) * 68] * pg8::WMUL, w, true); p[q] = w; }
            unsigned char* d;
            if (t.kind == 2) d = ws + WS_WGATET + (size_t)n * D;
            else if (t.kind == 4) { const int row = (n < FF) ? ((n >> 7) * 256 + (n & 127)) : ((((n - FF) >> 7) * 256) + 128 + ((n - FF) & 127)); d = ws + WS_W1T + ((size_t)t.e * (2 * FF) + row) * D; }
            else d = ws + WS_W2T + ((size_t)t.e * D + n) * FF;
            *(u32x4*)(d + t.k0 + 16 * c) = (u32x4){(unsigned)p[0], (unsigned)p[1], (unsigned)p[2], (unsigned)p[3]}; }
    } else {
        const int c = lane & 7;
        const f32x4 m0 = mw[0], m1 = mw[1];
#pragma unroll
        for (int j = 0; j < 8; ++j) { const int nl = (lane >> 3) + 8 * j, n = t.n0 + nl; const LAS float* s = scr + (8 * c) * 68 + nl;
            u32x4 o; o.x = pk2(s[0 * 68] * m0[0], s[1 * 68] * m0[1]); o.y = pk2(s[2 * 68] * m0[2], s[3 * 68] * m0[3]); o.z = pk2(s[4 * 68] * m1[0], s[5 * 68] * m1[1]); o.w = pk2(s[6 * 68] * m1[2], s[7 * 68] * m1[3]);
            bf16* p;
            if (t.kind == 0) { bf16* WinT = (bf16*)(ws + WS_WINT); bf16* WsmT = (bf16*)(ws + WS_WSMT);
                p = (n < 6144) ? WinT + (size_t)n * D : (n < 6176) ? WsmT + (size_t)(n - 6144) * D : (n < 11296) ? WinT + (size_t)(n - 32) * D : WsmT + (size_t)(32 + n - 11296) * D; }
            else if (t.kind == 1) p = (bf16*)(ws + WS_WOUTT) + (size_t)n * DMIX;
            else p = (bf16*)(ws + WS_WPROJT) + (size_t)n * PLE;
            *(u32x4*)(p + t.k0 + 8 * c) = o; }
    }
    LDS_WAIT();
}

struct F8Item { const float* W; int N, k0, n0, kind, e; };
constexpr int FI_1 = (D / 128) * (2 * FF / 128), FI_2 = (FF / 128) * (D / 128), FI_G = (D / 128) * (D / 128), FI_N = NE * FI_1 + NE * FI_2;
__device__ __forceinline__ F8Item f8_decode(const Args& a, int it) {
    F8Item t; int r = it;
    if (r < NE * FI_1) { const int e = r / FI_1, q = r % FI_1, nb = 2 * FF / 128; t.W = a.in[I_W1] + (size_t)e * D * 2 * FF; t.N = 2 * FF; t.k0 = (q / nb) * 128; t.n0 = (q % nb) * 128; t.kind = 4; t.e = e; return t; } r -= NE * FI_1;
    if (r < NE * FI_2) { const int e = r / FI_2, q = r % FI_2, nb = D / 128; t.W = a.in[I_W2] + (size_t)e * FF * D; t.N = D; t.k0 = (q / nb) * 128; t.n0 = (q % nb) * 128; t.kind = 5; t.e = e; return t; } r -= NE * FI_2;
    { const int nb = D / 128; t.W = a.in[I_WG]; t.N = D; t.k0 = (r / nb) * 128; t.n0 = (r % nb) * 128; t.kind = 2; t.e = 0; return t; }
}
__device__ __forceinline__ const GAS char* pin_sgpr(const void* q) { const unsigned long long b = (unsigned long long)q;
    return (const GAS char*)(((unsigned long long)(unsigned)__builtin_amdgcn_readfirstlane((int)(b >> 32)) << 32) | (unsigned)__builtin_amdgcn_readfirstlane((int)b)); }
__device__ __forceinline__ void f8_load(const F8Item& t, int sub, int lane, f32x4 (&v)[16]) {
    const float* p0 = t.W + (size_t)(t.k0 + 32 * sub) * t.N + t.n0; const unsigned rs = (unsigned)t.N * 4u, v0 = (unsigned)(lane & 31) * 16u + (unsigned)(lane >> 5) * 16u * rs;
    const unsigned vo[4] = {v0, v0 + rs, v0 + 2u * rs, v0 + 3u * rs};
#pragma unroll
    for (int q = 0; q < 4; ++q) { const GAS char* p = pin_sgpr(p0 + (size_t)(4 * q) * t.N);
#pragma unroll
        for (int j = 0; j < 4; ++j) v[4 * q + j] = __builtin_nontemporal_load((const GAS f32x4*)(p + vo[j])); }
}
__device__ __forceinline__ unsigned f8_pack4(f32x4 v) { int w = 0; w = __builtin_amdgcn_cvt_pk_fp8_f32(v[0] * pg8::WMUL, v[1] * pg8::WMUL, w, false); w = __builtin_amdgcn_cvt_pk_fp8_f32(v[2] * pg8::WMUL, v[3] * pg8::WMUL, w, true); return (unsigned)w; }
__device__ __forceinline__ void f8_pack_store(const f32x4 (&v)[16], int sub, int lane, LAS unsigned char* scr) {
    asm volatile("" : "+v"(lane));
    const int c = lane & 31, ch = 2 * sub + (lane >> 5);
    LAS unsigned char* base = scr + (4 * c) * 128 + 16 * (ch ^ (c & 7));
#pragma unroll
    for (int g = 0; g < 4; ++g) {
        const unsigned A = f8_pack4(v[4 * g]), B = f8_pack4(v[4 * g + 1]), C = f8_pack4(v[4 * g + 2]), Dd = f8_pack4(v[4 * g + 3]);
        const unsigned P = __builtin_amdgcn_perm(B, A, 0x05010400u), Q = __builtin_amdgcn_perm(B, A, 0x07030602u), R = __builtin_amdgcn_perm(Dd, C, 0x05010400u), S = __builtin_amdgcn_perm(Dd, C, 0x07030602u);
        *(LAS unsigned*)(base + 4 * g) = __builtin_amdgcn_perm(R, P, 0x05040100u); *(LAS unsigned*)(base + 128 + 4 * g) = __builtin_amdgcn_perm(R, P, 0x07060302u);
        *(LAS unsigned*)(base + 256 + 4 * g) = __builtin_amdgcn_perm(S, Q, 0x05040100u); *(LAS unsigned*)(base + 384 + 4 * g) = __builtin_amdgcn_perm(S, Q, 0x07060302u); }
}
template <bool NOSTORE = false> __device__ __forceinline__ void f8_flush(const F8Item& t, unsigned char* ws, LAS unsigned char* scr, int lane) {
    asm volatile("" : "+v"(lane));
    LDS_WAIT();
    const int q = lane & 7;
#pragma unroll
    for (int i = 0; i < 16; ++i) { const int r = (lane >> 3) + 8 * i; const u32x4 v = *(const LAS u32x4*)(scr + r * 128 + 16 * (q ^ ((r >> 2) & 7))); const int n = t.n0 + r;
        unsigned char* d;
        if (t.kind == 2) d = ws + WS_WGATET + (size_t)n * D;
        else if (t.kind == 4) { const int row = (n < FF) ? ((n >> 7) * 256 + (n & 127)) : ((((n - FF) >> 7) * 256) + 128 + ((n - FF) & 127)); d = ws + WS_W1T + ((size_t)t.e * (2 * FF) + row) * D; }
        else d = ws + WS_W2T + ((size_t)t.e * D + n) * FF;
        if constexpr (!NOSTORE) *(u32x4*)(d + t.k0 + 16 * q) = v; else asm volatile("" :: "v"(v), "v"(d)); }
    LDS_WAIT();
}
template <bool NOSTORE = false> __device__ __forceinline__ void f8_pool(const Args& a, LAS unsigned char* lds, int gw, int NGW, int lane_, int wave) {
    int lane = lane_; asm volatile("" : "+v"(lane));
    unsigned char* ws = a.ws; const int cw = wave & 3; const bool storer = wave >= 4;
    LAS unsigned char* tile0 = lds + cw * 32768;
    volatile LAS unsigned* fl = (volatile LAS unsigned*)(lds + 131072 + cw * 16);
    __syncthreads();
    if (wave < 4 && lane < 2) fl[lane] = 0u;
    __syncthreads();
    const int v0 = gw - wave + cw, v1 = v0 + 4;
#define F8_ITEM(j) ((((j) & 1) ? v1 : v0) + ((j) >> 1) * NGW)
#define F8_TILE(j) (tile0 + ((j) & 1) * 16384)
    if (!storer) {
        f32x4 b0[16], b1[16], b2[16]; int j = 0;
        bool vA = F8_ITEM(0) < FI_N, vB = F8_ITEM(1) < FI_N, vC = F8_ITEM(2) < FI_N, vD;
        if (vA) { const F8Item t = f8_decode(a, F8_ITEM(0)); f8_load(t, 0, lane, b0); f8_load(t, 1, lane, b1); }
#define F8_STEP(CUR, LD, SUBC, VL, JL, SUBL, JC) do { if (VL) { const F8Item tl = f8_decode(a, F8_ITEM(JL)); f8_load(tl, SUBL, lane, LD); } f8_pack_store(CUR, SUBC, lane, F8_TILE(JC)); } while (0)
#define F8_WAITD(jj) do { if ((jj) >= 2) { while (fl[1] < (unsigned)((jj) - 1)) __builtin_amdgcn_s_sleep(4); } asm volatile("" ::: "memory"); } while (0)
#define F8_SIGF(jj) do { LDS_WAIT(); if (lane == 0) fl[0] = (unsigned)((jj) + 1); } while (0)
#pragma unroll 1
        while (vA) {
            F8_WAITD(j); F8_STEP(b0, b2, 0, true, j, 2, j); F8_STEP(b1, b0, 1, true, j, 3, j); F8_STEP(b2, b1, 2, vB, j + 1, 0, j); F8_STEP(b0, b2, 3, vB, j + 1, 1, j); F8_SIGF(j);
            if (!vB) break;
            F8_WAITD(j + 1); F8_STEP(b1, b0, 0, true, j + 1, 2, j + 1); F8_STEP(b2, b1, 1, true, j + 1, 3, j + 1); F8_STEP(b0, b2, 2, vC, j + 2, 0, j + 1); F8_STEP(b1, b0, 3, vC, j + 2, 1, j + 1); F8_SIGF(j + 1);
            if (!vC) break;
            vD = F8_ITEM(j + 3) < FI_N;
            F8_WAITD(j + 2); F8_STEP(b2, b1, 0, true, j + 2, 2, j + 2); F8_STEP(b0, b2, 1, true, j + 2, 3, j + 2); F8_STEP(b1, b0, 2, vD, j + 3, 0, j + 2); F8_STEP(b2, b1, 3, vD, j + 3, 1, j + 2); F8_SIGF(j + 2);
            j += 3; vA = vD; vB = F8_ITEM(j + 1) < FI_N; vC = F8_ITEM(j + 2) < FI_N;
        }
#undef F8_STEP
#undef F8_WAITD
#undef F8_SIGF
    } else {
#pragma unroll 1
        for (int j = 0; F8_ITEM(j) < FI_N; ++j) {
            while (fl[0] < (unsigned)(j + 1)) __builtin_amdgcn_s_sleep(4);
            asm volatile("" ::: "memory");
            f8_flush<NOSTORE>(f8_decode(a, F8_ITEM(j)), ws, F8_TILE(j), lane);
            if (lane == 0) fl[1] = (unsigned)(j + 1);
        }
    }
#undef F8_ITEM
#undef F8_TILE
}
__device__ __forceinline__ void stream_probe_vgpr(const Args& a, int gw, int NGW, int lane_) {
    int lane = lane_; asm volatile("" : "+v"(lane));
    f32x4 b0[16], b1[16], b2[16]; f32x4 acc = {0.f, 0.f, 0.f, 0.f};
#define SP_ACC(B) do { _Pragma("unroll") for (int i = 0; i < 16; ++i) acc += B[i]; } while (0)
#pragma unroll 1
    for (int it = gw; it < FI_N; it += NGW) { const F8Item t = f8_decode(a, it);
        f8_load(t, 0, lane, b0); f8_load(t, 1, lane, b1); f8_load(t, 2, lane, b2); SP_ACC(b0); f8_load(t, 3, lane, b0); SP_ACC(b1); SP_ACC(b2); SP_ACC(b0); }
#undef SP_ACC
    if (acc[0] + acc[1] + acc[2] + acc[3] == 123.456f) *(float*)(a.ws + WS_CTL + 4096) = 1.f;
}
__device__ __forceinline__ void stream_probe_dma(const Args& a, LAS unsigned char* lds, int gw, int NGW, int lane_, int wave) {
    int lane = lane_; asm volatile("" : "+v"(lane));
    LAS unsigned char* scr = lds + wave * 16384;
#pragma unroll 1
    for (int it = gw; it < FI_N; it += NGW) { const F8Item t = f8_decode(a, it);
#pragma unroll
        for (int sub = 0; sub < 4; ++sub) { const float* p0 = t.W + (size_t)(t.k0 + 32 * sub) * t.N + t.n0; const unsigned rs = (unsigned)t.N * 4u, v0 = (unsigned)(lane & 31) * 16u + (unsigned)(lane >> 5) * 16u * rs;
#pragma unroll
            for (int i = 0; i < 16; ++i) __builtin_amdgcn_global_load_lds((const unsigned*)((const char*)p0 + (size_t)i * rs + v0), (LAS unsigned*)(scr + i * 1024), 16, 0, 0);
            asm volatile("s_waitcnt vmcnt(48)" ::: "memory"); } }
    asm volatile("s_waitcnt vmcnt(0)" ::: "memory");
}
template <int POOL> __device__ __forceinline__ void tr_pool(const Args& a, LAS unsigned char* lds, int gw, int NGW, int lane_, int wave) {
    int lane = lane_; asm volatile("" : "+v"(lane));
    unsigned char* ws = a.ws; constexpr int NIT = POOL == 0 ? TI_NA : TI_NB;
    LAS float* scr = (LAS float*)(lds + wave * 17408);
    f32x4 va[16], vb[16], ma[2], mb[2]; int it = gw; const float* gnw = a.in[I_GNORM]; const float* snw = a.in[I_SNORM];
    TrItem ta, tb; if (it < NIT) { ta = tr_decode<POOL>(a, it); tr_load(ta, lane, va, ma, gnw, snw); launder(va); launder(ma); }
#pragma unroll 1
    while (it < NIT) {
        const int it1 = it + NGW, it2 = it + 2 * NGW;
        if (it1 < NIT) { tb = tr_decode<POOL>(a, it1); tr_load(tb, lane, vb, mb, gnw, snw); }
        tr_finish(ta, va, ws, scr, lane, ma);
        if (it1 >= NIT) break;
        launder(vb); launder(mb);
        if (it2 < NIT) { ta = tr_decode<POOL>(a, it2); tr_load(ta, lane, va, ma, gnw, snw); }
        tr_finish(tb, vb, ws, scr, lane, mb);
        launder(va); launder(ma);
        it = it2;
    }
}
__device__ __forceinline__ void phase_prologue(const Args& a, LAS unsigned char* lds, int gw, int NGW, int lane, int wave) {
    unsigned char* ws = a.ws;
    tr_pool<0>(a, lds, gw, NGW, lane, wave);
    { const float* x = a.in[I_X]; const float* nw = a.in[I_MIXN]; bf16* U = (bf16*)(ws + WS_U);
      f32x4 w8[8];
#pragma unroll
      for (int j = 0; j < 8; ++j) w8[j] = ((const f32x4*)nw)[lane + 64 * j];
      for (int m = gw; m < M; m += 2 * NGW) {
          const int m2 = (m + NGW < M) ? m + NGW : m;
          const f32x4* xr = (const f32x4*)(x + (size_t)m * D); const f32x4* xr2 = (const f32x4*)(x + (size_t)m2 * D); f32x4 v[8], v2[8]; float s = 0.f, s2 = 0.f;
#pragma unroll
          for (int j = 0; j < 8; ++j) { v[j] = xr[lane + 64 * j]; v2[j] = xr2[lane + 64 * j]; }
#pragma unroll
          for (int j = 0; j < 8; ++j) { s += (v[j][0] * v[j][0] + v[j][1] * v[j][1]) + (v[j][2] * v[j][2] + v[j][3] * v[j][3]); s2 += (v2[j][0] * v2[j][0] + v2[j][1] * v2[j][1]) + (v2[j][2] * v2[j][2] + v2[j][3] * v2[j][3]); }
          const float r = 1.0f / sqrtf(wave_sum(s) * (1.0f / D) + EPS), r2 = 1.0f / sqrtf(wave_sum(s2) * (1.0f / D) + EPS);
          u32x2* o = (u32x2*)(U + (size_t)m * D); u32x2* o2 = (u32x2*)(U + (size_t)m2 * D);
#pragma unroll
          for (int j = 0; j < 8; ++j) { const f32x4 w = w8[j]; u32x2 q; q.x = pk2(v[j][0] * r * w[0], v[j][1] * r * w[1]); q.y = pk2(v[j][2] * r * w[2], v[j][3] * r * w[3]); o[lane + 64 * j] = q;
              u32x2 q2; q2.x = pk2(v2[j][0] * r2 * w[0], v2[j][1] * r2 * w[1]); q2.y = pk2(v2[j][2] * r2 * w[2], v2[j][3] * r2 * w[3]); o2[lane + 64 * j] = q2; }
      } }
    { const f32x4* p = (const f32x4*)a.in[I_P]; u32x2* o = (u32x2*)(ws + WS_PBF); const int n4 = M * PLE / 4;
      const int st = NGW * 64;
      for (int i = gw * 64 + lane; i < n4; i += 4 * st) { f32x4 v[4];
#pragma unroll
          for (int q4 = 0; q4 < 4; ++q4) v[q4] = (i + q4 * st < n4) ? p[i + q4 * st] : (f32x4){0.f, 0.f, 0.f, 0.f};
#pragma unroll
          for (int q4 = 0; q4 < 4; ++q4) if (i + q4 * st < n4) { u32x2 q; q.x = pk2(v[q4][0], v[q4][1]); q.y = pk2(v[q4][2], v[q4][3]); o[i + q4 * st] = q; } } }
    { const float* wr = a.in[I_WR]; bf16* hi = (bf16*)(ws + WS_WRT); bf16* lo = hi + NE * D;
      for (int i = gw * 64 + lane; i < NE * D; i += NGW * 64) { const int e = i / D, k = i % D; const float v = wr[(size_t)k * NE + e]; const unsigned h = f2bf(v); hi[i] = (bf16)h; lo[i] = (bf16)f2bf(v - bf2f(h)); } }
}

__device__ __forceinline__ void small_gemm(const bf16* U, const bf16* WsmT, float* PSM, int vcu, int G, int wave, int lane) {
    for (int blk = vcu; blk < M / 64; blk += G) {
        const int row0 = blk * 64 + (wave >> 1) * 16, cb = (wave & 1) * 2;
        const bf16* ap = U + (size_t)(row0 + (lane & 15)) * D + 8 * (lane >> 4);
        const bf16* bp0 = WsmT + (size_t)(cb * 16 + (lane & 15)) * D + 8 * (lane >> 4);
        const bf16* bp1 = bp0 + (size_t)16 * D;
        f32x4 c0 = {0.f, 0.f, 0.f, 0.f}, c1 = {0.f, 0.f, 0.f, 0.f};
#pragma unroll 8
        for (int ks = 0; ks < D / 32; ++ks) { const bf16x8 av = *(const bf16x8*)(ap + ks * 32); c0 = mfma16(av, *(const bf16x8*)(bp0 + ks * 32), c0); c1 = mfma16(av, *(const bf16x8*)(bp1 + ks * 32), c1); }
#pragma unroll
        for (int r = 0; r < 4; ++r) { float* o = PSM + (size_t)(row0 + 4 * (lane >> 4) + r) * NSM + cb * 16 + (lane & 15); o[0] = c0[r]; o[16] = c1[r]; }
    }
}

template <int OFF0, int OFF1>
__device__ __forceinline__ bf16x8 tr_frag(unsigned addr) {
    union { bf16x8 v; u32x2 h[2]; } r;
    asm volatile("ds_read_b64_tr_b16 %0, %2 offset:%3\n\tds_read_b64_tr_b16 %1, %2 offset:%4\n\ts_waitcnt lgkmcnt(0)" : "=&v"(r.h[0]), "=&v"(r.h[1]) : "v"(addr), "i"(OFF0), "i"(OFF1) : "memory");
    return r.v;
}
template <int KS_STRIDE, int T_STRIDE>
__device__ __forceinline__ void tr_frag4(unsigned addr, bf16x8 (&f)[4]) {
    union { bf16x8 v; u32x2 h[2]; } r[4];
    asm volatile("ds_read_b64_tr_b16 %0, %8 offset:%9\n\tds_read_b64_tr_b16 %1, %8 offset:%10\n\tds_read_b64_tr_b16 %2, %8 offset:%11\n\tds_read_b64_tr_b16 %3, %8 offset:%12\n\t"
                 "ds_read_b64_tr_b16 %4, %8 offset:%13\n\tds_read_b64_tr_b16 %5, %8 offset:%14\n\tds_read_b64_tr_b16 %6, %8 offset:%15\n\tds_read_b64_tr_b16 %7, %8 offset:%16\n\ts_waitcnt lgkmcnt(0)"
                 : "=&v"(r[0].h[0]), "=&v"(r[0].h[1]), "=&v"(r[1].h[0]), "=&v"(r[1].h[1]), "=&v"(r[2].h[0]), "=&v"(r[2].h[1]), "=&v"(r[3].h[0]), "=&v"(r[3].h[1])
                 : "v"(addr), "i"(0), "i"(T_STRIDE), "i"(KS_STRIDE), "i"(KS_STRIDE + T_STRIDE), "i"(2 * KS_STRIDE), "i"(2 * KS_STRIDE + T_STRIDE), "i"(3 * KS_STRIDE), "i"(3 * KS_STRIDE + T_STRIDE) : "memory");
#pragma unroll
    for (int i = 0; i < 4; ++i) f[i] = r[i].v;
}
template <int O0, int O1, int O2, int O3>
__device__ __forceinline__ void tr_frag2(unsigned addr, bf16x8& f0, bf16x8& f1) {
    union { bf16x8 v; u32x2 h[2]; } r0, r1;
    asm volatile("ds_read_b64_tr_b16 %0, %4 offset:%5\n\tds_read_b64_tr_b16 %1, %4 offset:%6\n\tds_read_b64_tr_b16 %2, %4 offset:%7\n\tds_read_b64_tr_b16 %3, %4 offset:%8\n\ts_waitcnt lgkmcnt(0)"
                 : "=&v"(r0.h[0]), "=&v"(r0.h[1]), "=&v"(r1.h[0]), "=&v"(r1.h[1]) : "v"(addr), "i"(O0), "i"(O1), "i"(O2), "i"(O3) : "memory");
    f0 = r0.v; f1 = r1.v;
}
__device__ __forceinline__ unsigned lds_addr(const LAS unsigned char* p) { return (unsigned)(uintptr_t)p; }


struct ConvItem { const bf16* src; bf16* outp; const float* cw; const float* biasp; int wcol, cwN, ldo, t0; bool first, active; float qsc; int kb; };
__device__ __forceinline__ ConvItem conv_item(const Args& a, int item, int tid) {
    unsigned char* ws = a.ws; ConvItem c;
    const bf16* PROJ = (const bf16*)(ws + WS_PROJ); bf16* QKVC = (bf16*)(ws + WS_QKVC); bf16* XBCC = (bf16*)(ws + WS_XBCC);
    const int kb = ((item & 3) + (item >> 9)) & 3  , strip = item >> 2; c.kb = kb; c.t0 = strip * 32; c.first = (c.t0 % SEQ) == 0; c.active = !(kb == 3 && tid >= 256); int pcol; c.biasp = nullptr;
    if (kb < 2) { pcol = kb * 2048 + 4 * tid; c.wcol = pcol; c.cw = a.in[I_GCONV]; c.cwN = 4096; c.outp = QKVC + pcol; c.ldo = 4096; }
    else if (kb == 2) { pcol = C_X + 4 * tid; c.wcol = 4 * tid; c.cw = a.in[I_SCONV]; c.cwN = 3072; c.outp = XBCC + c.wcol; c.ldo = 3072; c.biasp = a.in[I_SCONVB] + c.wcol; }
    else { pcol = C_B + 4 * (tid & 255); c.wcol = 2048 + 4 * (tid & 255); c.cw = a.in[I_SCONV]; c.cwN = 3072; c.outp = XBCC + c.wcol; c.ldo = 3072; c.biasp = a.in[I_SCONVB] + c.wcol; }
    c.src = PROJ + (size_t)c.t0 * NPROJ + pcol; c.qsc = (kb == 0) ? ((tid < 256) ? 0.08838834764831845f : 1.0f) : 0.f;
    return c;
}
__device__ __forceinline__ void conv_loadw(const ConvItem& c, f32x4 (&cwb)[5]) {
#pragma unroll
    for (int k = 0; k < 5; ++k) cwb[k] = (f32x4){0.f, 0.f, 0.f, 0.f};
    if (c.active) {
#pragma unroll
        for (int k = 0; k < 4; ++k) cwb[k] = *(const f32x4*)(c.cw + k * c.cwN + c.wcol);
        if (c.biasp) cwb[4] = *(const f32x4*)c.biasp; }
}
__device__ __forceinline__ void conv_load(const ConvItem& c, u32x2 (&raw)[35]) {
#pragma unroll
    for (int r = 0; r < 35; ++r) { raw[r] = (u32x2){0u, 0u}; if (c.active && !(c.first && r < 3)) raw[r] = *(const u32x2*)(c.src + (long)(r - 3) * NPROJ); }
}
__device__ __forceinline__ void conv_compute(const ConvItem& c, const u32x2 (&raw)[35], const f32x4 (&cwb)[5]) {
    if (!c.active) return;
    const f32x4 w0 = cwb[0], w1 = cwb[1], w2 = cwb[2], w3 = cwb[3], bb = cwb[4];
    f32x4 xa = {bflo(raw[0].x), bfhi(raw[0].x), bflo(raw[0].y), bfhi(raw[0].y)}, xb = {bflo(raw[1].x), bfhi(raw[1].x), bflo(raw[1].y), bfhi(raw[1].y)}, xc = {bflo(raw[2].x), bfhi(raw[2].x), bflo(raw[2].y), bfhi(raw[2].y)};
#pragma unroll
    for (int r = 3; r < 35; ++r) { const f32x4 xd = {bflo(raw[r].x), bfhi(raw[r].x), bflo(raw[r].y), bfhi(raw[r].y)};
        f32x4 o = w0 * xa + w1 * xb + w2 * xc + w3 * xd + bb; xa = xb; xb = xc; xc = xd;
        o = (f32x4){siluf_(o[0]), siluf_(o[1]), siluf_(o[2]), siluf_(o[3])};
        if (c.kb == 0) { float ss = (o[0] * o[0] + o[1] * o[1]) + (o[2] * o[2] + o[3] * o[3]);
            ss += __shfl_xor(ss, 1); ss += __shfl_xor(ss, 2); ss += __shfl_xor(ss, 4); ss += __shfl_xor(ss, 8); ss += __shfl_xor(ss, 16);
            const float rn = c.qsc * __builtin_amdgcn_rsqf(ss + EPS); o = o * rn; }
        u32x2 q; q.x = pk2(o[0], o[1]); q.y = pk2(o[2], o[3]); *(u32x2*)(c.outp + (size_t)(c.t0 + r - 3) * c.ldo) = q; }
}
__device__ __forceinline__ void phase_conv(const Args& a, int vcu, int G, int tid, int lane) {
    constexpr int NIT = 512 * 4;
    u32x2 ra[35], rb[35]; f32x4 w[5]; int item = vcu, kbw = -1;
    ConvItem ca, cb; if (item < NIT) { ca = conv_item(a, item, tid); conv_load(ca, ra); conv_loadw(ca, w); kbw = ca.kb; launder(ra); launder(w); }
#pragma unroll 1
    while (item < NIT) {
        const int i1 = item + G, i2 = item + 2 * G;
        if (i1 < NIT) { cb = conv_item(a, i1, tid); conv_load(cb, rb); }
        conv_compute(ca, ra, w);
        if (i1 >= NIT) break;
        if (cb.kb != kbw) { conv_loadw(cb, w); kbw = cb.kb; }
        launder(rb); launder(w);
        if (i2 < NIT) { ca = conv_item(a, i2, tid); conv_load(ca, ra); }
        conv_compute(cb, rb, w);
        if (i2 < NIT && ca.kb != kbw) { conv_loadw(ca, w); kbw = ca.kb; }
        launder(ra); launder(w);
        item = i2;
    }
}

__device__ __forceinline__ void phase_ssd_scalars(const Args& a, int vcu, int G, int wave, int lane) {
    unsigned char* ws = a.ws; const float* PSM = (const float*)(ws + WS_PSM); f32x4* SSDT = (f32x4*)(ws + WS_SSDT);
    for (int job = vcu; job < NB * 16 * 2; job += G) { const int t0 = (job >> 1) * 128, hhalf = job & 1;
#pragma unroll
        for (int hh = 0; hh < 2; ++hh) { const int h = 16 * hhalf + 2 * wave + hh; const float dtb = a.in[I_SDTB][h], ea = -__expf(a.in[I_SALOG][h]);
            const float d0 = softplusf_(PSM[(size_t)(t0 + 2 * lane) * NSM + 32 + h] + dtb), d1 = softplusf_(PSM[(size_t)(t0 + 2 * lane + 1) * NSM + 32 + h] + dtb);
            const float a0 = ea * d0, a1 = ea * d1; float sc = a0 + a1;
#pragma unroll
            for (int o = 1; o < 64; o <<= 1) { const float n = __shfl_up(sc, o); if (lane >= o) sc += n; }
            const float alast = __shfl(sc, 63);
            SSDT[(size_t)(t0 + 2 * lane) * 32 + h] = (f32x4){d0, sc - a1, d0 * __expf(alast - (sc - a1)), 0.f};
            SSDT[(size_t)(t0 + 2 * lane + 1) * 32 + h] = (f32x4){d1, sc, d1 * __expf(alast - sc), 0.f}; } }
}

constexpr int G2_QL = 0, G2_KL = 17408, G2_VL = 34816, G2_MX = 69632, G2_LD = 143360, G2_SM = 153600;
template <class Epi>
__device__ __forceinline__ void mm64(const LAS unsigned char* Aimg, const LAS unsigned char* Bimg, int rb, int lane, Epi epi) {
    const int r16 = lane & 15, kq = lane >> 4, qq = (lane & 15) >> 2, pp = lane & 3;
    bf16x8 af[2];
#pragma unroll
    for (int ks = 0; ks < 2; ++ks) af[ks] = *(const LAS bf16x8*)(Aimg + (16 * rb + r16) * 144 + kq * 16 + ks * 64);
    const unsigned ba = lds_addr(Bimg + (8 * kq + qq) * 144 + (4 * pp) * 2);
#pragma unroll
    for (int cbk = 0; cbk < 4; ++cbk) {
        bf16x8 b0, b1;
        if (cbk == 0) tr_frag2<0, 576, 4608, 4608 + 576>(ba, b0, b1); else if (cbk == 1) tr_frag2<32, 32 + 576, 4608 + 32, 4608 + 32 + 576>(ba, b0, b1);
        else if (cbk == 2) tr_frag2<64, 64 + 576, 4608 + 64, 4608 + 64 + 576>(ba, b0, b1); else tr_frag2<96, 96 + 576, 4608 + 96, 4608 + 96 + 576>(ba, b0, b1);
        f32x4 c = {0.f, 0.f, 0.f, 0.f}; c = mfma16(b0, af[0], c); c = mfma16(b1, af[1], c);
        epi(16 * rb + r16, 16 * cbk + 4 * kq, c);
    }
}
__device__ __forceinline__ void st4bf(LAS unsigned char* img, int r, int c0, f32x4 v) { u32x2 w; w.x = pk2(v[0], v[1]); w.y = pk2(v[2], v[3]); *(LAS u32x2*)(img + r * 144 + c0 * 2) = w; }

template <int k> __device__ __forceinline__ void g2_addr(int tz, int t0, int hq, const bf16* QKVC, const bf16*& gp, int& lo) {
    if constexpr (k < 4) { const int id = tz + 512 * (k & 1), row = id >> 4, cc = id & 15; gp = QKVC + (size_t)(t0 + row) * 4096 + (k < 2 ? 0 : 1024) + hq * 128 + cc * 8; lo = (k < 2 ? G2_QL : G2_KL) + row * 272 + cc * 16; }
    else { const int id = tz + 512 * (k - 4), row = id >> 5, cc = id & 31; gp = QKVC + (size_t)(t0 + row) * 4096 + 2048 + hq * 256 + cc * 8; lo = G2_VL + (cc >> 4) * 17408 + row * 272 + (cc & 15) * 16; }
}
#define G2_FOR_K(X) X(0) X(1) X(2) X(3) X(4) X(5) X(6) X(7)
__device__ __forceinline__ void phase_gdn_pre(const Args& a, LAS unsigned char* lds, int vcu, int G, int tid, int wave, int lane) {
    unsigned char* ws = a.ws;
    const bf16* QKVC = (const bf16*)(ws + WS_QKVC); const float* PSM = (const float*)(ws + WS_PSM);
    bf16* GW = (bf16*)(ws + WS_GW); bf16* GUT = (bf16*)(ws + WS_GUT); bf16* GATT = (bf16*)(ws + WS_GATT); float* GGL = (float*)(ws + WS_GGL); float* GCS = (float*)(ws + WS_GCS);
    LAS float* sm = (LAS float*)(lds + G2_SM); LAS float* gcs = sm; LAS float* beta = sm + 128;
    const int r16 = lane & 15, kq = lane >> 4, qq = (lane & 15) >> 2, pp = lane & 3;
    u32x4 R[8]; float araw = 0.f, braw = 0.f, galog = 0.f, gdtb = 0.f;
    { const int unit = vcu; if (unit < NB * 32 * 8) { const int hq = unit & 7, c = (unit >> 3) & 31, b = unit >> 8, t0 = b * SEQ + c * 64;
#define G2_LD(k) { const bf16* gp; int lo; g2_addr<k>(tid, t0, hq, QKVC, gp, lo); R[k] = *(const u32x4*)gp; }
        G2_FOR_K(G2_LD)
        if (tid >= 128 && tid < 256) { const int e = (tid - 128) >> 6, hv = 2 * hq + e; araw = PSM[(size_t)(t0 + lane) * NSM + 16 + hv]; braw = PSM[(size_t)(t0 + lane) * NSM + hv]; galog = a.in[I_GALOG][hv]; gdtb = a.in[I_GDTB][hv]; } } }
    for (int unit = vcu; unit < NB * 32 * 8; unit += G) {
        const int hq = unit & 7, c = (unit >> 3) & 31, b = unit >> 8;
        const int t0 = b * SEQ + c * 64;
        const size_t chb = (size_t)(b * 32 + c) * 16 + 2 * hq;
        { int tz = tid; asm volatile("" : "+v"(tz));
#define G2_ST(k) { const bf16* gp; int lo; g2_addr<k>(tz, t0, hq, QKVC, gp, lo); *(LAS u32x4*)(lds + lo) = R[k]; }
          G2_FOR_K(G2_ST)
#undef G2_ST
        }
        if (tid >= 128 && tid < 256) { const int e = (tid - 128) >> 6, hv = 2 * hq + e;
            float g = -__expf(galog) * softplusf_(araw + gdtb);
#pragma unroll
            for (int o = 1; o < 64; o <<= 1) { const float n = __shfl_up(g, o); if (lane >= o) g += n; }
            gcs[e * 64 + lane] = g; beta[e * 64 + lane] = sigmoidf_(braw); GCS[(chb + e) * 64 + lane] = g; if (lane == 63) GGL[chb + e] = __expf(g); }
        for (int i = tid; i < 2 * 2304; i += 512) { const int e = i / 2304, o = i % 2304; ((LAS unsigned*)(lds + G2_MX + e * 36864 + 9216))[o] = 0u; }
        __syncthreads();
        { const int un = unit + G; if (un < NB * 32 * 8) { const int hq2 = un & 7, c2 = (un >> 3) & 31, b2 = un >> 8, t2 = b2 * SEQ + c2 * 64; int tz = tid; asm volatile("" : "+v"(tz));
#define G2_LD2(k) { const bf16* gp; int lo; g2_addr<k>(tz, t2, hq2, QKVC, gp, lo); R[k] = *(const u32x4*)gp; }
            G2_FOR_K(G2_LD2)
#undef G2_LD2
            if (tid >= 128 && tid < 256) { const int e = (tid - 128) >> 6, hv = 2 * hq2 + e; araw = PSM[(size_t)(t2 + lane) * NSM + 16 + hv]; braw = PSM[(size_t)(t2 + lane) * NSM + hv]; galog = a.in[I_GALOG][hv]; gdtb = a.in[I_GDTB][hv]; } } }
        { const bool isq = wave >= 4; const int ni = isq ? 3 - (wave & 3) : (wave & 3);
          const LAS unsigned char* bbase = lds + (isq ? G2_QL : G2_KL) + (16 * ni + r16) * 272 + kq * 16;
          bf16x8 bf[4];
#pragma unroll
          for (int ks = 0; ks < 4; ++ks) bf[ks] = *(const LAS bf16x8*)(bbase + ks * 64);
          const int i = 16 * ni + r16;
#pragma unroll
          for (int mj = 0; mj < 4; ++mj) {
              f32x4 cacc = {0.f, 0.f, 0.f, 0.f};
              if (mj <= ni) { const LAS unsigned char* abase = lds + G2_KL + (16 * mj + r16) * 272 + kq * 16;
#pragma unroll
                  for (int ks = 0; ks < 4; ++ks) cacc = mfma16(*(const LAS bf16x8*)(abase + ks * 64), bf[ks], cacc); }
              const int j0 = 16 * mj + 4 * kq;
#pragma unroll
              for (int e = 0; e < 2; ++e) { const float gi = gcs[e * 64 + i], bi = beta[e * 64 + i]; const f32x4 gj = *(const LAS f32x4*)(gcs + e * 64 + j0);
                  f32x4 o;
#pragma unroll
                  for (int r = 0; r < 4; ++r) { const float dec = __expf(fminf(gi - gj[r], 0.f)); const float vl = cacc[r] * dec * (isq ? 1.0f : bi); o[r] = (isq ? (i >= j0 + r) : (i > j0 + r)) ? vl : 0.f; }
                  if (!isq) { if (mj == ni) *(LAS f32x4*)(lds + G2_LD + e * 5120 + ((ni * 16 + r16) * 20 + 4 * kq) * 4) = o;
                      st4bf(lds + G2_MX + e * 36864, i, j0, (mj < ni) ? o : (f32x4){0.f, 0.f, 0.f, 0.f}); }
                  else { u32x2 w; w.x = pk2(o[0], o[1]); w.y = pk2(o[2], o[3]); *(u32x2*)(GATT + (chb + e) * 4096 + (size_t)i * 64 + j0) = w; } }
          } }
        __syncthreads();
        if (wave < 2) { const int e = wave, blk = lane >> 4, jj = lane & 15; float x[16]; int lz = jj;
            const LAS float* Lb = (const LAS float*)(lds + G2_LD + e * 5120) + blk * 320;
#pragma unroll
            for (int hb = 0; hb < 2; ++hb) { const int i0 = hb ? 12 : 0, i1 = hb ? 16 : 12; f32x4 L4[12][4];
#pragma unroll
                for (int i = i0; i < i1; ++i)
#pragma unroll
                    for (int q = 0; q < (i + 3) / 4; ++q) L4[i - i0][q] = *(const LAS f32x4*)(Lb + i * 20 + 4 * q);
                __builtin_amdgcn_sched_barrier(0);
#pragma unroll
                for (int i = i0; i < i1; ++i) { asm volatile("" : "+v"(lz)); float sacc = 0.f;
#pragma unroll
                    for (int q = 0; q < (i + 3) / 4; ++q) { const f32x4 l4 = L4[i - i0][q];
#pragma unroll
                        for (int t = 0; t < 4; ++t) if (4 * q + t < i) sacc += l4[t] * x[4 * q + t]; }
                    x[i] = ((i == lz) ? 1.0f : 0.0f) - sacc; }
                __builtin_amdgcn_sched_barrier(0); }
            LAS unsigned char* di = lds + G2_MX + e * 36864 + 9216;
#pragma unroll
            for (int i = 0; i < 16; ++i) *(LAS bf16*)(di + (16 * blk + i) * 144 + (16 * blk + jj) * 2) = (bf16)f2bf(x[i]); }
        __syncthreads();
        { const int e = wave >> 2, rb = wave & 3; LAS unsigned char* mx = lds + G2_MX + e * 36864;
          mm64(mx + 9216, mx, rb, lane, [=](int r, int c0, f32x4 v) { st4bf(mx + 18432, r, c0, v); f32x4 m; for (int k = 0; k < 4; ++k) m[k] = ((r == c0 + k) ? 1.0f : 0.0f) - v[k]; st4bf(mx + 27648, r, c0, m); });
          __syncthreads();
          mm64(mx + 18432, mx + 18432, rb, lane, [=](int r, int c0, f32x4 v) { f32x4 m; for (int k = 0; k < 4; ++k) m[k] = ((r == c0 + k) ? 1.0f : 0.0f) + v[k]; st4bf(mx, r, c0, m); });
          __syncthreads();
          mm64(mx + 27648, mx, rb, lane, [=](int r, int c0, f32x4 v) { st4bf(mx + 18432, r, c0, v); });
          __syncthreads();
          mm64(mx + 18432, mx + 9216, rb, lane, [=](int r, int c0, f32x4 v) { const f32x4 b4 = *(const LAS f32x4*)(beta + e * 64 + c0), g4 = *(const LAS f32x4*)(gcs + e * 64 + c0); f32x4 tu, tw;
              for (int k = 0; k < 4; ++k) { tu[k] = v[k] * b4[k]; tw[k] = tu[k] * __expf(g4[k]); } st4bf(mx, r, c0, tu); st4bf(mx + 27648, r, c0, tw); });
          __syncthreads(); }
        { const int e = wave >> 2, kind = (wave >> 1) & 1, hf = wave & 1;
          const LAS unsigned char* mx = lds + G2_MX + e * 36864;
          if (kind == 0) {
#pragma unroll 1
              for (int nd = 0; nd < 8; ++nd) { bf16x8 v0, v1;
                  tr_frag2<0, 4 * 272, 32 * 272, 36 * 272>(lds_addr(lds + G2_VL + e * 17408 + (8 * kq + qq) * 272 + (16 * nd + 4 * pp) * 2), v0, v1);
#pragma unroll
                  for (int m2 = 0; m2 < 2; ++m2) { const int mi = 2 * hf + m2; const LAS unsigned char* ab = mx + (16 * mi + r16) * 144 + kq * 16;
                      f32x4 cc = {0.f, 0.f, 0.f, 0.f}; cc = mfma16(*(const LAS bf16x8*)(ab), v0, cc); cc = mfma16(*(const LAS bf16x8*)(ab + 64), v1, cc);
                      u32x2 w; w.x = pk2(cc[0], cc[1]); w.y = pk2(cc[2], cc[3]);
                      *(u32x2*)(GUT + (chb + e) * 8192 + (size_t)(16 * nd + r16) * 64 + 16 * mi + 4 * kq) = w; } }
          } else {
#pragma unroll 1
              for (int m4 = 0; m4 < 4; ++m4) { const int md = 4 * hf + m4; bf16x8 k0, k1;
                  tr_frag2<0, 4 * 272, 32 * 272, 36 * 272>(lds_addr(lds + G2_KL + (8 * kq + qq) * 272 + (16 * md + 4 * pp) * 2), k0, k1);
#pragma unroll
                  for (int ni = 0; ni < 4; ++ni) { const LAS unsigned char* bb = mx + 27648 + (16 * ni + r16) * 144 + kq * 16;
                      f32x4 cc = {0.f, 0.f, 0.f, 0.f}; cc = mfma16(k0, *(const LAS bf16x8*)(bb), cc); cc = mfma16(k1, *(const LAS bf16x8*)(bb + 64), cc);
                      u32x2 w; w.x = pk2(cc[0], cc[1]); w.y = pk2(cc[2], cc[3]);
                      *(u32x2*)(GW + (chb + e) * 8192 + (size_t)(16 * ni + r16) * 128 + 16 * md + 4 * kq) = w; } }
          } }
        __syncthreads();
    }
}
#undef G2_LD

constexpr int GS_ST = 0, GS_VN = 17408, GS_VN2 = 26624, GS_BUF = 35840, GS_BUFSZ = 61440, GS_W = 0, GS_Q = 17408, GS_K = 34816, GS_A = 52224;
struct GsTile { u32x4 r[7]; };
struct GsLane { u32x2 uT[2]; f32x4 gc; float g63, gcl; u32x2 z[2]; };
__device__ __forceinline__ void launder(GsLane& L) { launder(L.uT); launder(L.gc); launder(L.g63); launder(L.gcl); launder(L.z); }
__device__ __forceinline__ void gs_load_tile(GsTile& T, const bf16* GW, const bf16* QKVC, const bf16* GATT, size_t ch, int trow0, int hq, int tz) {
#pragma unroll
    for (int k = 0; k < 2; ++k) { const int id = tz + 512 * k, row = id >> 4, cc = id & 15;
        T.r[k] = *(const u32x4*)(GW + ch * 8192 + (size_t)row * 128 + cc * 8);
        T.r[2 + k] = *(const u32x4*)(QKVC + (size_t)(trow0 + row) * 4096 + hq * 128 + cc * 8);
        T.r[4 + k] = *(const u32x4*)(QKVC + (size_t)(trow0 + row) * 4096 + 1024 + hq * 128 + cc * 8); }
    { const int row = tz >> 3, cc = tz & 7; T.r[6] = *(const u32x4*)(GATT + ch * 4096 + (size_t)row * 64 + cc * 8); }
}
__device__ __forceinline__ void gs_store_tile(const GsTile& T, LAS unsigned char* buf, int tz) {
#pragma unroll
    for (int k = 0; k < 2; ++k) { const int id = tz + 512 * k, row = id >> 4, cc = id & 15;
        *(LAS u32x4*)(buf + GS_W + row * 272 + cc * 16) = T.r[k]; *(LAS u32x4*)(buf + GS_Q + row * 272 + cc * 16) = T.r[2 + k]; *(LAS u32x4*)(buf + GS_K + row * 272 + cc * 16) = T.r[4 + k]; }
    { const int row = tz >> 3, cc = tz & 7; *(LAS u32x4*)(buf + GS_A + row * 144 + cc * 16) = T.r[6]; }
}
__device__ __forceinline__ void gs_load_lane(GsLane& L, const bf16* GUT, const float* GGL, const float* GCS, size_t ch, int half, int wave, int lane, const unsigned short* zp) {
    const int ti = wave >> 1, tjp = wave & 1, r16 = lane & 15, kq = lane >> 4;
#pragma unroll
    for (int t = 0; t < 2; ++t) L.z[t] = *(const u32x2*)(zp + 16 * t);
    L.gcl = GCS[ch * 64 + 16 * ti + r16];
#pragma unroll
    for (int t = 0; t < 2; ++t) L.uT[t] = *(const u32x2*)(GUT + ch * 8192 + (size_t)(half * 64 + 16 * (2 * tjp + t) + r16) * 64 + 16 * ti + 4 * kq);
    L.gc = *(const f32x4*)(GCS + ch * 64 + 16 * ti + 4 * kq);
    L.g63 = GCS[ch * 64 + 63];
}
__device__ __forceinline__ void phase_gdn_scan(const Args& a, LAS unsigned char* lds, int vcu, int G, int tid, int wave, int lane) {
    unsigned char* ws = a.ws;
    const bf16* GW = (const bf16*)(ws + WS_GW); const bf16* QKVC = (const bf16*)(ws + WS_QKVC); const bf16* GUT = (const bf16*)(ws + WS_GUT); const bf16* GATT = (const bf16*)(ws + WS_GATT); const float* GGL = (const float*)(ws + WS_GGL); const float* GCS = (const float*)(ws + WS_GCS);
    bf16* OMIX = (bf16*)(ws + WS_OMIX); float* SSQG = (float*)(ws + WS_SSQG); const bf16* PROJ = (const bf16*)(ws + WS_PROJ);
    const int ti = wave >> 1, tjp = wave & 1, r16 = lane & 15, kq = lane >> 4, qq = (lane & 15) >> 2, pp = lane & 3;
    for (int unit = vcu; unit < NB * 16 * 2; unit += G) {
        const int half = unit & 1, hv = (unit >> 1) & 15, b = unit >> 5, hq = hv >> 1;
        const int ocol0 = hv * 128 + half * 64;
        for (int i = tid; i < 17408 / 4; i += 512) ((LAS unsigned*)(lds + GS_ST))[i] = 0u;
        f32x4 Sacc[4];
#pragma unroll
        for (int t = 0; t < 4; ++t) Sacc[t] = (f32x4){0.f, 0.f, 0.f, 0.f};
        const size_t chb = (size_t)(b * 32) * 16 + hv;
        GsTile TA, TB; GsLane L, LA, LB;
        const unsigned short* zbase = (const unsigned short*)PROJ + (size_t)(b * SEQ + 16 * ti + r16) * NPROJ + C_GZ + ocol0 + 32 * tjp + 4 * kq;
        gs_load_tile(TA, GW, QKVC, GATT, chb, b * SEQ, hq, tid); gs_load_lane(LA, GUT, GGL, GCS, chb, half, wave, lane, zbase);
        gs_load_tile(TB, GW, QKVC, GATT, chb + 16, b * SEQ + 64, hq, tid); gs_load_lane(LB, GUT, GGL, GCS, chb + 16, half, wave, lane, zbase + (size_t)64 * NPROJ);
        gs_store_tile(TA, lds + GS_BUF, tid); L = LA; launder(L);
        __syncthreads();
#pragma unroll 1
        for (int c2 = 0; c2 < 32; c2 += 2) {
#pragma unroll
          for (int hstep = 0; hstep < 2; ++hstep) {
            const int c = c2 + hstep;
            const int trow0 = b * SEQ + c * 64;
            LAS unsigned char* buf = lds + GS_BUF + hstep * GS_BUFSZ;
            int tz = tid; asm volatile("" : "+v"(tz));
            { const int cn = (c + 2 < 32) ? c + 2 : 31;
              if (hstep == 0) { gs_load_tile(TA, GW, QKVC, GATT, chb + (size_t)cn * 16, b * SEQ + cn * 64, hq, tz); gs_load_lane(LA, GUT, GGL, GCS, chb + (size_t)cn * 16, half, wave, lane, zbase + (size_t)cn * 64 * NPROJ); }
              else { gs_load_tile(TB, GW, QKVC, GATT, chb + (size_t)cn * 16, b * SEQ + cn * 64, hq, tz); gs_load_lane(LB, GUT, GGL, GCS, chb + (size_t)cn * 16, half, wave, lane, zbase + (size_t)cn * 64 * NPROJ); } }
            f32x4 ws2[2], qs[2];
            { bf16x8 aW[4], aQ[4];
#pragma unroll
              for (int ks = 0; ks < 4; ++ks) { aW[ks] = *(const LAS bf16x8*)(buf + GS_W + (16 * ti + r16) * 272 + kq * 16 + ks * 64); aQ[ks] = *(const LAS bf16x8*)(buf + GS_Q + (16 * ti + r16) * 272 + kq * 16 + ks * 64); }
#pragma unroll
              for (int t = 0; t < 2; ++t) { ws2[t] = (f32x4){0.f, 0.f, 0.f, 0.f}; qs[t] = (f32x4){0.f, 0.f, 0.f, 0.f};
                  const LAS unsigned char* sb = lds + GS_ST + (16 * (2 * tjp + t) + r16) * 272 + kq * 16;
#pragma unroll
                  for (int ks = 0; ks < 4; ++ks) { const bf16x8 bs = *(const LAS bf16x8*)(sb + ks * 64); ws2[t] = mfma16(aW[ks], bs, ws2[t]); qs[t] = mfma16(bs, aQ[ks], qs[t]); } } }
            const float lgl = L.g63, glv = __expf(L.g63);
            const f32x4 eg = {__expf(L.gc[0]), __expf(L.gc[1]), __expf(L.gc[2]), __expf(L.gc[3])};
            const f32x4 ek = {__expf(lgl - L.gc[0]), __expf(lgl - L.gc[1]), __expf(lgl - L.gc[2]), __expf(lgl - L.gc[3])};
#pragma unroll
            for (int t = 0; t < 2; ++t) { const float v0 = bflo(L.uT[t].x) - ws2[t][0], v1 = bfhi(L.uT[t].x) - ws2[t][1], v2 = bflo(L.uT[t].y) - ws2[t][2], v3 = bfhi(L.uT[t].y) - ws2[t][3];
                u32x2 w; w.x = pk2(v0, v1); w.y = pk2(v2, v3);
                *(LAS u32x2*)(lds + GS_VN + (16 * (2 * tjp + t) + r16) * 144 + (16 * ti + 4 * kq) * 2) = w;
                u32x2 w2; w2.x = pk2(v0 * ek[0], v1 * ek[1]); w2.y = pk2(v2 * ek[2], v3 * ek[3]);
                *(LAS u32x2*)(lds + GS_VN2 + (16 * (2 * tjp + t) + r16) * 144 + (16 * ti + 4 * kq) * 2) = w2; }
            __syncthreads();
            { bf16x8 aT[2];
#pragma unroll
              for (int ks = 0; ks < 2; ++ks) aT[ks] = *(const LAS bf16x8*)(buf + GS_A + (16 * ti + r16) * 144 + kq * 16 + ks * 64);
              float sq = 0.f; const float egl = __expf(L.gcl);
#pragma unroll
              for (int t = 0; t < 2; ++t) { const LAS unsigned char* vb = lds + GS_VN + (16 * (2 * tjp + t) + r16) * 144 + kq * 16;
                  f32x4 o = qs[t] * egl;
#pragma unroll
                  for (int ks = 0; ks < 2; ++ks) o = mfma16(*(const LAS bf16x8*)(vb + ks * 64), aT[ks], o);
                  sq += (o[0] * o[0] + o[1] * o[1]) + (o[2] * o[2] + o[3] * o[3]);
                  const u32x2 zz = L.z[t]; u32x2 w; w.x = pk2(o[0] * bflo(zz.x), o[1] * bfhi(zz.x)); w.y = pk2(o[2] * bflo(zz.y), o[3] * bfhi(zz.y));
                  *(u32x2*)(OMIX + (size_t)(trow0 + 16 * ti + r16) * DMIX + ocol0 + 16 * (2 * tjp + t) + 4 * kq) = w; }
              sq += __shfl_xor(sq, 16); sq += __shfl_xor(sq, 32);
              if (kq == 0) SSQG[((size_t)(trow0 + 16 * ti + r16) * 16 + hv) * 4 + half * 2 + tjp] = sq; }
            { const unsigned ka = lds_addr(buf + GS_K + (8 * kq + qq) * 272 + (16 * wave + 4 * pp) * 2);
              const bf16x8 k0 = tr_frag<0, 4 * 272>(ka), k1 = tr_frag<32 * 272, 36 * 272>(ka);
#pragma unroll
              for (int tj = 0; tj < 4; ++tj) { const LAS unsigned char* vb = lds + GS_VN2 + (16 * tj + r16) * 144 + kq * 16;
                  f32x4 sv = Sacc[tj] * glv;
                  sv = mfma16(k0, *(const LAS bf16x8*)(vb), sv); sv = mfma16(k1, *(const LAS bf16x8*)(vb + 64), sv);
                  Sacc[tj] = sv;
                  u32x2 w; w.x = pk2(sv[0], sv[1]); w.y = pk2(sv[2], sv[3]);
                  *(LAS u32x2*)(lds + GS_ST + (16 * tj + r16) * 272 + (16 * wave + 4 * kq) * 2) = w; } }
            if (hstep == 0) { gs_store_tile(TB, lds + GS_BUF + GS_BUFSZ, tz); L = LB; } else { gs_store_tile(TA, lds + GS_BUF, tz); L = LA; }
            launder(L);
            __syncthreads();
          }
        }
    }
}

constexpr int SS_C = 0, SS_B = 34816, SS_X = 69632, SS_XD = 88064, SS_PV = 106496, SS_Z = 123904, SS_SM = 142336;
template <int k>
__device__ __forceinline__ void ssd_chunk_addr(int tz, int t0, int h, int g, const bf16* XBCC, const bf16* PROJ, const bf16*& gp, int& lo) {
    if constexpr (k < 8) { const int id = tz + 512 * (k & 3), row = id >> 4, cc = id & 15; gp = XBCC + (size_t)(t0 + row) * 3072 + (k < 4 ? 2048 : 2560) + g * 128 + cc * 8; lo = (k < 4 ? SS_B : SS_C) + row * 272 + cc * 16; }
    else if constexpr (k < 10) { const int id = tz + 512 * (k - 8), row = id >> 3, cc = id & 7; gp = XBCC + (size_t)(t0 + row) * 3072 + h * 64 + cc * 8; lo = SS_X + row * 144 + cc * 16; }
    else { const int id = tz + 512 * (k - 10), row = id >> 3, cc = id & 7; gp = PROJ + (size_t)(t0 + row) * NPROJ + C_SZ + h * 64 + cc * 8; lo = SS_Z + row * 144 + cc * 16; }
}
#define SSD_FOR_K(X) X(0) X(1) X(2) X(3) X(4) X(5) X(6) X(7) X(8) X(9) X(10) X(11)
__device__ __forceinline__ void phase_ssd(const Args& a, LAS unsigned char* lds, int vcu, int G, int tid, int wave, int lane) {
    unsigned char* ws = a.ws;
    const bf16* PROJ = (const bf16*)(ws + WS_PROJ); const bf16* XBCC = (const bf16*)(ws + WS_XBCC); const float* PSM = (const float*)(ws + WS_PSM);
    bf16* YG = (bf16*)(ws + WS_OMIX) + D; float* SSQ = (float*)(ws + WS_SSQ); const f32x4* SSDT = (const f32x4*)(ws + WS_SSDT);
    LAS float* dts = (LAS float*)(lds + SS_SM); LAS float* acs = dts + 128; LAS float* dds = dts + 256;
    const int r16 = lane & 15, kq = lane >> 4, qq = (lane & 15) >> 2, pp = lane & 3;
    for (int unit = vcu; unit < NB * 32; unit += G) {
        const int h = unit & 31, b = unit >> 5, g = h >> 3;
        const float dskip = a.in[I_SD][h];
        f32x4 pacc[4];
#pragma unroll
        for (int t = 0; t < 4; ++t) pacc[t] = (f32x4){0.f, 0.f, 0.f, 0.f};
        for (int i = tid; i < 17408 / 4; i += 512) ((LAS unsigned*)(lds + SS_PV))[i] = 0u;
        u32x4 R[12]; f32x3 sc4 = {0.f, 0.f, 0.f}; float ddx0 = 0.f, ddx1 = 0.f;
        { const int t0 = b * SEQ;
#define SSD_LD(k) { const bf16* gp; int lo; ssd_chunk_addr<k>(tid, t0, h, g, XBCC, PROJ, gp, lo); R[k] = *(const u32x4*)gp; }
          SSD_FOR_K(SSD_LD)
#undef SSD_LD
          if (tid < 128) sc4 = *(const f32x3*)(SSDT + (size_t)(t0 + tid) * 32 + h);
          ddx0 = ((const float*)(SSDT + (size_t)(t0 + (tid >> 3)) * 32 + h))[2]; ddx1 = ((const float*)(SSDT + (size_t)(t0 + 64 + (tid >> 3)) * 32 + h))[2]; }
#pragma unroll 1
        for (int c = 0; c < 16; ++c) {
            const int t0 = b * SEQ + c * 128;
            int tz = tid; asm volatile("" : "+v"(tz));
#define SSD_ST(k) { const bf16* gp; int lo; ssd_chunk_addr<k>(tz, t0, h, g, XBCC, PROJ, gp, lo); *(LAS u32x4*)(lds + lo) = R[k]; }
            SSD_FOR_K(SSD_ST)
#undef SSD_ST
            if (tid < 128) { dts[tid] = sc4[0]; acs[tid] = sc4[1]; dds[tid] = sc4[2]; }
            { const float dd2[2] = {ddx0, ddx1};
#pragma unroll
              for (int k = 0; k < 2; ++k) { const int id = tz + 512 * k, row = id >> 3, cc = id & 7; const u32x4 v = R[8 + k]; const float dd = dd2[k];
                  u32x4 o; o.x = pk2(bflo(v.x) * dd, bfhi(v.x) * dd); o.y = pk2(bflo(v.y) * dd, bfhi(v.y) * dd); o.z = pk2(bflo(v.z) * dd, bfhi(v.z) * dd); o.w = pk2(bflo(v.w) * dd, bfhi(v.w) * dd);
                  *(LAS u32x4*)(lds + SS_XD + row * 144 + cc * 16) = o; } }
            __syncthreads();
            if (c + 1 < 16) { const int t1 = t0 + 128;
#define SSD_LD(k) { const bf16* gp; int lo; ssd_chunk_addr<k>(tz, t1, h, g, XBCC, PROJ, gp, lo); R[k] = *(const u32x4*)gp; }
                SSD_FOR_K(SSD_LD)
#undef SSD_LD
                if (tid < 128) sc4 = *(const f32x3*)(SSDT + (size_t)(t1 + tid) * 32 + h);
                ddx0 = ((const float*)(SSDT + (size_t)(t1 + (tid >> 3)) * 32 + h))[2]; ddx1 = ((const float*)(SSDT + (size_t)(t1 + 64 + (tid >> 3)) * 32 + h))[2]; }
            { const int w = (wave < 4) ? wave : 11 - wave;
              bf16x8 cf[4];
              { const LAS unsigned char* cbp = lds + SS_C + (16 * w + r16) * 272 + kq * 16;
#pragma unroll
                for (int ks = 0; ks < 4; ++ks) cf[ks] = *(const LAS bf16x8*)(cbp + ks * 64); }
              f32x4 yd[4], yo[4];
#pragma unroll
              for (int pj = 0; pj < 4; ++pj) { yd[pj] = (f32x4){0.f, 0.f, 0.f, 0.f}; yo[pj] = (f32x4){0.f, 0.f, 0.f, 0.f}; }
              const int lq = 16 * w + r16; const float acl = acs[lq];
#pragma unroll
              for (int q = 0; q < 4; ++q) {
                  if (2 * q <= w) {
                      float gv[8];
#pragma unroll
                      for (int s2 = 0; s2 < 2; ++s2) { const int sb = 2 * q + s2; f32x4 gt = {0.f, 0.f, 0.f, 0.f};
                          if (sb <= w) { const LAS unsigned char* abp = lds + SS_B + (16 * sb + r16) * 272 + kq * 16;
#pragma unroll
                              for (int ks = 0; ks < 4; ++ks) gt = mfma16(*(const LAS bf16x8*)(abp + ks * 64), cf[ks], gt); }
                          const f32x4 as4 = *(const LAS f32x4*)(acs + 16 * sb + 4 * kq), dt4 = *(const LAS f32x4*)(dts + 16 * sb + 4 * kq);
#pragma unroll
                          for (int r = 0; r < 4; ++r) { const int s = 16 * sb + 4 * kq + r; const float val = gt[r] * __expf(fminf(acl - as4[r], 0.f)) * dt4[r]; gv[s2 * 4 + r] = (lq >= s) ? val : 0.f; } }
                      union { bf16x8 v; unsigned u[4]; } af; af.u[0] = pk2(gv[0], gv[1]); af.u[1] = pk2(gv[2], gv[3]); af.u[2] = pk2(gv[4], gv[5]); af.u[3] = pk2(gv[6], gv[7]);
                      const unsigned xa = lds_addr(lds + SS_X + (32 * q + 4 * kq + qq) * 144 + (4 * pp) * 2);
                      bf16x8 bx[4]; tr_frag4<32, 16 * 144>(xa, bx);
#pragma unroll
                      for (int pj = 0; pj < 4; ++pj) yd[pj] = mfma16(bx[pj], af.v, yd[pj]);
                  }
              }
#pragma unroll
              for (int pj = 0; pj < 4; ++pj) { const LAS unsigned char* pb = lds + SS_PV + (16 * pj + r16) * 272 + kq * 16;
#pragma unroll
                  for (int ks = 0; ks < 4; ++ks) yo[pj] = mfma16(*(const LAS bf16x8*)(pb + ks * 64), cf[ks], yo[pj]); }
              float ssq = 0.f;
              const int lrow = 16 * w + r16; const float el = __expf(acs[lrow]);
#pragma unroll
              for (int pj = 0; pj < 4; ++pj) { const int p0 = 16 * pj + 4 * kq;
                  const u32x2 xv = *(const LAS u32x2*)(lds + SS_X + lrow * 144 + p0 * 2); LAS u32x2* zp = (LAS u32x2*)(lds + SS_Z + lrow * 144 + p0 * 2); const u32x2 zv = *zp;
                  const float y0 = yd[pj][0] + el * yo[pj][0] + dskip * bflo(xv.x), y1 = yd[pj][1] + el * yo[pj][1] + dskip * bfhi(xv.x), y2 = yd[pj][2] + el * yo[pj][2] + dskip * bflo(xv.y), y3 = yd[pj][3] + el * yo[pj][3] + dskip * bfhi(xv.y);
                  const float z0 = y0 * bflo(zv.x), z1 = y1 * bfhi(zv.x), z2 = y2 * bflo(zv.y), z3 = y3 * bfhi(zv.y);
                  ssq += (z0 * z0 + z1 * z1) + (z2 * z2 + z3 * z3);
                  u32x2 wv; wv.x = pk2(z0, z1); wv.y = pk2(z2, z3); *zp = wv; }
              ssq += __shfl_xor(ssq, 16); ssq += __shfl_xor(ssq, 32);
              if (kq == 0) SSQ[(size_t)(t0 + lrow) * 32 + h] = ssq;
              LDS_WAIT();
#pragma unroll
              for (int k = 0; k < 2; ++k) { const int id = lane + 64 * k, row = id >> 3, cc = id & 7; const u32x4 v = *(const LAS u32x4*)(lds + SS_Z + (16 * w + row) * 144 + cc * 16);
                  *(u32x4*)(YG + (size_t)(t0 + 16 * w + row) * DMIX + h * 64 + cc * 8) = v; }
              const float cdec = __expf(acs[127]);
              bf16x8 bt[4];
              tr_frag4<32 * 272, 4 * 272>(lds_addr(lds + SS_B + (8 * kq + qq) * 272 + (16 * w + 4 * pp) * 2), bt);
#pragma unroll
              for (int pj = 0; pj < 4; ++pj) { bf16x8 xf[4]; tr_frag4<32 * 144, 4 * 144>(lds_addr(lds + SS_XD + (8 * kq + qq) * 144 + (16 * pj + 4 * pp) * 2), xf);
                  f32x4 s = pacc[pj] * cdec;
#pragma unroll
                  for (int ks = 0; ks < 4; ++ks) s = mfma16(bt[ks], xf[ks], s);
                  pacc[pj] = s; }
              __syncthreads();
#pragma unroll
              for (int pj = 0; pj < 4; ++pj) { u32x2 wv; wv.x = pk2(pacc[pj][0], pacc[pj][1]); wv.y = pk2(pacc[pj][2], pacc[pj][3]);
                  *(LAS u32x2*)(lds + SS_PV + (16 * pj + r16) * 272 + (16 * w + 4 * kq) * 2) = wv; }
            }
            __syncthreads();
        }
    }
}

__device__ __forceinline__ void post_token(int m, int lane, const bf16* PROJ, const bf16* ORAW, const bf16* YG, const float* SSQ, bf16* OMIX, const float* gnw, const float* snw) {
    u32x4 ov[4], zv[4], yv[4];
#pragma unroll
    for (int q = 0; q < 4; ++q) { ov[q] = ((const u32x4*)(ORAW + (size_t)m * D))[lane + 64 * q]; zv[q] = ((const u32x4*)(PROJ + (size_t)m * NPROJ + C_GZ))[lane + 64 * q]; yv[q] = ((const u32x4*)(YG + (size_t)m * D))[lane + 64 * q]; }
    const f32x4 s0 = *(const f32x4*)(SSQ + (size_t)m * 32 + (lane >> 4) * 8), s1 = *(const f32x4*)(SSQ + (size_t)m * 32 + (lane >> 4) * 8 + 4);
    float rs = 1.0f / sqrtf(((s0[0] + s0[1]) + (s0[2] + s0[3]) + (s1[0] + s1[1]) + (s1[2] + s1[3])) * (1.0f / 512.0f) + EPS);
#pragma unroll
    for (int q = 0; q < 4; ++q) { const unsigned w4[4] = {ov[q].x, ov[q].y, ov[q].z, ov[q].w}; const unsigned z4[4] = {zv[q].x, zv[q].y, zv[q].z, zv[q].w}; float ss = 0.f;
#pragma unroll
        for (int k = 0; k < 4; ++k) ss += bflo(w4[k]) * bflo(w4[k]) + bfhi(w4[k]) * bfhi(w4[k]);
        ss += __shfl_xor(ss, 1); ss += __shfl_xor(ss, 2); ss += __shfl_xor(ss, 4); ss += __shfl_xor(ss, 8);
        const float r = 1.0f / sqrtf(ss * (1.0f / 128.0f) + EPS); const int d0 = (lane & 15) * 8; unsigned o4[4];
        const f32x4 g0 = *(const f32x4*)(gnw + d0), g1 = *(const f32x4*)(gnw + d0 + 4); const float gw8[8] = {g0[0], g0[1], g0[2], g0[3], g1[0], g1[1], g1[2], g1[3]};
#pragma unroll
        for (int k = 0; k < 4; ++k) o4[k] = pk2(bflo(w4[k]) * r * gw8[2 * k] * siluf_(bflo(z4[k])), bfhi(w4[k]) * r * gw8[2 * k + 1] * siluf_(bfhi(z4[k])));
        ((u32x4*)(OMIX + (size_t)m * DMIX))[lane + 64 * q] = (u32x4){o4[0], o4[1], o4[2], o4[3]}; }
#pragma unroll
    for (int q = 0; q < 4; ++q) { const float r = __shfl(rs, 16 * q); const unsigned w4[4] = {yv[q].x, yv[q].y, yv[q].z, yv[q].w}; const int c0 = (lane + 64 * q) * 8; unsigned o4[4];
        const f32x4 g0 = *(const f32x4*)(snw + c0), g1 = *(const f32x4*)(snw + c0 + 4); const float gw8[8] = {g0[0], g0[1], g0[2], g0[3], g1[0], g1[1], g1[2], g1[3]};
#pragma unroll
        for (int k = 0; k < 4; ++k) o4[k] = pk2(bflo(w4[k]) * r * gw8[2 * k], bfhi(w4[k]) * r * gw8[2 * k + 1]);
        ((u32x4*)(OMIX + (size_t)m * DMIX + D))[lane + 64 * q] = (u32x4){o4[0], o4[1], o4[2], o4[3]}; }
}
__device__ __forceinline__ void phase_post(const Args& a, int gw, int NGW, int lane) {
    unsigned char* ws = a.ws;
    const bf16* PROJ = (const bf16*)(ws + WS_PROJ); const bf16* ORAW = (const bf16*)(ws + WS_ORAW); const bf16* YG = (const bf16*)(ws + WS_YG); const float* SSQ = (const float*)(ws + WS_SSQ);
    bf16* OMIX = (bf16*)(ws + WS_OMIX);
    const float* gnw = a.in[I_GNORM]; const float* snw = a.in[I_SNORM];
    for (int m = gw; m < M; m += 2 * NGW) { post_token(m, lane, PROJ, ORAW, YG, SSQ, OMIX, gnw, snw); if (m + NGW < M) post_token(m + NGW, lane, PROJ, ORAW, YG, SSQ, OMIX, gnw, snw); }
}

constexpr int RT_R = 0, RT_LG = 1024, RT_HIST = 1024 + 64 * 33 * 4;
__device__ __forceinline__ void phase_router(const Args& a, LAS unsigned char* lds, unsigned* ctl, int vcu, int G, int tid, int wave, int lane) {
    unsigned char* ws = a.ws;
    const bf16* H = (const bf16*)(ws + WS_HB); const float* nw = a.in[I_FFNN]; unsigned char* U8 = ws + WS_U8;
    const bf16* WrH = (const bf16*)(ws + WS_WRT); const bf16* WrL = WrH + NE * D;
    int* TOPI = (int*)(ws + WS_TOPI); float* GATE = (float*)(ws + WS_GATE); int* TOKS = (int*)(ws + WS_TOKS); float* GSLOT = (float*)(ws + WS_GSLOT);
    LAS float* rr = (LAS float*)(lds + RT_R); LAS float* lg = (LAS float*)(lds + RT_LG); LAS unsigned* hist = (LAS unsigned*)(lds + RT_HIST);
    for (int i = vcu * 512 + tid; i < MAXSLOT; i += G * 512) { TOKS[i] = 0; GSLOT[i] = 0.f; }
    const int r16 = lane & 15, kq = lane >> 4;
    for (int blk = vcu; blk < M / 64; blk += G) {
        const int m0 = blk * 64;
        if (tid < 32) hist[tid] = 0u;
        for (int t = 0; t < 8; t += 4) { u32x2 xq[4][8];
#pragma unroll
            for (int q = 0; q < 4; ++q)
#pragma unroll
                for (int j = 0; j < 8; ++j) xq[q][j] = *(const u32x2*)(H + (size_t)(m0 + wave * 8 + t + q) * D + 4 * (lane + 64 * j));
#pragma unroll
            for (int q = 0; q < 4; ++q) { float s = 0.f;
#pragma unroll
                for (int j = 0; j < 8; ++j) { const float v0 = bflo(xq[q][j].x), v1 = bfhi(xq[q][j].x), v2 = bflo(xq[q][j].y), v3 = bfhi(xq[q][j].y); s += (v0 * v0 + v1 * v1) + (v2 * v2 + v3 * v3); }
                s = wave_sum(s); if (lane == 0) rr[wave * 8 + t + q] = 1.0f / sqrtf(s * (1.0f / D) + EPS); } }
        __syncthreads();
        { const int tb = wave >> 1, eb = wave & 1; const int tok = m0 + 16 * tb + r16; const float rt = rr[16 * tb + r16];
          const bf16* hp = H + (size_t)tok * D + 8 * kq; const float* np = nw + 8 * kq;
          const bf16* bh = WrH + (size_t)(16 * eb + r16) * D + 8 * kq; const bf16* bl = WrL + (size_t)(16 * eb + r16) * D + 8 * kq;
          f32x4 acc = {0.f, 0.f, 0.f, 0.f};
          constexpr int GK = 8;
#pragma unroll 1
          for (int k0 = 0; k0 < D / 32; k0 += GK) {
          u32x2 hq[GK][2]; f32x4 nq[GK][2]; bf16x8 whq[GK], wlq[GK];
#pragma unroll
          for (int g = 0; g < GK; ++g) { const int ks = k0 + g; hq[g][0] = *(const u32x2*)(hp + ks * 32); hq[g][1] = *(const u32x2*)(hp + ks * 32 + 4); nq[g][0] = *(const f32x4*)(np + ks * 32); nq[g][1] = *(const f32x4*)(np + ks * 32 + 4);
              whq[g] = *(const bf16x8*)(bh + ks * 32); wlq[g] = *(const bf16x8*)(bl + ks * 32); }
          __builtin_amdgcn_sched_barrier(0);
#pragma unroll
          for (int g = 0; g < GK; ++g) { const int ks = k0 + g;
              const f32x4 h0 = {bflo(hq[g][0].x), bfhi(hq[g][0].x), bflo(hq[g][0].y), bfhi(hq[g][0].y)}, h1 = {bflo(hq[g][1].x), bfhi(hq[g][1].x), bflo(hq[g][1].y), bfhi(hq[g][1].y)}; const f32x4 n0 = nq[g][0], n1 = nq[g][1];
              float v[8] = {h0[0] * n0[0], h0[1] * n0[1], h0[2] * n0[2], h0[3] * n0[3], h1[0] * n1[0], h1[1] * n1[1], h1[2] * n1[2], h1[3] * n1[3]};
              union { bf16x8 v8; unsigned u[4]; } ah, al; unsigned hb[8];
#pragma unroll
              for (int j = 0; j < 8; ++j) { v[j] *= rt; hb[j] = f2bf(v[j]); }
#pragma unroll
              for (int j = 0; j < 4; ++j) { ah.u[j] = hb[2 * j] | (hb[2 * j + 1] << 16); al.u[j] = pk2(v[2 * j] - bf2f(hb[2 * j]), v[2 * j + 1] - bf2f(hb[2 * j + 1])); }
              if (eb == 0) { int p0 = 0, p1 = 0; p0 = __builtin_amdgcn_cvt_pk_fp8_f32(v[0], v[1], p0, false); p0 = __builtin_amdgcn_cvt_pk_fp8_f32(v[2], v[3], p0, true); p1 = __builtin_amdgcn_cvt_pk_fp8_f32(v[4], v[5], p1, false); p1 = __builtin_amdgcn_cvt_pk_fp8_f32(v[6], v[7], p1, true);
                  *(u32x2*)(U8 + (size_t)tok * D + ks * 32 + 8 * kq) = (u32x2){(unsigned)p0, (unsigned)p1}; }
              const bf16x8 wh = whq[g], wl = wlq[g];
              acc = mfma16(ah.v8, wh, acc); acc = mfma16(al.v8, wh, acc); acc = mfma16(ah.v8, wl, acc);
          }
          __builtin_amdgcn_sched_barrier(0); }
          const float br = a.in[I_BR][16 * eb + r16];
#pragma unroll
          for (int r = 0; r < 4; ++r) lg[(16 * tb + 4 * kq + r) * 33 + 16 * eb + r16] = acc[r] + br; }
        __syncthreads();
        if (tid < 64) { const int m = m0 + tid; float v[32];
#pragma unroll
            for (int e = 0; e < 32; ++e) v[e] = lg[tid * 33 + e];
            int bi[4]; float bv[4];
#pragma unroll
            for (int k = 0; k < 4; ++k) { float best = -3.0e38f; int be = 0;
#pragma unroll
                for (int e = 0; e < 32; ++e) { const bool taken = (k > 0 && bi[0] == e) || (k > 1 && bi[1] == e) || (k > 2 && bi[2] == e); if (!taken && v[e] > best) { best = v[e]; be = e; } }
                bi[k] = be; bv[k] = best; }
            const float e0 = 1.0f, e1 = __expf(bv[1] - bv[0]), e2 = __expf(bv[2] - bv[0]), e3 = __expf(bv[3] - bv[0]); const float inv = 1.0f / (e0 + e1 + e2 + e3);
            *(int4*)(TOPI + (size_t)m * 4) = make_int4(bi[0], bi[1], bi[2], bi[3]);
            *(f32x4*)(GATE + (size_t)m * 4) = (f32x4){e0 * inv, e1 * inv, e2 * inv, e3 * inv};
#pragma unroll
            for (int k = 0; k < 4; ++k) __hip_atomic_fetch_add(&hist[bi[k]], 1u, __ATOMIC_RELAXED, __HIP_MEMORY_SCOPE_WORKGROUP); }
        __syncthreads();
        if (tid < 32) { const unsigned hcount = hist[tid]; if (hcount) atomicAdd(ctl + CW_CNT + tid, hcount); }
        __syncthreads();
    }
}

__device__ __forceinline__ void moe_bases(const unsigned* ctl, LAS int* base  , int tid) {
    if (tid < 64) {
        const int c = (tid < NE) ? (int)__hip_atomic_load(ctl + CW_CNT + tid, RLX_AGENT) : 0; const int p = (c + 255) & ~255; int incl = p;
#pragma unroll
        for (int d = 1; d < 32; d <<= 1) { const int v = __shfl_up(incl, d); if (tid >= d) incl += v; }
        if (tid < NE) base[tid] = incl - p;
        if (tid == NE - 1) base[NE] = incl; }
}
__device__ __forceinline__ void moe_tile_experts(const unsigned* ctl, LAS int* base, int tid) {
    LAS unsigned char* texp = (LAS unsigned char*)(base + 36);
    if (tid < MAXSLOT / 256) { int e = 0; for (int q = 1; q < NE; ++q) e += (base[q] <= tid * 256) ? 1 : 0;
        const int valid = (int)__hip_atomic_load(ctl + CW_CNT + e, RLX_AGENT) - (tid * 256 - base[e]);
        texp[tid] = (unsigned char)(e | ((valid <= 128) ? 0x80 : 0)); }
}
__device__ __forceinline__ void phase_slots(const Args& a, LAS unsigned char* lds, unsigned* ctl, int vcu, int G, int tid) {
    unsigned char* ws = a.ws;
    const int* TOPI = (const int*)(ws + WS_TOPI); const float* GATE = (const float*)(ws + WS_GATE); int* SLOT = (int*)(ws + WS_SLOT); int* TOKS = (int*)(ws + WS_TOKS); float* GSLOT = (float*)(ws + WS_GSLOT);
    LAS int* base = (LAS int*)lds; LAS unsigned* lcnt = (LAS unsigned*)(lds + 256); LAS unsigned* bbase = (LAS unsigned*)(lds + 512);
    moe_bases(ctl, base, tid);
    for (int blk = vcu; blk < M / 64; blk += G) {
        if (tid < 32) lcnt[tid] = 0u;
        __syncthreads();
        int e = 0; unsigned lr = 0;
        if (tid < 256) { e = TOPI[(size_t)blk * 256 + tid]; lr = __hip_atomic_fetch_add(&lcnt[e], 1u, __ATOMIC_RELAXED, __HIP_MEMORY_SCOPE_WORKGROUP); }
        __syncthreads();
        if (tid < 32) { const unsigned n = lcnt[tid]; bbase[tid] = n ? atomicAdd(ctl + CW_FILL + tid, n) : 0u; }
        __syncthreads();
        if (tid < 256) { const int slot = base[e] + (int)bbase[e] + (int)lr; SLOT[(size_t)blk * 256 + tid] = slot; TOKS[slot] = blk * 64 + (tid >> 2); GSLOT[slot] = GATE[(size_t)blk * 256 + tid]; }
        __syncthreads();
    }
}

template <bool GATHER_> struct MoeOrder {
    static constexpr bool GATHER = GATHER_, HALFSEL = true;
    const LAS int* base;
    int MT, nN, G, c, KB; const int* toks; const char* A; const char* Bt; size_t bexp;
    bool rowsplit = false;
    int tev;
    __device__ __forceinline__ bool decode(int i, int& mt, int& n, int& hs) const {
        hs = 0;
        if (rowsplit && (G & 7) == 0) {
            const int per = G >> 3, x = c & 7, cl = c >> 3, lo = (x * MT) >> 3, hi = ((x + 1) * MT) >> 3; const int T = (hi - lo) * nN, R = T / per, L = T - R * per; int j;
            if (i < R) j = i * per + cl;
            else if (i == R && L > 0) { if (2 * L <= per) { if (cl >= 2 * L) return false; j = R * per + (cl >> 1); hs = 1 + (cl & 1); } else { if (cl >= L) return false; j = R * per + cl; } }
            else return false;
            mt = lo + j / nN; n = j % nN; }
        else if ((G & 7) == 0 && (nN & 7) == 0) { const int npx = nN >> 3, per = G >> 3, x = c & 7, cl = c >> 3; const int T = MT * npx, R = T / per, L = T - R * per; int j;
            if (i < R) j = i * per + cl;
            else if (i == R && L > 0) {
                if (2 * L <= per) { if (cl >= 2 * L) return false; j = R * per + (cl >> 1); hs = 1 + (cl & 1); } else { if (cl >= L) return false; j = R * per + cl; } }
            else return false;
            mt = j / npx; n = x * npx + j % npx; }
        else { const long L = (long)i * G + c; if (L >= (long)MT * nN) return false; mt = (int)(L / nN); n = (int)(L % nN); }
        return true;
    }
    __device__ __forceinline__ void prime(int lane) { int mt = 0, n, hs; tev = decode(lane, mt, n, hs) ? (int)((const LAS unsigned char*)(base + 36))[mt] : 0; }
    __device__ bool next(int i, pg8::Unit& u) const {
        int mt, n, hs;
        if (i >= 64 || !decode(i, mt, n, hs)) return false;
        const int te = __builtin_amdgcn_readlane(tev, i); const int e = te & 31;
        if (te & 0x80) { if (hs == 2) return false; hs = 1; }
        u.pm = mt; u.pn = n; u.aux = e; u.hsel = hs;
        u.A = GATHER ? A : A + (size_t)mt * 256 * KB;
        u.B = Bt + (size_t)e * bexp + (size_t)n * 256 * KB;
        return true;
    }
    __device__ __forceinline__ void a_off(const pg8::Unit& u, const int (&sR)[2], const int (&sC)[2], unsigned (&v)[2][2], const LAS unsigned char* side = nullptr) const {
#pragma unroll
        for (int h = 0; h < 2; ++h)
#pragma unroll
            for (int i = 0; i < 2; ++i) { const int row = GATHER ? ((const LAS int*)side)[h * 128 + sR[i]] : (h * 128 + sR[i]); v[h][i] = (unsigned)(row * KB + sC[i] * 2); }
    }
};

__device__ __forceinline__ void combine_tokens(int m, int m2, int lane, bf16* H, const unsigned char* Y2, const int* SLOT, unsigned char* U3, const f32x4 (&w8)[8]) {
    const int4 sa = *(const int4*)(SLOT + (size_t)m * 4), sb = *(const int4*)(SLOT + (size_t)m2 * 4); const int s4[4] = {sa.x, sa.y, sa.z, sa.w}, t4[4] = {sb.x, sb.y, sb.z, sb.w};
    bf16* hr = H + (size_t)m * D; bf16* hr2 = H + (size_t)m2 * D; f32x4 v[8], v2[8]; unsigned ya[4][8], yb[4][8];
#pragma unroll
    for (int j = 0; j < 8; ++j) { v[j] = h4_ld(hr + 4 * (lane + 64 * j)); v2[j] = h4_ld(hr2 + 4 * (lane + 64 * j)); }
#pragma unroll
    for (int k = 0; k < 4; ++k) { const unsigned* yp = (const unsigned*)(Y2 + (size_t)s4[k] * D); const unsigned* yq = (const unsigned*)(Y2 + (size_t)t4[k] * D);
#pragma unroll
        for (int j = 0; j < 8; ++j) { ya[k][j] = yp[lane + 64 * j]; yb[k][j] = yq[lane + 64 * j]; } }
    float ss = 0.f, ss2 = 0.f;
#pragma unroll
    for (int k = 0; k < 4; ++k)
#pragma unroll
        for (int j = 0; j < 8; ++j) { const f32x2 lo = __builtin_amdgcn_cvt_pk_f32_fp8((int)ya[k][j], false), hi = __builtin_amdgcn_cvt_pk_f32_fp8((int)ya[k][j], true); v[j][0] += lo[0]; v[j][1] += lo[1]; v[j][2] += hi[0]; v[j][3] += hi[1];
            const f32x2 lo2 = __builtin_amdgcn_cvt_pk_f32_fp8((int)yb[k][j], false), hi2 = __builtin_amdgcn_cvt_pk_f32_fp8((int)yb[k][j], true); v2[j][0] += lo2[0]; v2[j][1] += lo2[1]; v2[j][2] += hi2[0]; v2[j][3] += hi2[1]; }
#pragma unroll
    for (int j = 0; j < 8; ++j) { h4_st(hr + 4 * (lane + 64 * j), v[j]); ss += (v[j][0] * v[j][0] + v[j][1] * v[j][1]) + (v[j][2] * v[j][2] + v[j][3] * v[j][3]);
        if (m2 != m) h4_st(hr2 + 4 * (lane + 64 * j), v2[j]); ss2 += (v2[j][0] * v2[j][0] + v2[j][1] * v2[j][1]) + (v2[j][2] * v2[j][2] + v2[j][3] * v2[j][3]); }
    const float r = 1.0f / sqrtf(wave_sum(ss) * (1.0f / D) + EPS), r2 = 1.0f / sqrtf(wave_sum(ss2) * (1.0f / D) + EPS);
    unsigned* o = (unsigned*)(U3 + (size_t)m * D); unsigned* o2 = (unsigned*)(U3 + (size_t)m2 * D);
#pragma unroll
    for (int j = 0; j < 8; ++j) { const f32x4 w = w8[j]; int p = 0; p = __builtin_amdgcn_cvt_pk_fp8_f32(v[j][0] * r * w[0], v[j][1] * r * w[1], p, false); p = __builtin_amdgcn_cvt_pk_fp8_f32(v[j][2] * r * w[2], v[j][3] * r * w[3], p, true); o[lane + 64 * j] = (unsigned)p;
        int p2 = 0; p2 = __builtin_amdgcn_cvt_pk_fp8_f32(v2[j][0] * r2 * w[0], v2[j][1] * r2 * w[1], p2, false); p2 = __builtin_amdgcn_cvt_pk_fp8_f32(v2[j][2] * r2 * w[2], v2[j][3] * r2 * w[3], p2, true); if (m2 != m) o2[lane + 64 * j] = (unsigned)p2; }
}
__device__ __forceinline__ void phase_combine(const Args& a, int gw, int NGW, int lane) {
    unsigned char* ws = a.ws;
    bf16* H = (bf16*)(ws + WS_HB); const unsigned char* Y2 = ws + WS_Y2; const int* SLOT = (const int*)(ws + WS_SLOT); unsigned char* U3 = ws + WS_U8; const float* nw = a.in[I_PLEN];
    f32x4 w8[8];
#pragma unroll
    for (int j = 0; j < 8; ++j) w8[j] = ((const f32x4*)nw)[lane + 64 * j];
    for (int m = gw; m < M; m += 2 * NGW) combine_tokens(m, (m + NGW < M) ? m + NGW : m, lane, H, Y2, SLOT, U3, w8);
}
__device__ __forceinline__ void phase_final(const Args& a, int gw, int NGW, int lane) {
    const bf16* HB = (const bf16*)(a.ws + WS_HB); float* H = a.out; const float* nw = a.in[I_FINN];
    f32x4 w8[8];
#pragma unroll
    for (int j = 0; j < 8; ++j) w8[j] = ((const f32x4*)nw)[lane + 64 * j];
    for (int m = gw; m < M; m += 2 * NGW) {
        const int m2 = (m + NGW < M) ? m + NGW : m;
        f32x4 v[8], v2[8]; float ss = 0.f, ss2 = 0.f;
#pragma unroll
        for (int j = 0; j < 8; ++j) { v[j] = h4_ld(HB + (size_t)m * D + 4 * (lane + 64 * j)); v2[j] = h4_ld(HB + (size_t)m2 * D + 4 * (lane + 64 * j)); }
#pragma unroll
        for (int j = 0; j < 8; ++j) { ss += (v[j][0] * v[j][0] + v[j][1] * v[j][1]) + (v[j][2] * v[j][2] + v[j][3] * v[j][3]); ss2 += (v2[j][0] * v2[j][0] + v2[j][1] * v2[j][1]) + (v2[j][2] * v2[j][2] + v2[j][3] * v2[j][3]); }
        const float r = 1.0f / sqrtf(wave_sum(ss) * (1.0f / D) + EPS), r2 = 1.0f / sqrtf(wave_sum(ss2) * (1.0f / D) + EPS);
        f32x4* hr = (f32x4*)(H + (size_t)m * D); f32x4* hr2 = (f32x4*)(H + (size_t)m2 * D);
#pragma unroll
        for (int j = 0; j < 8; ++j) { const f32x4 w = w8[j]; hr[lane + 64 * j] = (f32x4){v[j][0] * r * w[0], v[j][1] * r * w[1], v[j][2] * r * w[2], v[j][3] * r * w[3]};
            hr2[lane + 64 * j] = (f32x4){v2[j][0] * r2 * w[0], v2[j][1] * r2 * w[1], v2[j][2] * r2 * w[2], v2[j][3] * r2 * w[3]}; }
    }
}

constexpr int NPH = 13;
__global__ void __launch_bounds__(512, 2) mk_fwd(Args args) {
    extern __shared__ __attribute__((aligned(16))) unsigned char lds_raw[];
    LAS unsigned char* lds = (LAS unsigned char*)lds_raw;
    volatile LAS unsigned* MISC = (volatile LAS unsigned*)(lds + MISC_OFF);
    const int tid = threadIdx.x, lane = tid & 63, wave = __builtin_amdgcn_readfirstlane(tid >> 6);
    const int G = gridDim.x; const int bx = blockIdx.x; const int vcu = (G % 8 == 0) ? (bx % 8) * (G / 8) + bx / 8 : bx;
    const int gw = vcu * 8 + wave, NGW = G * 8;
    unsigned char* ws = args.ws; unsigned* ctl = (unsigned*)(ws + WS_CTL);
    for (int u = tid; u < (LDS_BYTES - MISC_OFF) / 4; u += 512) ((LAS unsigned*)(lds + MISC_OFF))[u] = 0u;
    __syncthreads();
    XcdBarrier bar; bar.bar = ctl + CW_BAR; bar.x = 0; bar.st = nullptr;
    if (MK_N_LAUNCHES == 1) bar = xcd_barrier_post(ctl + CW_BAR, MISC + 8);
    const int lo = args.ph_lo, hi = args.ph_hi;
#ifndef PHASE_MASK
#define PHASE_MASK 0xFFFF
#endif
#define IN(k) (((PHASE_MASK >> (k)) & 1) && lo <= (k) && (k) < hi)
#define SEAM(k) do { if (IN(k) && IN((k) + 1)) { if (MK_N_LAUNCHES == 1) xcd_barrier(bar); } } while (0)

#ifndef REPEAT_MASK
#define REPEAT_MASK 0
#endif
#define REP(k) ((REPEAT_MASK >> (k)) & 1)
#define PHASE(k, ...) do { if (IN(k)) { __VA_ARGS__ if (REP(k)) { if (MK_N_LAUNCHES == 1) xcd_barrier(bar); __VA_ARGS__ } } SEAM(k); } while (0)

    PHASE(0, { phase_prologue(args, lds, gw, NGW, lane, wave); });
    PHASE(1, {
        { const int cls = ((bx >> 2) & 1) * 2;
          _Pragma("unroll") for (int slot = 0; slot < 4; ++slot) {
              if (cls == slot) { tr_pool<1>(args, lds, gw, NGW, lane, wave); __syncthreads(); f8_pool(args, lds, gw, NGW, lane, wave); __syncthreads(); if (REP(17)) { f8_pool(args, lds, gw, NGW, lane, wave); __syncthreads(); } if (REP(20)) { f8_pool<true>(args, lds, gw, NGW, lane, wave); __syncthreads(); } if (REP(18)) { stream_probe_vgpr(args, gw, NGW, lane); __syncthreads(); } if (REP(19)) { stream_probe_dma(args, lds, gw, NGW, lane, wave); __syncthreads(); } }
              pg8::StaticOrder S; S.init(ws + WS_U, ws + WS_WINT, M, NPROJ, D, G, bx); S.i0 = 3 * slot; S.i1 = slot == 3 ? (1 << 30) : 3 * slot + 3;
              pg8::EpiBf16 E{(bf16*)(ws + WS_PROJ), NPROJ, C_GZ / 256, C_X / 256, C_SZ / 256, NPROJ / 256}; pg8::gemm_phase<pg8::EpiBf16, pg8::StaticOrder>(lds, D, S, E); } }
        { pg8::StaticOrder S; S.init(ws + WS_PBF, ws + WS_WPROJT, M, D, PLE, G, bx); pg8::EpiBf16 E{(bf16*)(ws + WS_PP), D}; pg8::gemm_phase<pg8::EpiBf16, pg8::StaticOrder>(lds, PLE, S, E); }
        small_gemm((const bf16*)(ws + WS_U), (const bf16*)(ws + WS_WSMT), (float*)(ws + WS_PSM), vcu, G, wave, lane);
    });
    PHASE(2, { phase_conv(args, vcu, G, tid, lane); phase_ssd_scalars(args, vcu, G, wave, lane); if (REP(15)) phase_conv(args, vcu, G, tid, lane); xcd_barrier(bar); phase_gdn_pre(args, lds, vcu, G, tid, wave, lane); if (REP(16)) { __syncthreads(); phase_gdn_pre(args, lds, vcu, G, tid, wave, lane); } });
    PHASE(3, { phase_gdn_scan(args, lds, vcu, G, tid, wave, lane); __syncthreads(); if (REP(13)) { phase_gdn_scan(args, lds, vcu, G, tid, wave, lane); __syncthreads(); } phase_ssd(args, lds, vcu, G, tid, wave, lane); if (REP(14)) { __syncthreads(); phase_ssd(args, lds, vcu, G, tid, wave, lane); } });

    PHASE(5, { pg8::StaticOrder S; S.init(ws + WS_OMIX, ws + WS_WOUTT, M, D, DMIX, G, bx); pg8::EpiResF32 E{args.in[I_X], (bf16*)(ws + WS_HB), D, (const float*)(ws + WS_SSQG), (const float*)(ws + WS_SSQ)}; pg8::gemm_phase<pg8::EpiResF32, pg8::StaticOrder>(lds, DMIX, S, E); });
    PHASE(6, { phase_router(args, lds, ctl, vcu, G, tid, wave, lane); });
    PHASE(7, { phase_slots(args, lds, ctl, vcu, G, tid); });
    PHASE(8, {
        LAS int* base = (LAS int*)(lds + MISC_OFF + 64);
        moe_bases(ctl, base, tid); __syncthreads(); moe_tile_experts(ctl, base, tid); __syncthreads();
        MoeOrder<true> S; S.base = base; S.MT = __builtin_amdgcn_readfirstlane(base[NE]) / 256; S.nN = 16; S.G = G; S.c = bx; S.KB = D; S.toks = (const int*)(ws + WS_TOKS); S.A = (const char*)(ws + WS_U8); S.Bt = (const char*)(ws + WS_W1T); S.bexp = (size_t)2 * FF * D;
        S.prime(lane); pg8::EpiMoe1 E{ws + WS_ACT, args.in[I_B1], (const int*)(ws + WS_TOKS)};
        pg8::gemm_phase<pg8::EpiMoe1, MoeOrder<true>, true, true, true>(lds, D, S, E);
    });
    PHASE(9, {
        LAS int* base = (LAS int*)(lds + MISC_OFF + 64);
        moe_bases(ctl, base, tid); __syncthreads(); moe_tile_experts(ctl, base, tid); __syncthreads();
        MoeOrder<false> S; S.base = base; S.MT = __builtin_amdgcn_readfirstlane(base[NE]) / 256; S.nN = 8; S.G = G; S.c = bx; S.KB = FF; S.toks = nullptr; S.rowsplit = true; S.A = (const char*)(ws + WS_ACT); S.Bt = (const char*)(ws + WS_W2T); S.bexp = (size_t)D * FF;
        S.prime(lane); pg8::EpiMoe2 E{ws + WS_Y2, args.in[I_B2], (const float*)(ws + WS_GSLOT)};
        pg8::gemm_phase<pg8::EpiMoe2, MoeOrder<false>, true, true, true>(lds, FF, S, E);
    });
    PHASE(10, { phase_combine(args, gw, NGW, lane); });
    PHASE(11, { pg8::StaticOrder S; S.init(ws + WS_U8, ws + WS_WGATET, M, D, D, G, bx, true); pg8::EpiGate E{(bf16*)(ws + WS_HB), (const bf16*)(ws + WS_PP)}; pg8::gemm_phase<pg8::EpiGate, pg8::StaticOrder, true, true, true>(lds, D, S, E); });
    PHASE(12, { phase_final(args, gw, NGW, lane); });
#undef PHASE
#undef REP
#undef IN
#undef SEAM
}

extern "C" void kernel_launch(void* const* d_in, const int* in_sizes, int n_in, void* d_out, int out_size, void* d_ws, size_t ws_size, hipStream_t stream) {
    static int grid = 0;
    if (grid == 0) {
        if (n_in != 26 || out_size != M * D || ws_size < WS_END) { fprintf(stderr, "kernel_launch: unexpected shapes (n_in %d out %d ws %zu)\n", n_in, out_size, ws_size); grid = -1; return; }
        int dev = 0, cus = 0, per_cu = 0;
        if (hipGetDevice(&dev) != hipSuccess || hipDeviceGetAttribute(&cus, hipDeviceAttributeMultiprocessorCount, dev) != hipSuccess) { grid = -1; return; }
        if (hipFuncSetAttribute((const void*)mk_fwd, hipFuncAttributeMaxDynamicSharedMemorySize, LDS_BYTES) != hipSuccess) { fprintf(stderr, "kernel_launch: hipFuncSetAttribute failed\n"); grid = -1; return; }
        if (hipOccupancyMaxActiveBlocksPerMultiprocessor(&per_cu, (const void*)mk_fwd, 512, LDS_BYTES) != hipSuccess || per_cu < 1) fprintf(stderr, "kernel_launch: occupancy query says %d\n", per_cu);
        (void)hipGetLastError();
        grid = cus;
    }
    if (grid < 0) return;
    (void)hipMemsetAsync((char*)d_ws + WS_CTL, 0, CTL_ZERO_BYTES, stream);
    Args a{};
    for (int i = 0; i < 26; ++i) a.in[i] = (const float*)d_in[i];
    a.out = (float*)d_out; a.ws = (unsigned char*)d_ws;
    if (MK_N_LAUNCHES == 1) { a.ph_lo = 0; a.ph_hi = NPH; hipLaunchKernelGGL(mk_fwd, dim3(grid), dim3(512), LDS_BYTES, stream, a); }
    else { for (int p = 0; p < NPH; ++p) { a.ph_lo = p; a.ph_hi = p + 1; hipLaunchKernelGGL(mk_fwd, dim3(grid), dim3(512), LDS_BYTES, stream, a); } }
}
```

```cpp
#include <hip/hip_runtime.h>
#include <cstdio>
#include <cstdint>

#ifndef MK_N_LAUNCHES
#define MK_N_LAUNCHES 1
#endif

#ifndef REPEAT_MASK
#define REPEAT_MASK 0
#endif
#define GAS __attribute__((address_space(1)))
#define LAS __attribute__((address_space(3)))
typedef unsigned short bf16;
typedef short bf16x8 __attribute__((ext_vector_type(8)));
typedef float f32x4 __attribute__((ext_vector_type(4)));
typedef float f32x3 __attribute__((ext_vector_type(3)));
typedef float f32x2 __attribute__((ext_vector_type(2)));
typedef unsigned u32x4 __attribute__((ext_vector_type(4)));
typedef unsigned u32x2 __attribute__((ext_vector_type(2)));

constexpr int M = 16384, SEQ = 2048, NB = 8, D = 2048;
constexpr int NPROJ = 11264, NSM = 64, INCOLS = 11328;
constexpr int DMIX = 4096, NE = 32, FF = 2048, PLE = 256;
constexpr int C_Q = 0, C_K = 1024, C_V = 2048, C_GZ = 4096, C_X = 6144, C_B = 8192, C_C = 8704, C_SZ = 9216;
constexpr int MAXSLOT = 73728;
constexpr float EPS = 1e-6f;

constexpr size_t MiB = 1u << 20;
constexpr size_t WS_CTL = 0, CTL_ZERO_BYTES = 1 * MiB;
constexpr size_t WS_WINT = 1 * MiB;
constexpr size_t WS_WSMT = 45 * MiB;
constexpr size_t WS_WOUTT = 46 * MiB;
constexpr size_t WS_WGATET = 62 * MiB;
constexpr size_t WS_WPROJT = 70 * MiB;
constexpr size_t WS_WRT = 71 * MiB;
constexpr size_t WS_W1T = 72 * MiB;
constexpr size_t WS_W2T = 584 * MiB;
constexpr size_t WS_U = 840 * MiB;
constexpr size_t WS_PBF = 904 * MiB;
constexpr size_t WS_PP = 912 * MiB;
constexpr size_t WS_PROJ = 976 * MiB;
constexpr size_t WS_PSM = 1328 * MiB;
constexpr size_t WS_GW = 1332 * MiB;
constexpr size_t WS_GQD = 1396 * MiB;
constexpr size_t WS_GKDT = 1460 * MiB;
constexpr size_t WS_GUT = 1524 * MiB;
constexpr size_t WS_GATT = 1588 * MiB;
constexpr size_t WS_GGL = 1620 * MiB;
constexpr size_t WS_ORAW = 1621 * MiB;
constexpr size_t WS_YG = 1685 * MiB;
constexpr size_t WS_SSQG = WS_ORAW;
constexpr size_t WS_SSQ = 1749 * MiB;
constexpr size_t WS_OMIX = 1751 * MiB;
constexpr size_t WS_TOPI = 1879 * MiB;
constexpr size_t WS_GATE = 1880 * MiB;
constexpr size_t WS_SLOT = 1881 * MiB;
constexpr size_t WS_TOKS = 1882 * MiB;
constexpr size_t WS_GSLOT = 1882 * MiB + 512 * 1024;
constexpr size_t WS_ACT = 1883 * MiB;
constexpr size_t WS_Y2 = 2171 * MiB;
constexpr size_t WS_QKVC = 2459 * MiB;
constexpr size_t WS_XBCC = 2587 * MiB;
constexpr size_t WS_GCS = 2683 * MiB;
constexpr size_t WS_U8 = 2684 * MiB;
constexpr size_t WS_HB = 2716 * MiB;
constexpr size_t WS_SSDT = 2780 * MiB;
constexpr size_t WS_END = 2788 * MiB;
constexpr int CW_TMO = 0, CW_CODE = 1;
constexpr int CW_CNT = 1024;
constexpr int CW_FILL = 1024 + 64;
constexpr int CW_BAR = 4096;

constexpr int LDS_BYTES = 163840;
constexpr int MISC_OFF = 163840 - 512;
constexpr int SCR_BYTES = MISC_OFF;

#define LDS_WAIT() asm volatile("s_waitcnt lgkmcnt(0)" ::: "memory")
#define VM_WAIT() asm volatile("s_waitcnt vmcnt(0)" ::: "memory")
#define RLX_AGENT __ATOMIC_RELAXED, __HIP_MEMORY_SCOPE_AGENT

typedef __bf16 bf16x2_t __attribute__((ext_vector_type(2)));
__device__ __forceinline__ unsigned f2bf(float f) { return (unsigned)__builtin_bit_cast(unsigned short, (__bf16)f); }
__device__ __forceinline__ unsigned pk2(float lo, float hi) { f32x2 v = {lo, hi}; return __builtin_bit_cast(unsigned, __builtin_convertvector(v, bf16x2_t)); }
__device__ __forceinline__ float bf2f(unsigned b) { return __builtin_bit_cast(float, b << 16); }
__device__ __forceinline__ float bflo(unsigned w) { return __builtin_bit_cast(float, w << 16); }
__device__ __forceinline__ float bfhi(unsigned w) { return __builtin_bit_cast(float, w & 0xffff0000u); }
__device__ __forceinline__ f32x4 h4_ld(const bf16* p) { const u32x2 w = *(const u32x2*)p; return (f32x4){bflo(w.x), bfhi(w.x), bflo(w.y), bfhi(w.y)}; }
__device__ __forceinline__ float sigmoidf_(float x) { return __builtin_amdgcn_rcpf(1.0f + __expf(-x)); }
__device__ __forceinline__ float siluf_(float x) { return x * __builtin_amdgcn_rcpf(1.0f + __expf(-x)); }
__device__ __forceinline__ float softplusf_(float x) { return fmaxf(x, 0.f) + log1pf(__expf(-fabsf(x))); }
template <int CTRL> __device__ __forceinline__ float dpp_get(float v) { return __builtin_bit_cast(float, __builtin_amdgcn_update_dpp(0, __builtin_bit_cast(int, v), CTRL, 0xF, 0xF, true)); }
__device__ __forceinline__ float sum32_all(float v) {
    v += dpp_get<0xB1>(v); v += dpp_get<0x4E>(v); v += dpp_get<0x141>(v); v += dpp_get<0x140>(v);
    v += __builtin_bit_cast(float, __builtin_amdgcn_ds_swizzle(__builtin_bit_cast(int, v), 0x401F));
    return v; }

template <int CTRL, int ROWMASK> __device__ __forceinline__ float dpp_get0(float v) { return __builtin_bit_cast(float, __builtin_amdgcn_update_dpp(0, __builtin_bit_cast(int, v), CTRL, ROWMASK, 0xF, false)); }
__device__ __forceinline__ float wave_scan_incl(float v) {
    v += dpp_get<0x111>(v); v += dpp_get<0x112>(v); v += dpp_get<0x114>(v); v += dpp_get<0x118>(v);
    v += dpp_get0<0x142, 0xA>(v); v += dpp_get0<0x143, 0xC>(v);
    return v; }
__device__ __forceinline__ float wave_sum(float v) {
    const int h = __builtin_bit_cast(int, sum32_all(v));
    return __builtin_bit_cast(float, __builtin_amdgcn_readlane(h, 0)) + __builtin_bit_cast(float, __builtin_amdgcn_readlane(h, 32));
}
__device__ __forceinline__ void h4_st(bf16* p, f32x4 v) { u32x2 w; w.x = pk2(v[0], v[1]); w.y = pk2(v[2], v[3]); *(u32x2*)p = w; }
__device__ __forceinline__ f32x4 mfma16(bf16x8 a, bf16x8 b, f32x4 c) { return __builtin_amdgcn_mfma_f32_16x16x32_bf16(a, b, c, 0, 0, 0); }

template <class T> __device__ __forceinline__ void launder(T& r) { asm volatile("" : "+v"(r)); }
template <class T, int N> __device__ __forceinline__ void launder(T (&r)[N]) {
#pragma unroll
    for (int i = 0; i < N; ++i) asm volatile("" : "+v"(r[i])); }

namespace pg8 {
constexpr int BM = 256, BK = 64, HALF = 128, HTB = HALF * BK * 2, STAGE_BYTES = 8 * HTB, NXCD = 8, WGM = 8;
__host__ __device__ __forceinline__ int lds_byte(int r, int c) { const int st = (r >> 4) * 2 + (c >> 5), rr = r & 15, cc = c & 31, ob = rr * 64 + cc * 2; return st * 1024 + (ob ^ (((ob >> 9) & 1) << 5)); }
__host__ __device__ __forceinline__ void stage_rc(int b, int& R, int& C) { const int st = b / 1024, sb = b % 1024, swz = sb ^ (((sb >> 9) & 1) << 5); R = (st >> 1) * 16 + swz / 64; C = (st & 1) * 32 + (swz % 64) / 2; }
__host__ __device__ __forceinline__ int perm32(int rho) { const int n = rho >> 4, i = rho & 15; return 8 * (i >> 2) + 4 * n + (i & 3); }

struct Unit { int pm, pn, aux, hsel; const char* A; const char* B; };

struct StaticOrder {
    static constexpr bool GATHER = false, HALFSEL = false;
    int nM, nN, nwg, G, c, KB, i0 = 0, i1 = 1 << 30; const char* A; const char* Bt;
    __device__ void init(const void* A_, const void* Bt_, int Mrows, int N, int K_, int G_, int c_, bool f8 = false) { A = (const char*)A_; Bt = (const char*)Bt_; nM = Mrows / BM; nN = N / BM; nwg = nM * nN; G = G_; c = c_; KB = f8 ? K_ : 2 * K_; }
    __device__ bool next(int i, Unit& u) const {
        i += i0; if (i >= i1) return false;
        const long L = (long)i * G + c; if (L >= nwg) return false;
        int wgid = (int)L; { const int q = nwg / NXCD, r = nwg % NXCD, xcd = wgid % NXCD, off = wgid / NXCD; wgid = (xcd < r ? xcd * (q + 1) : r * (q + 1) + (xcd - r) * q) + off; }
        const int nig = WGM * nN, gid = wgid / nig, fm = gid * WGM, gsz = (nM - fm) < WGM ? (nM - fm) : WGM;
        u.pm = fm + ((wgid % nig) % gsz); u.pn = (wgid % nig) / gsz; u.aux = 0; u.hsel = 0;
        u.A = A + (size_t)u.pm * BM * KB; u.B = Bt + (size_t)u.pn * BM * KB; return true;
    }
    __device__ __forceinline__ void a_off(const Unit&, const int (&sR)[2], const int (&sC)[2], unsigned (&v)[2][2], const LAS unsigned char* = nullptr) const {
#pragma unroll
        for (int h = 0; h < 2; ++h)
#pragma unroll
            for (int i = 0; i < 2; ++i) v[h][i] = (unsigned)((h * HALF + sR[i]) * KB + sC[i] * 2);
    }
};

typedef int v8i __attribute__((ext_vector_type(8)));
constexpr int WSCL = 0x79797979;
constexpr float WMUL = 64.0f;
__device__ __forceinline__ const GAS char* pin64(const void* q) { const unsigned long long b = (unsigned long long)q;
    return (const GAS char*)(((unsigned long long)(unsigned)__builtin_amdgcn_readfirstlane((int)(b >> 32)) << 32) | (unsigned)__builtin_amdgcn_readfirstlane((int)b)); }
template <class Epi, class Sched, bool ALIGN_EPI = true, bool SP2 = true, bool F8 = false>
__device__ __forceinline__ void gemm_phase(LAS unsigned char* lds, const int K, const Sched& S, const Epi& E) {
    int tid_ = threadIdx.x; asm volatile("" : "+v"(tid_));
    const int tid = tid_, wid = __builtin_amdgcn_readfirstlane(tid >> 6), lane = tid & 63, wr = wid >> 2, wc = wid & 3, fr = lane & 15, fq = lane >> 4;
    const int KB = F8 ? K : 2 * K;
    const int nt = KB / (BK * 2);
    int sR[2], sC[2]; unsigned voffB[2];
#pragma unroll
    for (int i = 0; i < 2; ++i) { int R, C; stage_rc(tid * 16 + i * 8192, R, C); sR[i] = R; sC[i] = C; const int Rb = Epi::PERM ? ((R & ~31) + perm32(R & 31)) : R; voffB[i] = (unsigned)(Rb * KB + C * 2); }
    const size_t kstep = (size_t)(BK * 2);
    const size_t hstepB = (size_t)HALF * KB;
    const unsigned ldsw = (unsigned)wid * 1024u;
    const int aoff = F8 ? lds_byte(wr * 64 + fr, fq * 16) : lds_byte(wr * 64 + fr, fq * 8), boff = F8 ? lds_byte(wc * 32 + fr, fq * 16) : lds_byte(wc * 32 + fr, fq * 8);
    constexpr int FR2 = F8 ? 16 : 1024;
#define PG8_SA(b, h) (((b) * 2 + (h)) * HTB)
#define PG8_SB(b, h) ((4 + (b) * 2 + (h)) * HTB)
#define PG8_STAGE(bufoff, gbase, voff) do { const GAS char* _g = pin64(gbase); _Pragma("unroll") for (int _i = 0; _i < 2; ++_i) \
        __builtin_amdgcn_global_load_lds((const GAS unsigned*)(_g + (voff)[_i]), (LAS unsigned*)(lds + (bufoff) + ldsw + _i * 8192), 16, 0, 0); } while (0)
#define PG8_LDA(dst, b, h) do { _Pragma("unroll") for (int m = 0; m < 4; ++m) { dst[m].hv[0] = *(const LAS bf16x8*)(lds + PG8_SA(b, h) + aoff + m * 2048); dst[m].hv[1] = *(const LAS bf16x8*)(lds + PG8_SA(b, h) + aoff + FR2 + m * 2048); } } while (0)
#define PG8_LDB(dst, b, h) do { _Pragma("unroll") for (int n = 0; n < 2; ++n) { dst[n].hv[0] = *(const LAS bf16x8*)(lds + PG8_SB(b, h) + boff + n * 2048); dst[n].hv[1] = *(const LAS bf16x8*)(lds + PG8_SB(b, h) + boff + FR2 + n * 2048); } } while (0)
#define PG8_MMA(ai, bj, At, Bt) do { __builtin_amdgcn_s_setprio(1); _Pragma("unroll") for (int m = 0; m < 4; ++m) _Pragma("unroll") for (int n = 0; n < 2; ++n) { \
        if constexpr (F8) { asm volatile("v_mfma_scale_f32_16x16x128_f8f6f4 %0, %1, %2, %0, %3, %4 op_sel_hi:[0,0,0]" : "+v"(acc[ai][bj][m][n]) : "v"(Bt[n].v), "v"(At[m].v), "v"(wscl), "v"(ascl)); } \
        else { _Pragma("unroll") for (int k = 0; k < 2; ++k) acc[ai][bj][m][n] = __builtin_amdgcn_mfma_f32_16x16x32_bf16(Bt[n].hv[k], At[m].hv[k], acc[ai][bj][m][n], 0, 0, 0); } } __builtin_amdgcn_s_setprio(0); } while (0)
#define PG8_WAIT_V(n) asm volatile("s_waitcnt vmcnt(" #n ")" ::: "memory")
#define PG8_WAIT_L(n) asm volatile("s_waitcnt lgkmcnt(" #n ")" ::: "memory")
#define PG8_BAR __builtin_amdgcn_s_barrier()
#define PG8_SCHED __builtin_amdgcn_sched_barrier(0)
    Unit cur, nxt; int ui = 0;
    if (!S.next(0, cur)) return;
    unsigned vA[2][2], nvA[2][2];
    constexpr int NS = Epi::NSIDE; constexpr int SIDE_OFF = 131072;
    int par = 0;
#define PG8_SIDE(u, pr) do { if constexpr (NS > 0) { if (wid < 4) { _Pragma("unroll") for (int _k = 0; _k < NS; ++_k) \
        __builtin_amdgcn_global_load_lds((const GAS unsigned*)E.side_src(u, _k, tid), (LAS unsigned*)(lds + SIDE_OFF + ((pr) * NS + _k) * 1024 + wid * 256), 4, 0, 0); } } } while (0)
    PG8_SIDE(cur, 0);
    if constexpr (NS > 0) { asm volatile("s_waitcnt vmcnt(0)" ::: "memory"); __builtin_amdgcn_s_barrier(); }
    S.a_off(cur, sR, sC, vA, lds + SIDE_OFF + 1024);
    if constexpr (Epi::RESCALE) { E.build(cur, lds, tid); if ((REPEAT_MASK >> 21) & 1) { PG8_SCHED; E.build(cur, lds, tid); } PG8_SCHED; }
    f32x4 acc[2][2][4][2];
    if constexpr (NS > 0) E.init_acc(acc, lds + SIDE_OFF, wc, fq);
    else {
#pragma unroll
    for (int a = 0; a < 2; ++a)
#pragma unroll
        for (int b = 0; b < 2; ++b)
#pragma unroll
            for (int m = 0; m < 4; ++m)
#pragma unroll
                for (int n = 0; n < 2; ++n) acc[a][b][m][n] = (f32x4){0.f, 0.f, 0.f, 0.f};
    }
    union Frag { bf16x8 hv[2]; v8i v; };
    Frag At[4], B0[2], B1[2];
    int wscl = WSCL, ascl = 0x7f7f7f7f; if constexpr (F8) { asm volatile("" : "+v"(wscl), "+v"(ascl)); }
    const char* cA = cur.A; const char* cB = cur.B;
    if constexpr (SP2) {
        PG8_STAGE(PG8_SB(0, 0), cB, voffB); PG8_STAGE(PG8_SB(0, 1), cB + hstepB, voffB); PG8_STAGE(PG8_SA(0, 0), cA, vA[0]); PG8_STAGE(PG8_SA(0, 1), cA, vA[1]);
        if (wr == 1) PG8_BAR;
        PG8_WAIT_V(2); PG8_BAR;
        PG8_STAGE(PG8_SB(1, 0), cB + kstep, voffB); PG8_STAGE(PG8_SA(1, 0), cA + kstep, vA[0]); PG8_STAGE(PG8_SB(1, 1), cB + hstepB + kstep, voffB);
        PG8_WAIT_V(6); PG8_BAR;
    } else {
        PG8_STAGE(PG8_SB(0, 0), cB, voffB); PG8_STAGE(PG8_SA(0, 0), cA, vA[0]); PG8_STAGE(PG8_SB(0, 1), cB + hstepB, voffB); PG8_STAGE(PG8_SA(0, 1), cA, vA[1]);
        if (wr == 1) PG8_BAR;
        PG8_WAIT_V(4); PG8_BAR;
        PG8_STAGE(PG8_SB(1, 0), cB + kstep, voffB); PG8_STAGE(PG8_SA(1, 0), cA + kstep, vA[0]); PG8_STAGE(PG8_SB(1, 1), cB + hstepB + kstep, voffB);
        PG8_WAIT_V(6); PG8_BAR;
    }
    for (;;) {
        const bool has_next = S.next(ui + 1, nxt);
        const char* nAp = has_next ? nxt.A : cA; const char* nBp = has_next ? nxt.B : cB;
        const int npar = (par == 2) ? 0 : par + 1;
        if (has_next) PG8_SIDE(nxt, npar);
        if constexpr (Sched::GATHER) {
#pragma unroll
            for (int h = 0; h < 2; ++h)
#pragma unroll
                for (int i = 0; i < 2; ++i) nvA[h][i] = vA[h][i];
        }
        for (int t = 0; t < nt; t += 2) {
            const bool last = (t == nt - 2);
            if constexpr (Sched::GATHER) { if (last && has_next) S.a_off(nxt, sR, sC, nvA, lds + SIDE_OFF + (npar * NS + 1) * 1024); }
            if constexpr (Epi::RESCALE) { const int it = t >> 1; if (it >= 1 && (it <= 16 || (it & 3) == 0)) { E.template rescale<false>(acc, lds, it <= 16 ? it - 1 : 15 + ((it - 16) >> 2), wr, fr); if ((REPEAT_MASK >> 22) & 1) { PG8_SCHED; E.template rescale<true>(acc, lds, it <= 16 ? it - 1 : 15 + ((it - 16) >> 2), wr, fr); } } PG8_SCHED; }
            const char* a1 = cA + (size_t)(t + 1) * kstep;
            const char* a2 = last ? nAp : cA + (size_t)(t + 2) * kstep; const char* b2 = last ? nBp : cB + (size_t)(t + 2) * kstep;
            const char* a3 = a2 + kstep; const char* b3 = b2 + kstep;
            unsigned w2[2][2];
#pragma unroll
            for (int h = 0; h < 2; ++h)
#pragma unroll
                for (int i = 0; i < 2; ++i) w2[h][i] = (Sched::GATHER && last) ? nvA[h][i] : vA[h][i];
            if constexpr (SP2) {
            PG8_LDB(B0, 0, 0); PG8_LDB(B1, 0, 1); PG8_SCHED; PG8_LDA(At, 0, 0); PG8_STAGE(PG8_SA(1, 1), a1, vA[1]);
            PG8_WAIT_V(8); PG8_WAIT_L(0); PG8_BAR; if (!Sched::HALFSEL || cur.hsel != 2) { PG8_MMA(0, 0, At, B0); PG8_MMA(0, 1, At, B1); } PG8_BAR; PG8_SCHED;
            PG8_LDA(At, 0, 1); PG8_STAGE(PG8_SB(0, 0), b2, voffB); PG8_STAGE(PG8_SB(0, 1), b2 + hstepB, voffB); PG8_STAGE(PG8_SA(0, 0), a2, w2[0]);
            PG8_WAIT_V(8); PG8_WAIT_L(0); PG8_BAR; if (!Sched::HALFSEL || cur.hsel != 1) { PG8_MMA(1, 0, At, B0); PG8_MMA(1, 1, At, B1); } PG8_BAR; PG8_SCHED;
            PG8_LDB(B0, 1, 0); PG8_LDB(B1, 1, 1); PG8_SCHED; PG8_LDA(At, 1, 0); PG8_STAGE(PG8_SA(0, 1), a2, w2[1]);
            PG8_WAIT_V(8); PG8_WAIT_L(0); PG8_BAR; if (!Sched::HALFSEL || cur.hsel != 2) { PG8_MMA(0, 0, At, B0); PG8_MMA(0, 1, At, B1); } PG8_BAR; PG8_SCHED;
            PG8_LDA(At, 1, 1); PG8_STAGE(PG8_SB(1, 0), b3, voffB); PG8_STAGE(PG8_SB(1, 1), b3 + hstepB, voffB); PG8_STAGE(PG8_SA(1, 0), a3, w2[0]);
            PG8_WAIT_V(8); PG8_WAIT_L(0); PG8_BAR; if (!Sched::HALFSEL || cur.hsel != 1) { PG8_MMA(1, 0, At, B0); PG8_MMA(1, 1, At, B1); } PG8_BAR; PG8_SCHED;
            } else {
            PG8_LDB(B0, 0, 0); PG8_SCHED; PG8_LDA(At, 0, 0); PG8_STAGE(PG8_SA(1, 1), a1, vA[1]);
            PG8_WAIT_L(8); PG8_BAR; PG8_WAIT_L(0); PG8_MMA(0, 0, At, B0); PG8_BAR; PG8_SCHED;
            PG8_LDB(B1, 0, 1); PG8_STAGE(PG8_SB(0, 0), b2, voffB);
            PG8_BAR; PG8_WAIT_L(0); PG8_MMA(0, 1, At, B1); PG8_BAR;
            PG8_LDA(At, 0, 1); PG8_STAGE(PG8_SA(0, 0), a2, w2[0]);
            PG8_BAR; PG8_WAIT_L(0); PG8_MMA(1, 0, At, B0); PG8_BAR; PG8_SCHED;
            PG8_STAGE(PG8_SB(0, 1), b2 + hstepB, voffB);
            PG8_WAIT_V(6); PG8_BAR; PG8_MMA(1, 1, At, B1); PG8_BAR;
            PG8_LDB(B0, 1, 0); PG8_SCHED; PG8_LDA(At, 1, 0); PG8_STAGE(PG8_SA(0, 1), a2, w2[1]);
            PG8_WAIT_L(8); PG8_BAR; PG8_WAIT_L(0); PG8_MMA(0, 0, At, B0); PG8_BAR; PG8_SCHED;
            PG8_LDB(B1, 1, 1); PG8_STAGE(PG8_SB(1, 0), b3, voffB);
            PG8_BAR; PG8_WAIT_L(0); PG8_MMA(0, 1, At, B1); PG8_BAR;
            PG8_LDA(At, 1, 1); PG8_STAGE(PG8_SA(1, 0), a3, w2[0]);
            PG8_BAR; PG8_WAIT_L(0); PG8_MMA(1, 0, At, B0); PG8_BAR; PG8_SCHED;
            PG8_STAGE(PG8_SB(1, 1), b3 + hstepB, voffB);
            PG8_WAIT_V(6); PG8_BAR; PG8_MMA(1, 1, At, B1); PG8_BAR;
            }
        }
        if constexpr (ALIGN_EPI) { if (wr == 0) PG8_BAR; }
        if constexpr (F8) { PG8_SCHED; asm volatile("s_nop 15\n\ts_nop 15" ::: "memory"); PG8_SCHED; }
        if constexpr (Epi::RESCALE) E(acc, cur, wr, wc, fr, fq, lds); else if constexpr (NS > 0) E(acc, cur, wr, wc, fr, fq, lds + SIDE_OFF + par * NS * 1024); else E(acc, cur, wr, wc, fr, fq);
        if (!has_next) break;
        if constexpr (Epi::RESCALE) { if (nxt.pm != cur.pm) { PG8_SCHED; PG8_BAR; E.build(nxt, lds, tid); PG8_SCHED; } }
        if constexpr (NS > 0) E.init_acc(acc, lds + SIDE_OFF + npar * NS * 1024, wc, fq);
        else {
#pragma unroll
        for (int a = 0; a < 2; ++a)
#pragma unroll
            for (int b = 0; b < 2; ++b)
#pragma unroll
                for (int m = 0; m < 4; ++m)
#pragma unroll
                    for (int n = 0; n < 2; ++n) acc[a][b][m][n] = (f32x4){0.f, 0.f, 0.f, 0.f};
        }
        cur = nxt; cA = nAp; cB = nBp; ++ui; par = npar;
        if constexpr (Sched::GATHER) {
#pragma unroll
        for (int h = 0; h < 2; ++h)
#pragma unroll
            for (int i = 0; i < 2; ++i) vA[h][i] = nvA[h][i]; }
        if constexpr (ALIGN_EPI) { if (wr == 1) PG8_BAR; }
    }
    PG8_WAIT_V(0);
    if constexpr (!ALIGN_EPI) { if (wr == 0) PG8_BAR; }
    PG8_BAR;
#undef PG8_SA
#undef PG8_SB
#undef PG8_STAGE
#undef PG8_LDA
#undef PG8_LDB
#undef PG8_MMA
#undef PG8_WAIT_V
#undef PG8_WAIT_L
#undef PG8_BAR
#undef PG8_SCHED
}

struct EpiBf16 {
    static constexpr bool PERM = true; static constexpr bool RESCALE = false; static constexpr int NSIDE = 0;
    bf16* O; int ldc; int za0 = 0, za1 = 0, zb0 = 0, zb1 = 0;
    __device__ __forceinline__ void operator()(const f32x4 (&acc)[2][2][4][2], const Unit& u, int wr, int wc, int fr, int fq) const {
        const int row0 = u.pm * BM + wr * 64 + fr, col0 = u.pn * BM + wc * 32 + 8 * fq;
        const bool sz = (u.pn >= za0 && u.pn < za1) || (u.pn >= zb0 && u.pn < zb1);
#pragma unroll
        for (int ai = 0; ai < 2; ++ai)
#pragma unroll
            for (int m = 0; m < 4; ++m) { bf16* rowp = O + (size_t)(row0 + ai * HALF + m * 16) * ldc + col0;
#pragma unroll
                for (int bj = 0; bj < 2; ++bj) { f32x4 v0 = acc[ai][bj][m][0], v1 = acc[ai][bj][m][1];
                    if (sz) { v0 = (f32x4){siluf_(v0[0]), siluf_(v0[1]), siluf_(v0[2]), siluf_(v0[3])}; v1 = (f32x4){siluf_(v1[0]), siluf_(v1[1]), siluf_(v1[2]), siluf_(v1[3])}; }
                    u32x4 w; w.x = pk2(v0[0], v0[1]); w.y = pk2(v0[2], v0[3]); w.z = pk2(v1[0], v1[1]); w.w = pk2(v1[2], v1[3]);
                    *(u32x4*)(rowp + bj * HALF) = w; } }
    }
};
struct EpiResF32 {
    static constexpr bool PERM = false; static constexpr bool RESCALE = true; static constexpr int NSIDE = 0;
    static constexpr int TAB = 131072;
    const float* base; bf16* out; int ldc; const float* SSQG; const float* SSQ;
    __device__ __forceinline__ void build(const Unit& u, LAS unsigned char* lds, int tid) const {
        if (tid < 256) {
            const int row = u.pm * BM + tid; float r[20], q[20];
            const f32x4* g4 = (const f32x4*)(SSQG + (size_t)row * 64);
#pragma unroll
            for (int hv = 0; hv < 16; ++hv) { const f32x4 v = g4[hv]; const float ms = ((v[0] + v[1]) + (v[2] + v[3])) * (1.0f / 128.0f) + EPS; q[hv] = __builtin_amdgcn_sqrtf(ms); r[hv] = __builtin_amdgcn_rsqf(ms); }
            const f32x4* s4 = (const f32x4*)(SSQ + (size_t)row * 32);
#pragma unroll
            for (int g = 0; g < 4; ++g) { const f32x4 v0 = s4[2 * g], v1 = s4[2 * g + 1]; const float ms = ((v0[0] + v0[1]) + (v0[2] + v0[3]) + (v1[0] + v1[1]) + (v1[2] + v1[3])) * (1.0f / 512.0f) + EPS; q[16 + g] = __builtin_amdgcn_sqrtf(ms); r[16 + g] = __builtin_amdgcn_rsqf(ms); }
            LAS float* tab = (LAS float*)(lds + TAB) + tid * 20;
#pragma unroll
            for (int s5 = 0; s5 < 5; ++s5) { f32x4 o;
#pragma unroll
                for (int j = 0; j < 4; ++j) { const int sg = 4 * s5 + j; o[j] = sg < 19 ? r[sg] * q[sg < 19 ? sg + 1 : 19] : r[19]; }
                *(LAS f32x4*)(tab + 4 * s5) = o; }
        }
    }
    template <bool ONES> __device__ __forceinline__ void rescale(f32x4 (&acc)[2][2][4][2], LAS unsigned char* lds, int sg, int wr, int fr) const {
        int fo = (wr * 64 + fr) * 80 + sg * 4; asm volatile("" : "+v"(fo));
        const LAS unsigned char* tab = lds + TAB + fo;
#pragma unroll
        for (int ai = 0; ai < 2; ++ai)
#pragma unroll
            for (int m = 0; m < 4; ++m) { float rho = *(const LAS float*)(tab + (ai * HALF + m * 16) * 80); if (ONES) rho = __builtin_fmaf(rho, 0.0f, 1.0f);
#pragma unroll
                for (int bj = 0; bj < 2; ++bj)
#pragma unroll
                    for (int n = 0; n < 2; ++n) acc[ai][bj][m][n] *= rho; }
    }
    __device__ __forceinline__ void operator()(const f32x4 (&acc)[2][2][4][2], const Unit& u, int wr, int wc, int fr, int fq, LAS unsigned char* lds) const {
        const int row0 = u.pm * BM + wr * 64 + fr, col0 = u.pn * BM + wc * 32 + 4 * fq;
        const LAS float* tab = (const LAS float*)(lds + TAB) + (wr * 64 + fr) * 20 + 19;
#pragma unroll
        for (int ai = 0; ai < 2; ++ai) { f32x4 xb[4][2][2]; float rho[4];
#pragma unroll
            for (int m = 0; m < 4; ++m) { const size_t off = (size_t)(row0 + ai * HALF + m * 16) * ldc + col0; rho[m] = tab[(ai * HALF + m * 16) * 20];
#pragma unroll
                for (int bj = 0; bj < 2; ++bj)
#pragma unroll
                    for (int n = 0; n < 2; ++n) xb[m][bj][n] = *(const f32x4*)(base + off + bj * HALF + n * 16); }
            __builtin_amdgcn_sched_barrier(0);
#pragma unroll
            for (int m = 0; m < 4; ++m) { const size_t off = (size_t)(row0 + ai * HALF + m * 16) * ldc + col0;
#pragma unroll
                for (int bj = 0; bj < 2; ++bj)
#pragma unroll
                    for (int n = 0; n < 2; ++n) h4_st(out + off + bj * HALF + n * 16, xb[m][bj][n] + acc[ai][bj][m][n] * rho[m]); }
            __builtin_amdgcn_sched_barrier(0); }
    }
};
struct EpiMoe1 {
    static constexpr bool PERM = true; static constexpr bool RESCALE = false; static constexpr int NSIDE = 2;
    unsigned char* ACT; const float* b1; const int* toks;
    __device__ __forceinline__ const void* side_src(const Unit& u, int k, int tid) const {
        return k == 0 ? (const void*)(b1 + (size_t)u.aux * (2 * FF) + (tid < 128 ? 0 : FF - 128) + u.pn * HALF + tid) : (const void*)(toks + u.pm * BM + tid); }
    __device__ __forceinline__ void init_acc(f32x4 (&acc)[2][2][4][2], const LAS unsigned char* side, int wc, int fq) const {
        const LAS float* bs = (const LAS float*)side + wc * 32 + 8 * fq;
#pragma unroll
        for (int n = 0; n < 2; ++n) { const f32x4 bg = *(const LAS f32x4*)(bs + 4 * n), bl = *(const LAS f32x4*)(bs + 128 + 4 * n) + 1.0f;
#pragma unroll
            for (int ai = 0; ai < 2; ++ai)
#pragma unroll
                for (int m = 0; m < 4; ++m) { acc[ai][0][m][n] = bg; acc[ai][1][m][n] = bl; } }
    }
    __device__ __forceinline__ void operator()(const f32x4 (&acc)[2][2][4][2], const Unit& u, int wr, int wc, int fr, int fq, const LAS unsigned char* side) const {
        const int row0 = u.pm * BM + wr * 64 + fr, colg = u.pn * HALF + wc * 32 + 8 * fq;
#pragma unroll
        for (int ai = 0; ai < 2; ++ai) { if (u.hsel == 2 - ai) continue;
#pragma unroll
            for (int m = 0; m < 4; ++m) { unsigned char* rowp = ACT + (size_t)(row0 + ai * HALF + m * 16) * FF + colg;
                float o[8];
#pragma unroll
                for (int n = 0; n < 2; ++n)
                {
                    const f32x4 ag = acc[ai][0][m][n], al = acc[ai][1][m][n];
#define MED3(x, lo, hi) __builtin_amdgcn_fmed3f((x), (lo), (hi))
                    const f32x4 g4 = {MED3(ag[0], -3.0e38f, 7.0f), MED3(ag[1], -3.0e38f, 7.0f), MED3(ag[2], -3.0e38f, 7.0f), MED3(ag[3], -3.0e38f, 7.0f)};
                    const f32x4 l4 = {MED3(al[0], -6.0f, 8.0f), MED3(al[1], -6.0f, 8.0f), MED3(al[2], -6.0f, 8.0f), MED3(al[3], -6.0f, 8.0f)};
#undef MED3
                    const f32x4 t4 = g4 * -2.4554669596f;
                    const f32x4 d4 = (f32x4){__builtin_amdgcn_exp2f(t4[0]), __builtin_amdgcn_exp2f(t4[1]), __builtin_amdgcn_exp2f(t4[2]), __builtin_amdgcn_exp2f(t4[3])} + 1.0f;
                    const f32x4 r4 = {__builtin_amdgcn_rcpf(d4[0]), __builtin_amdgcn_rcpf(d4[1]), __builtin_amdgcn_rcpf(d4[2]), __builtin_amdgcn_rcpf(d4[3])};
                    const f32x4 o4 = (g4 * l4) * r4;
                    o[n * 4 + 0] = o4[0]; o[n * 4 + 1] = o4[1]; o[n * 4 + 2] = o4[2]; o[n * 4 + 3] = o4[3]; }
                int p0 = 0, p1 = 0; p0 = __builtin_amdgcn_cvt_pk_fp8_f32(o[0], o[1], p0, false); p0 = __builtin_amdgcn_cvt_pk_fp8_f32(o[2], o[3], p0, true); p1 = __builtin_amdgcn_cvt_pk_fp8_f32(o[4], o[5], p1, false); p1 = __builtin_amdgcn_cvt_pk_fp8_f32(o[6], o[7], p1, true);
                *(u32x2*)rowp = (u32x2){(unsigned)p0, (unsigned)p1}; } }
    }
};
struct EpiMoe2 {
    static constexpr bool PERM = true; static constexpr bool RESCALE = false; static constexpr int NSIDE = 2;
    unsigned char* Y2; const float* b2; const float* gslot;
    __device__ __forceinline__ const void* side_src(const Unit& u, int k, int tid) const { return k == 0 ? (const void*)(b2 + (size_t)u.aux * D + u.pn * BM + tid) : (const void*)(gslot + u.pm * BM + tid); }
    __device__ __forceinline__ void init_acc(f32x4 (&acc)[2][2][4][2], const LAS unsigned char* side, int wc, int fq) const {
        const LAS float* bs = (const LAS float*)side + wc * 32 + 8 * fq;
#pragma unroll
        for (int bj = 0; bj < 2; ++bj)
#pragma unroll
            for (int n = 0; n < 2; ++n) { const f32x4 bv = *(const LAS f32x4*)(bs + bj * HALF + 4 * n);
#pragma unroll
                for (int ai = 0; ai < 2; ++ai)
#pragma unroll
                    for (int m = 0; m < 4; ++m) acc[ai][bj][m][n] = bv; }
    }
    __device__ __forceinline__ void operator()(const f32x4 (&acc)[2][2][4][2], const Unit& u, int wr, int wc, int fr, int fq, const LAS unsigned char* side) const {
        const int row0 = u.pm * BM + wr * 64 + fr, col0 = u.pn * BM + wc * 32 + 8 * fq;
        const LAS float* gs = (const LAS float*)(side + 1024) + wr * 64 + fr;
#pragma unroll
        for (int ai = 0; ai < 2; ++ai) { if (u.hsel == 2 - ai) continue;
#pragma unroll
            for (int m = 0; m < 4; ++m) { const int row = row0 + ai * HALF + m * 16; const float g = gs[ai * HALF + m * 16]; unsigned char* rowp = Y2 + (size_t)row * D + col0;
#pragma unroll
                for (int bj = 0; bj < 2; ++bj) { const f32x4 v0 = acc[ai][bj][m][0] * g, v1 = acc[ai][bj][m][1] * g;
                    int p0 = 0, p1 = 0; p0 = __builtin_amdgcn_cvt_pk_fp8_f32(v0[0], v0[1], p0, false); p0 = __builtin_amdgcn_cvt_pk_fp8_f32(v0[2], v0[3], p0, true); p1 = __builtin_amdgcn_cvt_pk_fp8_f32(v1[0], v1[1], p1, false); p1 = __builtin_amdgcn_cvt_pk_fp8_f32(v1[2], v1[3], p1, true);
                    *(u32x2*)(rowp + bj * HALF) = (u32x2){(unsigned)p0, (unsigned)p1}; } } }
    }
};
struct EpiGate {
    static constexpr bool PERM = false; static constexpr bool RESCALE = false; static constexpr int NSIDE = 0;
    bf16* H; const bf16* PP;
    __device__ __forceinline__ void operator()(const f32x4 (&acc)[2][2][4][2], const Unit& u, int wr, int wc, int fr, int fq) const {
        const int row0 = u.pm * BM + wr * 64 + fr, col0 = u.pn * BM + wc * 32 + 4 * fq;
#pragma unroll
        for (int ai = 0; ai < 2; ++ai) { u32x2 hb[4][2][2], pb[4][2][2];
#pragma unroll
            for (int m = 0; m < 4; ++m) { const size_t off = (size_t)(row0 + ai * HALF + m * 16) * D + col0;
#pragma unroll
                for (int bj = 0; bj < 2; ++bj)
#pragma unroll
                    for (int n = 0; n < 2; ++n) { const size_t o = off + bj * HALF + n * 16; hb[m][bj][n] = *(const u32x2*)(H + o); pb[m][bj][n] = *(const u32x2*)(PP + o); } }
            __builtin_amdgcn_sched_barrier(0);
#pragma unroll
            for (int m = 0; m < 4; ++m) { const size_t off = (size_t)(row0 + ai * HALF + m * 16) * D + col0;
#pragma unroll
                for (int bj = 0; bj < 2; ++bj)
#pragma unroll
                    for (int n = 0; n < 2; ++n) { const size_t o = off + bj * HALF + n * 16; const u32x2 hh = hb[m][bj][n], p = pb[m][bj][n]; const f32x4 a = acc[ai][bj][m][n];
                        f32x4 r; r[0] = bflo(hh.x) + bflo(p.x) * sigmoidf_(a[0]); r[1] = bfhi(hh.x) + bfhi(p.x) * sigmoidf_(a[1]); r[2] = bflo(hh.y) + bflo(p.y) * sigmoidf_(a[2]); r[3] = bfhi(hh.y) + bfhi(p.y) * sigmoidf_(a[3]);
                        h4_st(H + o, r); } }
            __builtin_amdgcn_sched_barrier(0); }
    }
};
}

#define XB_TMO      128
#define XB_XCNT(j)  (256  + 64 * (j))
#define XB_XSUB(j)  (1280 + 64 * (j))
#define XB_XGEN(j)  (2304 + 64 * (j))
#define XB_TOP      3328
#define XB_TOPGEN   3392
#define XCD_BAR_WORDS 3456
#define XB_SPIN_CAP (1u << 18)
__device__ __forceinline__ unsigned xb_ld(unsigned* p)              { return __hip_atomic_load(p, __ATOMIC_RELAXED, __HIP_MEMORY_SCOPE_AGENT); }
__device__ __forceinline__ unsigned xb_add(unsigned* p, unsigned v) { return __hip_atomic_fetch_add(p, v, __ATOMIC_RELAXED, __HIP_MEMORY_SCOPE_AGENT); }
__device__ __forceinline__ unsigned xb_xcc_id() { return (unsigned)__builtin_amdgcn_s_getreg((3 << 11) | 20) & 0xFu; }
#define XB_SPIN(cond, bar) do { unsigned _sp = 0; while (cond) { __builtin_amdgcn_s_sleep(1); \
    if ((++_sp & 255u) == 0u) { if (xb_ld(&(bar)[XB_TMO])) break; if (_sp > XB_SPIN_CAP) { atomicAdd(&(bar)[XB_TMO], 1u); break; } } } } while (0)
struct XcdBarrier { unsigned* bar; unsigned x; volatile LAS unsigned* st; };
__device__ __forceinline__ XcdBarrier xcd_barrier_post(unsigned* bar, volatile LAS unsigned* st) {
    XcdBarrier b; b.bar = bar; b.x = xb_xcc_id(); b.st = st;
    if (threadIdx.x == 0) (void)xb_add(&bar[XB_XCNT(b.x)], 1u);
    return b;
}
__device__ __forceinline__ void xcd_barrier_complete(unsigned* bar, unsigned x, unsigned& nloc, unsigned& nx) {
    const unsigned G = gridDim.x * gridDim.y * gridDim.z;
    unsigned sum, cnt, mine, sp = 0u;
    for (;;) {
        sum = 0u; cnt = 0u; mine = 0u;
#pragma unroll
        for (unsigned j = 0; j < 16; ++j) { const unsigned c = xb_ld(&bar[XB_XCNT(j)]); sum += c; cnt += (c > 0u) ? 1u : 0u; mine = (j == x) ? c : mine; }
        if (sum == G) break;
        __builtin_amdgcn_s_sleep(1);
        if ((++sp & 255u) == 0u) { if (xb_ld(&bar[XB_TMO])) break; if (sp > XB_SPIN_CAP) { atomicAdd(&bar[XB_TMO], 1u); break; } }
    }
    nloc = mine > 0u ? mine : 1u; nx = cnt > 0u ? cnt : 1u;
}
__device__ __forceinline__ void xcd_barrier(const XcdBarrier& b) {
    asm volatile("s_waitcnt vmcnt(0)" ::: "memory");
    __syncthreads();
    if (threadIdx.x == 0) {
        unsigned* bar = b.bar;
        __builtin_amdgcn_s_waitcnt(0);
        unsigned nloc = b.st[0], nx = b.st[1];
        if (nloc == 0u) { xcd_barrier_complete(bar, b.x, nloc, nx); b.st[0] = nloc; b.st[1] = nx; }
        const unsigned old = xb_add(&bar[XB_XSUB(b.x)], 1u);
        const unsigned gen = old / nloc;
        if (old + 1u == (gen + 1u) * nloc) {
            __builtin_amdgcn_fence(__ATOMIC_RELEASE, "agent");
            asm volatile("s_waitcnt vmcnt(0)" ::: "memory");
            const unsigned og = xb_add(&bar[XB_TOP], 1u);
            const unsigned tg = og / nx;
            if (og + 1u == (tg + 1u) * nx) xb_add(&bar[XB_TOPGEN], 1u);
            else XB_SPIN(xb_ld(&bar[XB_TOPGEN]) == tg, bar);
            __builtin_amdgcn_fence(__ATOMIC_ACQUIRE, "agent");
            xb_add(&bar[XB_XGEN(b.x)], 1u);
            asm volatile("s_waitcnt vmcnt(0)" ::: "memory");
        } else {
            XB_SPIN(xb_ld(&bar[XB_XGEN(b.x)]) == gen, bar);
            __builtin_amdgcn_fence(__ATOMIC_ACQUIRE, "agent");
            asm volatile("s_waitcnt vmcnt(0)" ::: "memory");
        }
    }
    __syncthreads();
}

struct Args { const float* in[26]; float* out; unsigned char* ws; int ph_lo, ph_hi; };
enum { I_X = 0, I_P, I_MIXN, I_WIN, I_GCONV, I_GALOG, I_GDTB, I_GNORM, I_SCONV, I_SCONVB, I_SALOG, I_SDTB, I_SD, I_SNORM, I_WOUT, I_FFNN, I_WR, I_BR, I_W1, I_B1, I_W2, I_B2, I_PLEN, I_WG, I_WP, I_FINN };

struct TrItem { const float* W; int N, k0, n0, kind, e; };
constexpr int TI_IN = (D / 64) * (INCOLS / 64), TI_OUT = (DMIX / 64) * (D / 64), TI_G = (D / 64) * (D / 64), TI_PJ = (PLE / 64) * (D / 64), TI_1 = (D / 64) * (2 * FF / 64), TI_2 = (FF / 64) * (D / 64);
constexpr int TI_NA = TI_IN + TI_PJ, TI_NB = TI_OUT + TI_G;
template <int POOL> __device__ __forceinline__ TrItem tr_decode(const Args& a, int it) {
    TrItem t; int r = it; t.e = 0;
    if constexpr (POOL == 0) {
        if (r < TI_IN) { const int nb = INCOLS / 64; t.W = a.in[I_WIN]; t.N = INCOLS; t.k0 = (r / nb) * 64; t.n0 = (r % nb) * 64; t.kind = 0; return t; } r -= TI_IN;
        { const int nb = D / 64; t.W = a.in[I_WP]; t.N = D; t.k0 = (r / nb) * 64; t.n0 = (r % nb) * 64; t.kind = 3; return t; }
    }
    r += TI_IN;
    if (r < TI_IN) { const int nb = INCOLS / 64; t.W = a.in[I_WIN]; t.N = INCOLS; t.k0 = (r / nb) * 64; t.n0 = (r % nb) * 64; t.kind = 0; return t; } r -= TI_IN;
    if (r < TI_OUT) { const int nb = D / 64; t.W = a.in[I_WOUT]; t.N = D; t.k0 = (r / nb) * 64; t.n0 = (r % nb) * 64; t.kind = 1; return t; } r -= TI_OUT;
    if (r < TI_G) { const int nb = D / 64; t.W = a.in[I_WG]; t.N = D; t.k0 = (r / nb) * 64; t.n0 = (r % nb) * 64; t.kind = 2; return t; } r -= TI_G;
    if (r < NE * TI_1) { const int e = r / TI_1, q = r % TI_1, nb = 2 * FF / 64; t.W = a.in[I_W1] + (size_t)e * D * 2 * FF; t.N = 2 * FF; t.k0 = ((q / (2 * nb)) * 2 + (q & 1)) * 64; t.n0 = ((q >> 1) % nb) * 64; t.kind = 4; t.e = e; return t; } r -= NE * TI_1;
    { const int e = r / TI_2, q = r % TI_2, nb = D / 64; t.W = a.in[I_W2] + (size_t)e * FF * D; t.N = D; t.k0 = ((q / (2 * nb)) * 2 + (q & 1)) * 64; t.n0 = ((q >> 1) % nb) * 64; t.kind = 5; t.e = e; return t; }
}
__device__ __forceinline__ void tr_load(const TrItem& t, int lane, f32x4 (&v)[16], f32x4 (&mw)[2], const float* gnw, const float* snw) {
    mw[0] = (f32x4){1.f, 1.f, 1.f, 1.f}; mw[1] = mw[0];
    if (t.kind == 1) { const int k = t.k0 + 8 * (lane & 7); const float* nwp = (k < D) ? gnw + (k & 127) : snw + (k - D); mw[0] = *(const f32x4*)nwp; mw[1] = *(const f32x4*)(nwp + 4); }
#pragma unroll
    for (int i = 0; i < 16; ++i) { const int r = i * 4 + (lane >> 4), c4 = lane & 15; v[i] = __builtin_nontemporal_load((const f32x4*)(t.W + (size_t)(t.k0 + r) * t.N + t.n0 + 4 * c4)); }
}
__device__ __forceinline__ void tr_finish(const TrItem& t, const f32x4 (&v)[16], unsigned char* ws, LAS float* scr, int lane, const f32x4 (&mw)[2]) {
#pragma unroll
    for (int i = 0; i < 16; ++i) { const int r = i * 4 + (lane >> 4), c4 = lane & 15; *(LAS f32x4*)(scr + r * 68 + 4 * c4) = v[i]; }
    LDS_WAIT();
    if (t.kind == 2 || t.kind >= 4) {
        const int c = lane & 3;
#pragma unroll
        for (int j = 0; j < 4; ++j) { const int nl = (lane >> 2) + 16 * j, n = t.n0 + nl; const LAS float* s = scr + (16 * c) * 68 + nl; int p[4];
#pragma unroll
            for (int q = 0; q < 4; ++q) { int w = 0; w = __builtin_amdgcn_cvt_pk_fp8_f32(s[(4 * q) * 68] * pg8::WMUL, s[(4 * q + 1) * 68] * pg8::WMUL, w, false); w = __builtin_amdgcn_cvt_pk_fp8_f32(s[(4 * q + 2) * 68] * pg8::WMUL, s[(4 * q + 3) * 68] * pg8::WMUL, w, true); p[q] = w; }
            unsigned char* d;
            if (t.kind == 2) d = ws + WS_WGATET + (size_t)n * D;
            else if (t.kind == 4) { const int row = (n < FF) ? ((n >> 7) * 256 + (n & 127)) : ((((n - FF) >> 7) * 256) + 128 + ((n - FF) & 127)); d = ws + WS_W1T + ((size_t)t.e * (2 * FF) + row) * D; }
            else d = ws + WS_W2T + ((size_t)t.e * D + n) * FF;
            *(u32x4*)(d + t.k0 + 16 * c) = (u32x4){(unsigned)p[0], (unsigned)p[1], (unsigned)p[2], (unsigned)p[3]}; }
    } else {
        const int c = lane & 7;
        const f32x4 m0 = mw[0], m1 = mw[1];
#pragma unroll
        for (int j = 0; j < 8; ++j) { const int nl = (lane >> 3) + 8 * j, n = t.n0 + nl; const LAS float* s = scr + (8 * c) * 68 + nl;
            u32x4 o; o.x = pk2(s[0 * 68] * m0[0], s[1 * 68] * m0[1]); o.y = pk2(s[2 * 68] * m0[2], s[3 * 68] * m0[3]); o.z = pk2(s[4 * 68] * m1[0], s[5 * 68] * m1[1]); o.w = pk2(s[6 * 68] * m1[2], s[7 * 68] * m1[3]);
            bf16* p;
            if (t.kind == 0) { bf16* WinT = (bf16*)(ws + WS_WINT); bf16* WsmT = (bf16*)(ws + WS_WSMT);
                p = (n < 6144) ? WinT + (size_t)n * D : (n < 6176) ? WsmT + (size_t)(n - 6144) * D : (n < 11296) ? WinT + (size_t)(n - 32) * D : WsmT + (size_t)(32 + n - 11296) * D; }
            else if (t.kind == 1) p = (bf16*)(ws + WS_WOUTT) + (size_t)n * DMIX;
            else p = (bf16*)(ws + WS_WPROJT) + (size_t)n * PLE;
            *(u32x4*)(p + t.k0 + 8 * c) = o; }
    }
    LDS_WAIT();
}

struct F8Item { const float* W; int N, k0, n0, kind, e; };
constexpr int FI_1 = (D / 128) * (2 * FF / 128), FI_2 = (FF / 128) * (D / 128), FI_G = (D / 128) * (D / 128), FI_N = NE * FI_1 + NE * FI_2;
__device__ __forceinline__ F8Item f8_decode(const Args& a, int it) {
    F8Item t; int r = it;
    if (r < NE * FI_1) { const int e = r / FI_1, q = r % FI_1, nb = 2 * FF / 128; t.W = a.in[I_W1] + (size_t)e * D * 2 * FF; t.N = 2 * FF; t.k0 = (q / nb) * 128; t.n0 = (q % nb) * 128; t.kind = 4; t.e = e; return t; } r -= NE * FI_1;
    if (r < NE * FI_2) { const int e = r / FI_2, q = r % FI_2, nb = D / 128; t.W = a.in[I_W2] + (size_t)e * FF * D; t.N = D; t.k0 = (q / nb) * 128; t.n0 = (q % nb) * 128; t.kind = 5; t.e = e; return t; } r -= NE * FI_2;
    { const int nb = D / 128; t.W = a.in[I_WG]; t.N = D; t.k0 = (r / nb) * 128; t.n0 = (r % nb) * 128; t.kind = 2; t.e = 0; return t; }
}
__device__ __forceinline__ const GAS char* pin_sgpr(const void* q) { const unsigned long long b = (unsigned long long)q;
    return (const GAS char*)(((unsigned long long)(unsigned)__builtin_amdgcn_readfirstlane((int)(b >> 32)) << 32) | (unsigned)__builtin_amdgcn_readfirstlane((int)b)); }
__device__ __forceinline__ void f8_load(const F8Item& t, int sub, int lane, f32x4 (&v)[16]) {
    const float* p0 = t.W + (size_t)(t.k0 + 32 * sub) * t.N + t.n0; const unsigned rs = (unsigned)t.N * 4u, v0 = (unsigned)(lane & 31) * 16u + (unsigned)(lane >> 5) * 16u * rs;
    const unsigned vo[4] = {v0, v0 + rs, v0 + 2u * rs, v0 + 3u * rs};
#pragma unroll
    for (int q = 0; q < 4; ++q) { const GAS char* p = pin_sgpr(p0 + (size_t)(4 * q) * t.N);
#pragma unroll
        for (int j = 0; j < 4; ++j) v[4 * q + j] = __builtin_nontemporal_load((const GAS f32x4*)(p + vo[j])); }
}
__device__ __forceinline__ unsigned f8_pack4(f32x4 v) { int w = 0; w = __builtin_amdgcn_cvt_pk_fp8_f32(v[0] * pg8::WMUL, v[1] * pg8::WMUL, w, false); w = __builtin_amdgcn_cvt_pk_fp8_f32(v[2] * pg8::WMUL, v[3] * pg8::WMUL, w, true); return (unsigned)w; }
__device__ __forceinline__ void f8_pack_store(const f32x4 (&v)[16], int sub, int lane, LAS unsigned char* scr) {
    asm volatile("" : "+v"(lane));
    const int c = lane & 31, ch = 2 * sub + (lane >> 5);
    LAS unsigned char* base = scr + (4 * c) * 128 + 16 * (ch ^ (c & 7));
#pragma unroll
    for (int g = 0; g < 4; ++g) {
        const unsigned A = f8_pack4(v[4 * g]), B = f8_pack4(v[4 * g + 1]), C = f8_pack4(v[4 * g + 2]), Dd = f8_pack4(v[4 * g + 3]);
        const unsigned P = __builtin_amdgcn_perm(B, A, 0x05010400u), Q = __builtin_amdgcn_perm(B, A, 0x07030602u), R = __builtin_amdgcn_perm(Dd, C, 0x05010400u), S = __builtin_amdgcn_perm(Dd, C, 0x07030602u);
        *(LAS unsigned*)(base + 4 * g) = __builtin_amdgcn_perm(R, P, 0x05040100u); *(LAS unsigned*)(base + 128 + 4 * g) = __builtin_amdgcn_perm(R, P, 0x07060302u);
        *(LAS unsigned*)(base + 256 + 4 * g) = __builtin_amdgcn_perm(S, Q, 0x05040100u); *(LAS unsigned*)(base + 384 + 4 * g) = __builtin_amdgcn_perm(S, Q, 0x07060302u); }
}
template <bool NOSTORE = false> __device__ __forceinline__ void f8_flush(const F8Item& t, unsigned char* ws, LAS unsigned char* scr, int lane) {
    asm volatile("" : "+v"(lane));
    LDS_WAIT();
    const int q = lane & 7;
#pragma unroll
    for (int i = 0; i < 16; ++i) { const int r = (lane >> 3) + 8 * i; const u32x4 v = *(const LAS u32x4*)(scr + r * 128 + 16 * (q ^ ((r >> 2) & 7))); const int n = t.n0 + r;
        unsigned char* d;
        if (t.kind == 2) d = ws + WS_WGATET + (size_t)n * D;
        else if (t.kind == 4) { const int row = (n < FF) ? ((n >> 7) * 256 + (n & 127)) : ((((n - FF) >> 7) * 256) + 128 + ((n - FF) & 127)); d = ws + WS_W1T + ((size_t)t.e * (2 * FF) + row) * D; }
        else d = ws + WS_W2T + ((size_t)t.e * D + n) * FF;
        if constexpr (!NOSTORE) *(u32x4*)(d + t.k0 + 16 * q) = v; else asm volatile("" :: "v"(v), "v"(d)); }
    LDS_WAIT();
}
template <bool NOSTORE = false> __device__ __forceinline__ void f8_pool(const Args& a, LAS unsigned char* lds, int gw, int NGW, int lane_, int wave) {
    int lane = lane_; asm volatile("" : "+v"(lane));
    unsigned char* ws = a.ws; const int cw = wave & 3; const bool storer = wave >= 4;
    LAS unsigned char* tile0 = lds + cw * 32768;
    volatile LAS unsigned* fl = (volatile LAS unsigned*)(lds + 131072 + cw * 16);
    __syncthreads();
    if (wave < 4 && lane < 2) fl[lane] = 0u;
    __syncthreads();
    const int v0 = gw - wave + cw, v1 = v0 + 4;
#define F8_ITEM(j) ((((j) & 1) ? v1 : v0) + ((j) >> 1) * NGW)
#define F8_TILE(j) (tile0 + ((j) & 1) * 16384)
    if (!storer) {
        f32x4 b0[16], b1[16], b2[16]; int j = 0;
        bool vA = F8_ITEM(0) < FI_N, vB = F8_ITEM(1) < FI_N, vC = F8_ITEM(2) < FI_N, vD;
        if (vA) { const F8Item t = f8_decode(a, F8_ITEM(0)); f8_load(t, 0, lane, b0); f8_load(t, 1, lane, b1); }
#define F8_STEP(CUR, LD, SUBC, VL, JL, SUBL, JC) do { if (VL) { const F8Item tl = f8_decode(a, F8_ITEM(JL)); f8_load(tl, SUBL, lane, LD); } f8_pack_store(CUR, SUBC, lane, F8_TILE(JC)); } while (0)
#define F8_WAITD(jj) do { if ((jj) >= 2) { while (fl[1] < (unsigned)((jj) - 1)) __builtin_amdgcn_s_sleep(4); } asm volatile("" ::: "memory"); } while (0)
#define F8_SIGF(jj) do { LDS_WAIT(); if (lane == 0) fl[0] = (unsigned)((jj) + 1); } while (0)
#pragma unroll 1
        while (vA) {
            F8_WAITD(j); F8_STEP(b0, b2, 0, true, j, 2, j); F8_STEP(b1, b0, 1, true, j, 3, j); F8_STEP(b2, b1, 2, vB, j + 1, 0, j); F8_STEP(b0, b2, 3, vB, j + 1, 1, j); F8_SIGF(j);
            if (!vB) break;
            F8_WAITD(j + 1); F8_STEP(b1, b0, 0, true, j + 1, 2, j + 1); F8_STEP(b2, b1, 1, true, j + 1, 3, j + 1); F8_STEP(b0, b2, 2, vC, j + 2, 0, j + 1); F8_STEP(b1, b0, 3, vC, j + 2, 1, j + 1); F8_SIGF(j + 1);
            if (!vC) break;
            vD = F8_ITEM(j + 3) < FI_N;
            F8_WAITD(j + 2); F8_STEP(b2, b1, 0, true, j + 2, 2, j + 2); F8_STEP(b0, b2, 1, true, j + 2, 3, j + 2); F8_STEP(b1, b0, 2, vD, j + 3, 0, j + 2); F8_STEP(b2, b1, 3, vD, j + 3, 1, j + 2); F8_SIGF(j + 2);
            j += 3; vA = vD; vB = F8_ITEM(j + 1) < FI_N; vC = F8_ITEM(j + 2) < FI_N;
        }
#undef F8_STEP
#undef F8_WAITD
#undef F8_SIGF
    } else {
#pragma unroll 1
        for (int j = 0; F8_ITEM(j) < FI_N; ++j) {
            while (fl[0] < (unsigned)(j + 1)) __builtin_amdgcn_s_sleep(4);
            asm volatile("" ::: "memory");
            f8_flush<NOSTORE>(f8_decode(a, F8_ITEM(j)), ws, F8_TILE(j), lane);
            if (lane == 0) fl[1] = (unsigned)(j + 1);
        }
    }
#undef F8_ITEM
#undef F8_TILE
}
__device__ __forceinline__ void stream_probe_vgpr(const Args& a, int gw, int NGW, int lane_) {
    int lane = lane_; asm volatile("" : "+v"(lane));
    f32x4 b0[16], b1[16], b2[16]; f32x4 acc = {0.f, 0.f, 0.f, 0.f};
#define SP_ACC(B) do { _Pragma("unroll") for (int i = 0; i < 16; ++i) acc += B[i]; } while (0)
#pragma unroll 1
    for (int it = gw; it < FI_N; it += NGW) { const F8Item t = f8_decode(a, it);
        f8_load(t, 0, lane, b0); f8_load(t, 1, lane, b1); f8_load(t, 2, lane, b2); SP_ACC(b0); f8_load(t, 3, lane, b0); SP_ACC(b1); SP_ACC(b2); SP_ACC(b0); }
#undef SP_ACC
    if (acc[0] + acc[1] + acc[2] + acc[3] == 123.456f) *(float*)(a.ws + WS_CTL + 4096) = 1.f;
}
__device__ __forceinline__ void stream_probe_dma(const Args& a, LAS unsigned char* lds, int gw, int NGW, int lane_, int wave) {
    int lane = lane_; asm volatile("" : "+v"(lane));
    LAS unsigned char* scr = lds + wave * 16384;
#pragma unroll 1
    for (int it = gw; it < FI_N; it += NGW) { const F8Item t = f8_decode(a, it);
#pragma unroll
        for (int sub = 0; sub < 4; ++sub) { const float* p0 = t.W + (size_t)(t.k0 + 32 * sub) * t.N + t.n0; const unsigned rs = (unsigned)t.N * 4u, v0 = (unsigned)(lane & 31) * 16u + (unsigned)(lane >> 5) * 16u * rs;
#pragma unroll
            for (int i = 0; i < 16; ++i) __builtin_amdgcn_global_load_lds((const unsigned*)((const char*)p0 + (size_t)i * rs + v0), (LAS unsigned*)(scr + i * 1024), 16, 0, 0);
            asm volatile("s_waitcnt vmcnt(48)" ::: "memory"); } }
    asm volatile("s_waitcnt vmcnt(0)" ::: "memory");
}
template <int POOL> __device__ __forceinline__ void tr_pool(const Args& a, LAS unsigned char* lds, int gw, int NGW, int lane_, int wave) {
    int lane = lane_; asm volatile("" : "+v"(lane));
    unsigned char* ws = a.ws; constexpr int NIT = POOL == 0 ? TI_NA : TI_NB;
    LAS float* scr = (LAS float*)(lds + wave * 17408);
    f32x4 va[16], vb[16], ma[2], mb[2]; int it = gw; const float* gnw = a.in[I_GNORM]; const float* snw = a.in[I_SNORM];
    TrItem ta, tb; if (it < NIT) { ta = tr_decode<POOL>(a, it); tr_load(ta, lane, va, ma, gnw, snw); launder(va); launder(ma); }
#pragma unroll 1
    while (it < NIT) {
        const int it1 = it + NGW, it2 = it + 2 * NGW;
        if (it1 < NIT) { tb = tr_decode<POOL>(a, it1); tr_load(tb, lane, vb, mb, gnw, snw); }
        tr_finish(ta, va, ws, scr, lane, ma);
        if (it1 >= NIT) break;
        launder(vb); launder(mb);
        if (it2 < NIT) { ta = tr_decode<POOL>(a, it2); tr_load(ta, lane, va, ma, gnw, snw); }
        tr_finish(tb, vb, ws, scr, lane, mb);
        launder(va); launder(ma);
        it = it2;
    }
}
__device__ __forceinline__ void phase_prologue(const Args& a, LAS unsigned char* lds, int gw, int NGW, int lane, int wave) {
    unsigned char* ws = a.ws;
    tr_pool<0>(a, lds, gw, NGW, lane, wave);
    { const float* x = a.in[I_X]; const float* nw = a.in[I_MIXN]; bf16* U = (bf16*)(ws + WS_U);
      f32x4 w8[8];
#pragma unroll
      for (int j = 0; j < 8; ++j) w8[j] = ((const f32x4*)nw)[lane + 64 * j];
      for (int m = gw; m < M; m += 2 * NGW) {
          const int m2 = (m + NGW < M) ? m + NGW : m;
          const f32x4* xr = (const f32x4*)(x + (size_t)m * D); const f32x4* xr2 = (const f32x4*)(x + (size_t)m2 * D); f32x4 v[8], v2[8]; float s = 0.f, s2 = 0.f;
#pragma unroll
          for (int j = 0; j < 8; ++j) { v[j] = xr[lane + 64 * j]; v2[j] = xr2[lane + 64 * j]; }
#pragma unroll
          for (int j = 0; j < 8; ++j) { s += (v[j][0] * v[j][0] + v[j][1] * v[j][1]) + (v[j][2] * v[j][2] + v[j][3] * v[j][3]); s2 += (v2[j][0] * v2[j][0] + v2[j][1] * v2[j][1]) + (v2[j][2] * v2[j][2] + v2[j][3] * v2[j][3]); }
          const float r = __builtin_amdgcn_rsqf(wave_sum(s) * (1.0f / D) + EPS), r2 = __builtin_amdgcn_rsqf(wave_sum(s2) * (1.0f / D) + EPS);
          u32x2* o = (u32x2*)(U + (size_t)m * D); u32x2* o2 = (u32x2*)(U + (size_t)m2 * D);
#pragma unroll
          for (int j = 0; j < 8; ++j) { const f32x4 w = w8[j]; u32x2 q; q.x = pk2(v[j][0] * r * w[0], v[j][1] * r * w[1]); q.y = pk2(v[j][2] * r * w[2], v[j][3] * r * w[3]); o[lane + 64 * j] = q;
              u32x2 q2; q2.x = pk2(v2[j][0] * r2 * w[0], v2[j][1] * r2 * w[1]); q2.y = pk2(v2[j][2] * r2 * w[2], v2[j][3] * r2 * w[3]); o2[lane + 64 * j] = q2; }
      } }
    { const f32x4* p = (const f32x4*)a.in[I_P]; u32x2* o = (u32x2*)(ws + WS_PBF); const int n4 = M * PLE / 4;
      const int st = NGW * 64;
      for (int i = gw * 64 + lane; i < n4; i += 4 * st) { f32x4 v[4];
#pragma unroll
          for (int q4 = 0; q4 < 4; ++q4) v[q4] = (i + q4 * st < n4) ? p[i + q4 * st] : (f32x4){0.f, 0.f, 0.f, 0.f};
#pragma unroll
          for (int q4 = 0; q4 < 4; ++q4) if (i + q4 * st < n4) { u32x2 q; q.x = pk2(v[q4][0], v[q4][1]); q.y = pk2(v[q4][2], v[q4][3]); o[i + q4 * st] = q; } } }
    { const float* wr = a.in[I_WR]; bf16* hi = (bf16*)(ws + WS_WRT); bf16* lo = hi + NE * D;
      for (int i = gw * 64 + lane; i < NE * D; i += NGW * 64) { const int e = i / D, k = i % D; const float v = wr[(size_t)k * NE + e]; const unsigned h = f2bf(v); hi[i] = (bf16)h; lo[i] = (bf16)f2bf(v - bf2f(h)); } }
}

__device__ __forceinline__ void small_gemm(const bf16* U, const bf16* WsmT, float* PSM, int vcu, int G, int wave, int lane) {
    for (int blk = vcu; blk < M / 64; blk += G) {
        const int row0 = blk * 64 + (wave >> 1) * 16, cb = (wave & 1) * 2;
        const bf16* ap = U + (size_t)(row0 + (lane & 15)) * D + 8 * (lane >> 4);
        const bf16* bp0 = WsmT + (size_t)(cb * 16 + (lane & 15)) * D + 8 * (lane >> 4);
        const bf16* bp1 = bp0 + (size_t)16 * D;
        f32x4 c0 = {0.f, 0.f, 0.f, 0.f}, c1 = {0.f, 0.f, 0.f, 0.f};
#pragma unroll 1
        for (int k0 = 0; k0 < D / 32; k0 += 8) { bf16x8 av[8], b0[8], b1[8];
#pragma unroll
            for (int g = 0; g < 8; ++g) { av[g] = *(const bf16x8*)(ap + (k0 + g) * 32); b0[g] = *(const bf16x8*)(bp0 + (k0 + g) * 32); b1[g] = *(const bf16x8*)(bp1 + (k0 + g) * 32); }
            __builtin_amdgcn_sched_barrier(0);
#pragma unroll
            for (int g = 0; g < 8; ++g) { c0 = mfma16(av[g], b0[g], c0); c1 = mfma16(av[g], b1[g], c1); }
            __builtin_amdgcn_sched_barrier(0); }
#pragma unroll
        for (int r = 0; r < 4; ++r) { float* o = PSM + (size_t)(row0 + 4 * (lane >> 4) + r) * NSM + cb * 16 + (lane & 15); o[0] = c0[r]; o[16] = c1[r]; }
    }
}

template <int OFF0, int OFF1>
__device__ __forceinline__ bf16x8 tr_frag(unsigned addr) {
    union { bf16x8 v; u32x2 h[2]; } r;
    asm volatile("ds_read_b64_tr_b16 %0, %2 offset:%3\n\tds_read_b64_tr_b16 %1, %2 offset:%4\n\ts_waitcnt lgkmcnt(0)" : "=&v"(r.h[0]), "=&v"(r.h[1]) : "v"(addr), "i"(OFF0), "i"(OFF1) : "memory");
    return r.v;
}
template <int KS_STRIDE, int T_STRIDE>
__device__ __forceinline__ void tr_frag4(unsigned addr, bf16x8 (&f)[4]) {
    union { bf16x8 v; u32x2 h[2]; } r[4];
    asm volatile("ds_read_b64_tr_b16 %0, %8 offset:%9\n\tds_read_b64_tr_b16 %1, %8 offset:%10\n\tds_read_b64_tr_b16 %2, %8 offset:%11\n\tds_read_b64_tr_b16 %3, %8 offset:%12\n\t"
                 "ds_read_b64_tr_b16 %4, %8 offset:%13\n\tds_read_b64_tr_b16 %5, %8 offset:%14\n\tds_read_b64_tr_b16 %6, %8 offset:%15\n\tds_read_b64_tr_b16 %7, %8 offset:%16\n\ts_waitcnt lgkmcnt(0)"
                 : "=&v"(r[0].h[0]), "=&v"(r[0].h[1]), "=&v"(r[1].h[0]), "=&v"(r[1].h[1]), "=&v"(r[2].h[0]), "=&v"(r[2].h[1]), "=&v"(r[3].h[0]), "=&v"(r[3].h[1])
                 : "v"(addr), "i"(0), "i"(T_STRIDE), "i"(KS_STRIDE), "i"(KS_STRIDE + T_STRIDE), "i"(2 * KS_STRIDE), "i"(2 * KS_STRIDE + T_STRIDE), "i"(3 * KS_STRIDE), "i"(3 * KS_STRIDE + T_STRIDE) : "memory");
#pragma unroll
    for (int i = 0; i < 4; ++i) f[i] = r[i].v;
}
template <int O0, int O1, int O2, int O3>
__device__ __forceinline__ void tr_frag2(unsigned addr, bf16x8& f0, bf16x8& f1) {
    union { bf16x8 v; u32x2 h[2]; } r0, r1;
    asm volatile("ds_read_b64_tr_b16 %0, %4 offset:%5\n\tds_read_b64_tr_b16 %1, %4 offset:%6\n\tds_read_b64_tr_b16 %2, %4 offset:%7\n\tds_read_b64_tr_b16 %3, %4 offset:%8\n\ts_waitcnt lgkmcnt(0)"
                 : "=&v"(r0.h[0]), "=&v"(r0.h[1]), "=&v"(r1.h[0]), "=&v"(r1.h[1]) : "v"(addr), "i"(O0), "i"(O1), "i"(O2), "i"(O3) : "memory");
    f0 = r0.v; f1 = r1.v;
}
__device__ __forceinline__ unsigned lds_addr(const LAS unsigned char* p) { return (unsigned)(uintptr_t)p; }


struct ConvItem { const bf16* src; bf16* outp; const float* cw; const float* biasp; int wcol, cwN, ldo, t0; bool first, active; float qsc; int kb; };
__device__ __forceinline__ ConvItem conv_item(const Args& a, int item, int tid) {
    unsigned char* ws = a.ws; ConvItem c;
    const bf16* PROJ = (const bf16*)(ws + WS_PROJ); bf16* QKVC = (bf16*)(ws + WS_QKVC); bf16* XBCC = (bf16*)(ws + WS_XBCC);
    const int kb = ((item & 3) + (item >> 9)) & 3  , strip = item >> 2; c.kb = kb; c.t0 = strip * 32; c.first = (c.t0 % SEQ) == 0; c.active = !(kb == 3 && tid >= 256); int pcol; c.biasp = nullptr;
    if (kb < 2) { pcol = kb * 2048 + 4 * tid; c.wcol = pcol; c.cw = a.in[I_GCONV]; c.cwN = 4096; c.outp = QKVC + pcol; c.ldo = 4096; }
    else if (kb == 2) { pcol = C_X + 4 * tid; c.wcol = 4 * tid; c.cw = a.in[I_SCONV]; c.cwN = 3072; c.outp = XBCC + c.wcol; c.ldo = 3072; c.biasp = a.in[I_SCONVB] + c.wcol; }
    else { pcol = C_B + 4 * (tid & 255); c.wcol = 2048 + 4 * (tid & 255); c.cw = a.in[I_SCONV]; c.cwN = 3072; c.outp = XBCC + c.wcol; c.ldo = 3072; c.biasp = a.in[I_SCONVB] + c.wcol; }
    c.src = PROJ + (size_t)c.t0 * NPROJ + pcol; c.qsc = (kb == 0) ? ((tid < 256) ? 0.08838834764831845f : 1.0f) : 0.f;
    return c;
}
__device__ __forceinline__ void conv_loadw(const ConvItem& c, f32x4 (&cwb)[5]) {
#pragma unroll
    for (int k = 0; k < 5; ++k) cwb[k] = (f32x4){0.f, 0.f, 0.f, 0.f};
    if (c.active) {
#pragma unroll
        for (int k = 0; k < 4; ++k) cwb[k] = *(const f32x4*)(c.cw + k * c.cwN + c.wcol);
        if (c.biasp) cwb[4] = *(const f32x4*)c.biasp; }
}
__device__ __forceinline__ void conv_load(const ConvItem& c, u32x2 (&raw)[35]) {
#pragma unroll
    for (int r = 0; r < 35; ++r) { raw[r] = (u32x2){0u, 0u}; if (c.active && !(c.first && r < 3)) raw[r] = *(const u32x2*)(c.src + (long)(r - 3) * NPROJ); }
}
__device__ __forceinline__ void conv_compute(const ConvItem& c, const u32x2 (&raw)[35], const f32x4 (&cwb)[5]) {
    if (!c.active) return;
    const f32x4 w0 = cwb[0], w1 = cwb[1], w2 = cwb[2], w3 = cwb[3], bb = cwb[4];
    f32x4 xa = {bflo(raw[0].x), bfhi(raw[0].x), bflo(raw[0].y), bfhi(raw[0].y)}, xb = {bflo(raw[1].x), bfhi(raw[1].x), bflo(raw[1].y), bfhi(raw[1].y)}, xc = {bflo(raw[2].x), bfhi(raw[2].x), bflo(raw[2].y), bfhi(raw[2].y)};
#pragma unroll
    for (int r = 3; r < 35; ++r) { const f32x4 xd = {bflo(raw[r].x), bfhi(raw[r].x), bflo(raw[r].y), bfhi(raw[r].y)};
        f32x4 o = w0 * xa + w1 * xb + w2 * xc + w3 * xd + bb; xa = xb; xb = xc; xc = xd;
        o = (f32x4){siluf_(o[0]), siluf_(o[1]), siluf_(o[2]), siluf_(o[3])};
        if (c.kb == 0) { float ss = (o[0] * o[0] + o[1] * o[1]) + (o[2] * o[2] + o[3] * o[3]);
            ss = sum32_all(ss);
            const float rn = c.qsc * __builtin_amdgcn_rsqf(ss + EPS); o = o * rn; }
        u32x2 q; q.x = pk2(o[0], o[1]); q.y = pk2(o[2], o[3]); *(u32x2*)(c.outp + (size_t)(c.t0 + r - 3) * c.ldo) = q; }
}
__device__ __forceinline__ void phase_conv(const Args& a, int vcu, int G, int tid, int lane) {
    constexpr int NIT = 512 * 4;
    u32x2 ra[35], rb[35]; f32x4 w[5]; int item = vcu, kbw = -1;
    ConvItem ca, cb; if (item < NIT) { ca = conv_item(a, item, tid); conv_load(ca, ra); conv_loadw(ca, w); kbw = ca.kb; launder(ra); launder(w); }
#pragma unroll 1
    while (item < NIT) {
        const int i1 = item + G, i2 = item + 2 * G;
        if (i1 < NIT) { cb = conv_item(a, i1, tid); conv_load(cb, rb); }
        conv_compute(ca, ra, w);
        if (i1 >= NIT) break;
        if (cb.kb != kbw) { conv_loadw(cb, w); kbw = cb.kb; }
        launder(rb); launder(w);
        if (i2 < NIT) { ca = conv_item(a, i2, tid); conv_load(ca, ra); }
        conv_compute(cb, rb, w);
        if (i2 < NIT && ca.kb != kbw) { conv_loadw(ca, w); kbw = ca.kb; }
        launder(ra); launder(w);
        item = i2;
    }
}

__device__ __forceinline__ void phase_ssd_scalars(const Args& a, int vcu, int G, int wave, int lane) {
    unsigned char* ws = a.ws; const float* PSM = (const float*)(ws + WS_PSM); f32x4* SSDT = (f32x4*)(ws + WS_SSDT);
    for (int job = vcu; job < NB * 16 * 2; job += G) { const int t0 = (job >> 1) * 128, hhalf = job & 1;
#pragma unroll
        for (int hh = 0; hh < 2; ++hh) { const int h = 16 * hhalf + 2 * wave + hh; const float dtb = a.in[I_SDTB][h], ea = -__expf(a.in[I_SALOG][h]);
            const float d0 = softplusf_(PSM[(size_t)(t0 + 2 * lane) * NSM + 32 + h] + dtb), d1 = softplusf_(PSM[(size_t)(t0 + 2 * lane + 1) * NSM + 32 + h] + dtb);
            const float a0 = ea * d0, a1 = ea * d1; float sc = a0 + a1;
            sc = wave_scan_incl(sc);
            const float alast = __builtin_bit_cast(float, __builtin_amdgcn_readlane(__builtin_bit_cast(int, sc), 63));
            SSDT[(size_t)(t0 + 2 * lane) * 32 + h] = (f32x4){d0, sc - a1, d0 * __expf(alast - (sc - a1)), 0.f};
            SSDT[(size_t)(t0 + 2 * lane + 1) * 32 + h] = (f32x4){d1, sc, d1 * __expf(alast - sc), 0.f}; } }
}

constexpr int G2_QL = 0, G2_KL = 17408, G2_VL = 34816, G2_MX = 69632, G2_LD = 143360, G2_SM = 153600;
template <class Epi>
__device__ __forceinline__ void mm64(const LAS unsigned char* Aimg, const LAS unsigned char* Bimg, int rb, int lane, Epi epi) {
    const int r16 = lane & 15, kq = lane >> 4, qq = (lane & 15) >> 2, pp = lane & 3;
    bf16x8 af[2];
#pragma unroll
    for (int ks = 0; ks < 2; ++ks) af[ks] = *(const LAS bf16x8*)(Aimg + (16 * rb + r16) * 144 + kq * 16 + ks * 64);
    const unsigned ba = lds_addr(Bimg + (8 * kq + qq) * 144 + (4 * pp) * 2);
#pragma unroll
    for (int cbk = 0; cbk < 4; ++cbk) {
        bf16x8 b0, b1;
        if (cbk == 0) tr_frag2<0, 576, 4608, 4608 + 576>(ba, b0, b1); else if (cbk == 1) tr_frag2<32, 32 + 576, 4608 + 32, 4608 + 32 + 576>(ba, b0, b1);
        else if (cbk == 2) tr_frag2<64, 64 + 576, 4608 + 64, 4608 + 64 + 576>(ba, b0, b1); else tr_frag2<96, 96 + 576, 4608 + 96, 4608 + 96 + 576>(ba, b0, b1);
        f32x4 c = {0.f, 0.f, 0.f, 0.f}; c = mfma16(b0, af[0], c); c = mfma16(b1, af[1], c);
        epi(16 * rb + r16, 16 * cbk + 4 * kq, c);
    }
}
__device__ __forceinline__ void st4bf(LAS unsigned char* img, int r, int c0, f32x4 v) { u32x2 w; w.x = pk2(v[0], v[1]); w.y = pk2(v[2], v[3]); *(LAS u32x2*)(img + r * 144 + c0 * 2) = w; }

template <int k> __device__ __forceinline__ void g2_addr(int tz, int t0, int hq, const bf16* QKVC, const bf16*& gp, int& lo) {
    if constexpr (k < 4) { const int id = tz + 512 * (k & 1), row = id >> 4, cc = id & 15; gp = QKVC + (size_t)(t0 + row) * 4096 + (k < 2 ? 0 : 1024) + hq * 128 + cc * 8; lo = (k < 2 ? G2_QL : G2_KL) + row * 272 + cc * 16; }
    else { const int id = tz + 512 * (k - 4), row = id >> 5, cc = id & 31; gp = QKVC + (size_t)(t0 + row) * 4096 + 2048 + hq * 256 + cc * 8; lo = G2_VL + (cc >> 4) * 17408 + row * 272 + (cc & 15) * 16; }
}
#define G2_FOR_K(X) X(0) X(1) X(2) X(3) X(4) X(5) X(6) X(7)
__device__ __forceinline__ void phase_gdn_pre(const Args& a, LAS unsigned char* lds, int vcu, int G, int tid, int wave, int lane) {
    unsigned char* ws = a.ws;
    const bf16* QKVC = (const bf16*)(ws + WS_QKVC); const float* PSM = (const float*)(ws + WS_PSM);
    bf16* GW = (bf16*)(ws + WS_GW); bf16* GUT = (bf16*)(ws + WS_GUT); bf16* GATT = (bf16*)(ws + WS_GATT); float* GGL = (float*)(ws + WS_GGL); float* GCS = (float*)(ws + WS_GCS);
    LAS float* sm = (LAS float*)(lds + G2_SM); LAS float* gcs = sm; LAS float* beta = sm + 128;
    const int r16 = lane & 15, kq = lane >> 4, qq = (lane & 15) >> 2, pp = lane & 3;
    u32x4 R[8]; float araw = 0.f, braw = 0.f, galog = 0.f, gdtb = 0.f;
    { const int unit = vcu; if (unit < NB * 32 * 8) { const int hq = unit & 7, c = (unit >> 3) & 31, b = unit >> 8, t0 = b * SEQ + c * 64;
#define G2_LD(k) { const bf16* gp; int lo; g2_addr<k>(tid, t0, hq, QKVC, gp, lo); R[k] = *(const u32x4*)gp; }
        G2_FOR_K(G2_LD)
        if (tid >= 128 && tid < 256) { const int e = (tid - 128) >> 6, hv = 2 * hq + e; araw = PSM[(size_t)(t0 + lane) * NSM + 16 + hv]; braw = PSM[(size_t)(t0 + lane) * NSM + hv]; galog = a.in[I_GALOG][hv]; gdtb = a.in[I_GDTB][hv]; } } }
    for (int unit = vcu; unit < NB * 32 * 8; unit += G) {
        const int hq = unit & 7, c = (unit >> 3) & 31, b = unit >> 8;
        const int t0 = b * SEQ + c * 64;
        const size_t chb = (size_t)(b * 32 + c) * 16 + 2 * hq;
        { int tz = tid; asm volatile("" : "+v"(tz));
#define G2_ST(k) { const bf16* gp; int lo; g2_addr<k>(tz, t0, hq, QKVC, gp, lo); *(LAS u32x4*)(lds + lo) = R[k]; }
          G2_FOR_K(G2_ST)
#undef G2_ST
        }
        if (tid >= 128 && tid < 256) { const int e = (tid - 128) >> 6, hv = 2 * hq + e;
            float g = -__expf(galog) * softplusf_(araw + gdtb);
            g = wave_scan_incl(g);
            gcs[e * 64 + lane] = g; beta[e * 64 + lane] = sigmoidf_(braw); GCS[(chb + e) * 64 + lane] = g; if (lane == 63) GGL[chb + e] = __expf(g); }
        for (int i = tid; i < 2 * 2304; i += 512) { const int e = i / 2304, o = i % 2304; ((LAS unsigned*)(lds + G2_MX + e * 36864 + 9216))[o] = 0u; }
        __syncthreads();
        { const int un = unit + G; if (un < NB * 32 * 8) { const int hq2 = un & 7, c2 = (un >> 3) & 31, b2 = un >> 8, t2 = b2 * SEQ + c2 * 64; int tz = tid; asm volatile("" : "+v"(tz));
#define G2_LD2(k) { const bf16* gp; int lo; g2_addr<k>(tz, t2, hq2, QKVC, gp, lo); R[k] = *(const u32x4*)gp; }
            G2_FOR_K(G2_LD2)
#undef G2_LD2
            if (tid >= 128 && tid < 256) { const int e = (tid - 128) >> 6, hv = 2 * hq2 + e; araw = PSM[(size_t)(t2 + lane) * NSM + 16 + hv]; braw = PSM[(size_t)(t2 + lane) * NSM + hv]; galog = a.in[I_GALOG][hv]; gdtb = a.in[I_GDTB][hv]; } } }
        { const bool isq = wave >= 4; const int ni = isq ? 3 - (wave & 3) : (wave & 3);
          const LAS unsigned char* bbase = lds + (isq ? G2_QL : G2_KL) + (16 * ni + r16) * 272 + kq * 16;
          bf16x8 bf[4];
#pragma unroll
          for (int ks = 0; ks < 4; ++ks) bf[ks] = *(const LAS bf16x8*)(bbase + ks * 64);
          const int i = 16 * ni + r16;
#pragma unroll
          for (int mj = 0; mj < 4; ++mj) {
              if (mj > ni) {
                  const int jz = 16 * mj + 4 * kq;
#pragma unroll
                  for (int e = 0; e < 2; ++e) { if (!isq) st4bf(lds + G2_MX + e * 36864, i, jz, (f32x4){0.f, 0.f, 0.f, 0.f}); else *(u32x2*)(GATT + (chb + e) * 4096 + (size_t)i * 64 + jz) = (u32x2){0u, 0u}; }
                  continue; }
              f32x4 cacc = {0.f, 0.f, 0.f, 0.f};
              if (mj <= ni) { const LAS unsigned char* abase = lds + G2_KL + (16 * mj + r16) * 272 + kq * 16;
#pragma unroll
                  for (int ks = 0; ks < 4; ++ks) cacc = mfma16(*(const LAS bf16x8*)(abase + ks * 64), bf[ks], cacc); }
              const int j0 = 16 * mj + 4 * kq;
#pragma unroll
              for (int e = 0; e < 2; ++e) { const float gi = gcs[e * 64 + i], bi = beta[e * 64 + i]; const f32x4 gj = *(const LAS f32x4*)(gcs + e * 64 + j0);
                  f32x4 o;
#pragma unroll
                  for (int r = 0; r < 4; ++r) { const float dec = __expf(fminf(gi - gj[r], 0.f)); const float vl = cacc[r] * dec * (isq ? 1.0f : bi); o[r] = (isq ? (i >= j0 + r) : (i > j0 + r)) ? vl : 0.f; }
                  if (!isq) { if (mj == ni) *(LAS f32x4*)(lds + G2_LD + e * 5120 + ((ni * 16 + r16) * 20 + 4 * kq) * 4) = o;
                      st4bf(lds + G2_MX + e * 36864, i, j0, (mj < ni) ? o : (f32x4){0.f, 0.f, 0.f, 0.f}); }
                  else { u32x2 w; w.x = pk2(o[0], o[1]); w.y = pk2(o[2], o[3]); *(u32x2*)(GATT + (chb + e) * 4096 + (size_t)i * 64 + j0) = w; } }
          } }
        __syncthreads();
        if (wave < 2) { const int e = wave, blk = lane >> 4, jj = lane & 15; float x[16]; int lz = jj;
            const LAS float* Lb = (const LAS float*)(lds + G2_LD + e * 5120) + blk * 320;
#pragma unroll
            for (int hb = 0; hb < 2; ++hb) { const int i0 = hb ? 12 : 0, i1 = hb ? 16 : 12; f32x4 L4[12][4];
#pragma unroll
                for (int i = i0; i < i1; ++i)
#pragma unroll
                    for (int q = 0; q < (i + 3) / 4; ++q) L4[i - i0][q] = *(const LAS f32x4*)(Lb + i * 20 + 4 * q);
                __builtin_amdgcn_sched_barrier(0);
#pragma unroll
                for (int i = i0; i < i1; ++i) { asm volatile("" : "+v"(lz)); float sacc = 0.f;
#pragma unroll
                    for (int q = 0; q < (i + 3) / 4; ++q) { const f32x4 l4 = L4[i - i0][q];
#pragma unroll
                        for (int t = 0; t < 4; ++t) if (4 * q + t < i) sacc += l4[t] * x[4 * q + t]; }
                    x[i] = ((i == lz) ? 1.0f : 0.0f) - sacc; }
                __builtin_amdgcn_sched_barrier(0); }
            LAS unsigned char* di = lds + G2_MX + e * 36864 + 9216;
#pragma unroll
            for (int i = 0; i < 16; ++i) *(LAS bf16*)(di + (16 * blk + i) * 144 + (16 * blk + jj) * 2) = (bf16)f2bf(x[i]); }
        __syncthreads();
        { const int e = wave >> 2, rb = wave & 3; LAS unsigned char* mx = lds + G2_MX + e * 36864;
          mm64(mx + 9216, mx, rb, lane, [=](int r, int c0, f32x4 v) { st4bf(mx + 18432, r, c0, v); f32x4 m; for (int k = 0; k < 4; ++k) m[k] = ((r == c0 + k) ? 1.0f : 0.0f) - v[k]; st4bf(mx + 27648, r, c0, m); });
          __syncthreads();
          mm64(mx + 18432, mx + 18432, rb, lane, [=](int r, int c0, f32x4 v) { f32x4 m; for (int k = 0; k < 4; ++k) m[k] = ((r == c0 + k) ? 1.0f : 0.0f) + v[k]; st4bf(mx, r, c0, m); });
          __syncthreads();
          mm64(mx + 27648, mx, rb, lane, [=](int r, int c0, f32x4 v) { st4bf(mx + 18432, r, c0, v); });
          __syncthreads();
          mm64(mx + 18432, mx + 9216, rb, lane, [=](int r, int c0, f32x4 v) { const f32x4 b4 = *(const LAS f32x4*)(beta + e * 64 + c0), g4 = *(const LAS f32x4*)(gcs + e * 64 + c0); f32x4 tu, tw;
              for (int k = 0; k < 4; ++k) { tu[k] = v[k] * b4[k]; tw[k] = tu[k] * __expf(g4[k]); } st4bf(mx, r, c0, tu); st4bf(mx + 27648, r, c0, tw); });
          __syncthreads(); }
        { const int e = wave >> 2, kind = (wave >> 1) & 1, hf = wave & 1;
          const LAS unsigned char* mx = lds + G2_MX + e * 36864;
          if (kind == 0) {
#pragma unroll 1
              for (int nd = 0; nd < 8; ++nd) { bf16x8 v0, v1;
                  tr_frag2<0, 4 * 272, 32 * 272, 36 * 272>(lds_addr(lds + G2_VL + e * 17408 + (8 * kq + qq) * 272 + (16 * nd + 4 * pp) * 2), v0, v1);
#pragma unroll
                  for (int m2 = 0; m2 < 2; ++m2) { const int mi = 2 * hf + m2; const LAS unsigned char* ab = mx + (16 * mi + r16) * 144 + kq * 16;
                      f32x4 cc = {0.f, 0.f, 0.f, 0.f}; cc = mfma16(*(const LAS bf16x8*)(ab), v0, cc); cc = mfma16(*(const LAS bf16x8*)(ab + 64), v1, cc);
                      u32x2 w; w.x = pk2(cc[0], cc[1]); w.y = pk2(cc[2], cc[3]);
                      *(u32x2*)(GUT + (chb + e) * 8192 + (size_t)(16 * nd + r16) * 64 + 16 * mi + 4 * kq) = w; } }
          } else {
#pragma unroll 1
              for (int m4 = 0; m4 < 4; ++m4) { const int md = 4 * hf + m4; bf16x8 k0, k1;
                  tr_frag2<0, 4 * 272, 32 * 272, 36 * 272>(lds_addr(lds + G2_KL + (8 * kq + qq) * 272 + (16 * md + 4 * pp) * 2), k0, k1);
#pragma unroll
                  for (int ni = 0; ni < 4; ++ni) { const LAS unsigned char* bb = mx + 27648 + (16 * ni + r16) * 144 + kq * 16;
                      f32x4 cc = {0.f, 0.f, 0.f, 0.f}; cc = mfma16(k0, *(const LAS bf16x8*)(bb), cc); cc = mfma16(k1, *(const LAS bf16x8*)(bb + 64), cc);
                      u32x2 w; w.x = pk2(cc[0], cc[1]); w.y = pk2(cc[2], cc[3]);
                      *(u32x2*)(GW + (chb + e) * 8192 + (size_t)(16 * ni + r16) * 128 + 16 * md + 4 * kq) = w; } }
          } }
        __syncthreads();
    }
}
#undef G2_LD

constexpr int GS_ST = 0, GS_VN = 17408, GS_VN2 = 26624, GS_BUF = 35840, GS_BUFSZ = 61440, GS_W = 0, GS_Q = 17408, GS_K = 34816, GS_A = 52224;
struct GsTile { u32x4 r[7]; };
struct GsLane { u32x2 uT[2]; f32x4 gc; float g63, gcl; u32x2 z[2]; };
__device__ __forceinline__ void launder(GsLane& L) { launder(L.uT); launder(L.gc); launder(L.g63); launder(L.gcl); launder(L.z); }
__device__ __forceinline__ void gs_load_tile(GsTile& T, const bf16* GW, const bf16* QKVC, const bf16* GATT, size_t ch, int trow0, int hq, int tz) {
#pragma unroll
    for (int k = 0; k < 2; ++k) { const int id = tz + 512 * k, row = id >> 4, cc = id & 15;
        T.r[k] = *(const u32x4*)(GW + ch * 8192 + (size_t)row * 128 + cc * 8);
        T.r[2 + k] = *(const u32x4*)(QKVC + (size_t)(trow0 + row) * 4096 + hq * 128 + cc * 8);
        T.r[4 + k] = *(const u32x4*)(QKVC + (size_t)(trow0 + row) * 4096 + 1024 + hq * 128 + cc * 8); }
    { const int row = tz >> 3, cc = tz & 7; T.r[6] = *(const u32x4*)(GATT + ch * 4096 + (size_t)row * 64 + cc * 8); }
}
__device__ __forceinline__ void gs_store_tile(const GsTile& T, LAS unsigned char* buf, int tz) {
#pragma unroll
    for (int k = 0; k < 2; ++k) { const int id = tz + 512 * k, row = id >> 4, cc = id & 15;
        *(LAS u32x4*)(buf + GS_W + row * 272 + cc * 16) = T.r[k]; *(LAS u32x4*)(buf + GS_Q + row * 272 + cc * 16) = T.r[2 + k]; *(LAS u32x4*)(buf + GS_K + row * 272 + cc * 16) = T.r[4 + k]; }
    { const int row = tz >> 3, cc = tz & 7; *(LAS u32x4*)(buf + GS_A + row * 144 + cc * 16) = T.r[6]; }
}
__device__ __forceinline__ void gs_load_lane(GsLane& L, const bf16* GUT, const float* GGL, const float* GCS, size_t ch, int half, int wave, int lane, const unsigned short* zp) {
    const int ti = wave >> 1, tjp = wave & 1, r16 = lane & 15, kq = lane >> 4;
#pragma unroll
    for (int t = 0; t < 2; ++t) L.z[t] = *(const u32x2*)(zp + 16 * t);
    L.gcl = GCS[ch * 64 + 16 * ti + r16];
#pragma unroll
    for (int t = 0; t < 2; ++t) L.uT[t] = *(const u32x2*)(GUT + ch * 8192 + (size_t)(half * 64 + 16 * (2 * tjp + t) + r16) * 64 + 16 * ti + 4 * kq);
    L.gc = *(const f32x4*)(GCS + ch * 64 + 16 * ti + 4 * kq);
    L.g63 = GCS[ch * 64 + 63];
}
__device__ __forceinline__ void phase_gdn_scan(const Args& a, LAS unsigned char* lds, int vcu, int G, int tid, int wave, int lane) {
    unsigned char* ws = a.ws;
    const bf16* GW = (const bf16*)(ws + WS_GW); const bf16* QKVC = (const bf16*)(ws + WS_QKVC); const bf16* GUT = (const bf16*)(ws + WS_GUT); const bf16* GATT = (const bf16*)(ws + WS_GATT); const float* GGL = (const float*)(ws + WS_GGL); const float* GCS = (const float*)(ws + WS_GCS);
    bf16* OMIX = (bf16*)(ws + WS_OMIX); float* SSQG = (float*)(ws + WS_SSQG); const bf16* PROJ = (const bf16*)(ws + WS_PROJ);
    const int ti = wave >> 1, tjp = wave & 1, r16 = lane & 15, kq = lane >> 4, qq = (lane & 15) >> 2, pp = lane & 3;
    for (int unit = vcu; unit < NB * 16 * 2; unit += G) {
        const int half = unit & 1, hv = (unit >> 1) & 15, b = unit >> 5, hq = hv >> 1;
        const int ocol0 = hv * 128 + half * 64;
        for (int i = tid; i < 17408 / 4; i += 512) ((LAS unsigned*)(lds + GS_ST))[i] = 0u;
        f32x4 Sacc[4];
#pragma unroll
        for (int t = 0; t < 4; ++t) Sacc[t] = (f32x4){0.f, 0.f, 0.f, 0.f};
        const size_t chb = (size_t)(b * 32) * 16 + hv;
        GsTile TA, TB; GsLane L, LA, LB;
        const unsigned short* zbase = (const unsigned short*)PROJ + (size_t)(b * SEQ + 16 * ti + r16) * NPROJ + C_GZ + ocol0 + 32 * tjp + 4 * kq;
        gs_load_tile(TA, GW, QKVC, GATT, chb, b * SEQ, hq, tid); gs_load_lane(LA, GUT, GGL, GCS, chb, half, wave, lane, zbase);
        gs_load_tile(TB, GW, QKVC, GATT, chb + 16, b * SEQ + 64, hq, tid); gs_load_lane(LB, GUT, GGL, GCS, chb + 16, half, wave, lane, zbase + (size_t)64 * NPROJ);
        gs_store_tile(TA, lds + GS_BUF, tid); L = LA; launder(L);
        __syncthreads();
#pragma unroll 1
        for (int c2 = 0; c2 < 32; c2 += 2) {
#pragma unroll
          for (int hstep = 0; hstep < 2; ++hstep) {
            const int c = c2 + hstep;
            const int trow0 = b * SEQ + c * 64;
            LAS unsigned char* buf = lds + GS_BUF + hstep * GS_BUFSZ;
            int tz = tid; asm volatile("" : "+v"(tz));
            { const int cn = (c + 2 < 32) ? c + 2 : 31;
              if (hstep == 0) { gs_load_tile(TA, GW, QKVC, GATT, chb + (size_t)cn * 16, b * SEQ + cn * 64, hq, tz); gs_load_lane(LA, GUT, GGL, GCS, chb + (size_t)cn * 16, half, wave, lane, zbase + (size_t)cn * 64 * NPROJ); }
              else { gs_load_tile(TB, GW, QKVC, GATT, chb + (size_t)cn * 16, b * SEQ + cn * 64, hq, tz); gs_load_lane(LB, GUT, GGL, GCS, chb + (size_t)cn * 16, half, wave, lane, zbase + (size_t)cn * 64 * NPROJ); } }
            f32x4 ws2[2], qs[2];
            { bf16x8 aW[4], aQ[4];
#pragma unroll
              for (int ks = 0; ks < 4; ++ks) { aW[ks] = *(const LAS bf16x8*)(buf + GS_W + (16 * ti + r16) * 272 + kq * 16 + ks * 64); aQ[ks] = *(const LAS bf16x8*)(buf + GS_Q + (16 * ti + r16) * 272 + kq * 16 + ks * 64); }
#pragma unroll
              for (int t = 0; t < 2; ++t) { ws2[t] = (f32x4){0.f, 0.f, 0.f, 0.f}; qs[t] = (f32x4){0.f, 0.f, 0.f, 0.f};
                  const LAS unsigned char* sb = lds + GS_ST + (16 * (2 * tjp + t) + r16) * 272 + kq * 16;
#pragma unroll
                  for (int ks = 0; ks < 4; ++ks) { const bf16x8 bs = *(const LAS bf16x8*)(sb + ks * 64); ws2[t] = mfma16(aW[ks], bs, ws2[t]); qs[t] = mfma16(bs, aQ[ks], qs[t]); } } }
            const float lgl = L.g63, glv = __expf(L.g63);
            const f32x4 eg = {__expf(L.gc[0]), __expf(L.gc[1]), __expf(L.gc[2]), __expf(L.gc[3])};
            const f32x4 ek = {__expf(lgl - L.gc[0]), __expf(lgl - L.gc[1]), __expf(lgl - L.gc[2]), __expf(lgl - L.gc[3])};
#pragma unroll
            for (int t = 0; t < 2; ++t) { const float v0 = bflo(L.uT[t].x) - ws2[t][0], v1 = bfhi(L.uT[t].x) - ws2[t][1], v2 = bflo(L.uT[t].y) - ws2[t][2], v3 = bfhi(L.uT[t].y) - ws2[t][3];
                u32x2 w; w.x = pk2(v0, v1); w.y = pk2(v2, v3);
                *(LAS u32x2*)(lds + GS_VN + (16 * (2 * tjp + t) + r16) * 144 + (16 * ti + 4 * kq) * 2) = w;
                u32x2 w2; w2.x = pk2(v0 * ek[0], v1 * ek[1]); w2.y = pk2(v2 * ek[2], v3 * ek[3]);
                *(LAS u32x2*)(lds + GS_VN2 + (16 * (2 * tjp + t) + r16) * 144 + (16 * ti + 4 * kq) * 2) = w2; }
            __syncthreads();
            { bf16x8 aT[2];
#pragma unroll
              for (int ks = 0; ks < 2; ++ks) aT[ks] = *(const LAS bf16x8*)(buf + GS_A + (16 * ti + r16) * 144 + kq * 16 + ks * 64);
              float sq = 0.f; const float egl = __expf(L.gcl);
#pragma unroll
              for (int t = 0; t < 2; ++t) { const LAS unsigned char* vb = lds + GS_VN + (16 * (2 * tjp + t) + r16) * 144 + kq * 16;
                  f32x4 o = qs[t] * egl;
#pragma unroll
                  for (int ks = 0; ks < 2; ++ks) o = mfma16(*(const LAS bf16x8*)(vb + ks * 64), aT[ks], o);
                  sq += (o[0] * o[0] + o[1] * o[1]) + (o[2] * o[2] + o[3] * o[3]);
                  const u32x2 zz = L.z[t]; u32x2 w; w.x = pk2(o[0] * bflo(zz.x), o[1] * bfhi(zz.x)); w.y = pk2(o[2] * bflo(zz.y), o[3] * bfhi(zz.y));
                  *(u32x2*)(OMIX + (size_t)(trow0 + 16 * ti + r16) * DMIX + ocol0 + 16 * (2 * tjp + t) + 4 * kq) = w; }
              sq += __builtin_bit_cast(float, __builtin_amdgcn_ds_swizzle(__builtin_bit_cast(int, sq), 0x401F)); sq += __shfl_xor(sq, 32);
              if (kq == 0) SSQG[((size_t)(trow0 + 16 * ti + r16) * 16 + hv) * 4 + half * 2 + tjp] = sq; }
            { const unsigned ka = lds_addr(buf + GS_K + (8 * kq + qq) * 272 + (16 * wave + 4 * pp) * 2);
              const bf16x8 k0 = tr_frag<0, 4 * 272>(ka), k1 = tr_frag<32 * 272, 36 * 272>(ka);
#pragma unroll
              for (int tj = 0; tj < 4; ++tj) { const LAS unsigned char* vb = lds + GS_VN2 + (16 * tj + r16) * 144 + kq * 16;
                  f32x4 sv = Sacc[tj] * glv;
                  sv = mfma16(k0, *(const LAS bf16x8*)(vb), sv); sv = mfma16(k1, *(const LAS bf16x8*)(vb + 64), sv);
                  Sacc[tj] = sv;
                  u32x2 w; w.x = pk2(sv[0], sv[1]); w.y = pk2(sv[2], sv[3]);
                  *(LAS u32x2*)(lds + GS_ST + (16 * tj + r16) * 272 + (16 * wave + 4 * kq) * 2) = w; } }
            if (hstep == 0) { gs_store_tile(TB, lds + GS_BUF + GS_BUFSZ, tz); L = LB; } else { gs_store_tile(TA, lds + GS_BUF, tz); L = LA; }
            launder(L);
            __syncthreads();
          }
        }
    }
}

constexpr int SS_C = 0, SS_B = 34816, SS_X = 69632, SS_XD = 88064, SS_PV = 106496, SS_Z = 123904, SS_SM = 142336;
template <int k>
__device__ __forceinline__ void ssd_chunk_addr(int tz, int t0, int h, int g, const bf16* XBCC, const bf16* PROJ, const bf16*& gp, int& lo) {
    if constexpr (k < 8) { const int id = tz + 512 * (k & 3), row = id >> 4, cc = id & 15; gp = XBCC + (size_t)(t0 + row) * 3072 + (k < 4 ? 2048 : 2560) + g * 128 + cc * 8; lo = (k < 4 ? SS_B : SS_C) + row * 272 + cc * 16; }
    else if constexpr (k < 10) { const int id = tz + 512 * (k - 8), row = id >> 3, cc = id & 7; gp = XBCC + (size_t)(t0 + row) * 3072 + h * 64 + cc * 8; lo = SS_X + row * 144 + cc * 16; }
    else { const int id = tz + 512 * (k - 10), row = id >> 3, cc = id & 7; gp = PROJ + (size_t)(t0 + row) * NPROJ + C_SZ + h * 64 + cc * 8; lo = SS_Z + row * 144 + cc * 16; }
}
#define SSD_FOR_K(X) X(0) X(1) X(2) X(3) X(4) X(5) X(6) X(7) X(8) X(9) X(10) X(11)
__device__ __forceinline__ void phase_ssd(const Args& a, LAS unsigned char* lds, int vcu, int G, int tid, int wave, int lane) {
    unsigned char* ws = a.ws;
    const bf16* PROJ = (const bf16*)(ws + WS_PROJ); const bf16* XBCC = (const bf16*)(ws + WS_XBCC); const float* PSM = (const float*)(ws + WS_PSM);
    bf16* YG = (bf16*)(ws + WS_OMIX) + D; float* SSQ = (float*)(ws + WS_SSQ); const f32x4* SSDT = (const f32x4*)(ws + WS_SSDT);
    LAS float* dts = (LAS float*)(lds + SS_SM); LAS float* acs = dts + 128; LAS float* dds = dts + 256;
    const int r16 = lane & 15, kq = lane >> 4, qq = (lane & 15) >> 2, pp = lane & 3;
    for (int unit = vcu; unit < NB * 32; unit += G) {
        const int h = unit & 31, b = unit >> 5, g = h >> 3;
        const float dskip = a.in[I_SD][h];
        f32x4 pacc[4];
#pragma unroll
        for (int t = 0; t < 4; ++t) pacc[t] = (f32x4){0.f, 0.f, 0.f, 0.f};
        for (int i = tid; i < 17408 / 4; i += 512) ((LAS unsigned*)(lds + SS_PV))[i] = 0u;
        u32x4 R[12]; f32x3 sc4 = {0.f, 0.f, 0.f}; float ddx0 = 0.f, ddx1 = 0.f;
        { const int t0 = b * SEQ;
#define SSD_LD(k) { const bf16* gp; int lo; ssd_chunk_addr<k>(tid, t0, h, g, XBCC, PROJ, gp, lo); R[k] = *(const u32x4*)gp; }
          SSD_FOR_K(SSD_LD)
#undef SSD_LD
          if (tid < 128) sc4 = *(const f32x3*)(SSDT + (size_t)(t0 + tid) * 32 + h);
          ddx0 = ((const float*)(SSDT + (size_t)(t0 + (tid >> 3)) * 32 + h))[2]; ddx1 = ((const float*)(SSDT + (size_t)(t0 + 64 + (tid >> 3)) * 32 + h))[2]; }
#pragma unroll 1
        for (int c = 0; c < 16; ++c) {
            const int t0 = b * SEQ + c * 128;
            int tz = tid; asm volatile("" : "+v"(tz));
#define SSD_ST(k) { const bf16* gp; int lo; ssd_chunk_addr<k>(tz, t0, h, g, XBCC, PROJ, gp, lo); *(LAS u32x4*)(lds + lo) = R[k]; }
            SSD_FOR_K(SSD_ST)
#undef SSD_ST
            if (tid < 128) { dts[tid] = sc4[0]; acs[tid] = sc4[1]; dds[tid] = sc4[2]; }
            { const float dd2[2] = {ddx0, ddx1};
#pragma unroll
              for (int k = 0; k < 2; ++k) { const int id = tz + 512 * k, row = id >> 3, cc = id & 7; const u32x4 v = R[8 + k]; const float dd = dd2[k];
                  u32x4 o; o.x = pk2(bflo(v.x) * dd, bfhi(v.x) * dd); o.y = pk2(bflo(v.y) * dd, bfhi(v.y) * dd); o.z = pk2(bflo(v.z) * dd, bfhi(v.z) * dd); o.w = pk2(bflo(v.w) * dd, bfhi(v.w) * dd);
                  *(LAS u32x4*)(lds + SS_XD + row * 144 + cc * 16) = o; } }
            __syncthreads();
            if (c + 1 < 16) { const int t1 = t0 + 128;
#define SSD_LD(k) { const bf16* gp; int lo; ssd_chunk_addr<k>(tz, t1, h, g, XBCC, PROJ, gp, lo); R[k] = *(const u32x4*)gp; }
                SSD_FOR_K(SSD_LD)
#undef SSD_LD
                if (tid < 128) sc4 = *(const f32x3*)(SSDT + (size_t)(t1 + tid) * 32 + h);
                ddx0 = ((const float*)(SSDT + (size_t)(t1 + (tid >> 3)) * 32 + h))[2]; ddx1 = ((const float*)(SSDT + (size_t)(t1 + 64 + (tid >> 3)) * 32 + h))[2]; }
            { const int w = (wave < 4) ? wave : 11 - wave;
              bf16x8 cf[4];
              { const LAS unsigned char* cbp = lds + SS_C + (16 * w + r16) * 272 + kq * 16;
#pragma unroll
                for (int ks = 0; ks < 4; ++ks) cf[ks] = *(const LAS bf16x8*)(cbp + ks * 64); }
              f32x4 yd[4], yo[4];
#pragma unroll
              for (int pj = 0; pj < 4; ++pj) { yd[pj] = (f32x4){0.f, 0.f, 0.f, 0.f}; yo[pj] = (f32x4){0.f, 0.f, 0.f, 0.f}; }
              const int lq = 16 * w + r16; const float acl = acs[lq];
#pragma unroll
              for (int q = 0; q < 4; ++q) {
                  if (2 * q <= w) {
                      float gv[8];
#pragma unroll
                      for (int s2 = 0; s2 < 2; ++s2) { const int sb = 2 * q + s2; f32x4 gt = {0.f, 0.f, 0.f, 0.f};
                          if (sb <= w) { const LAS unsigned char* abp = lds + SS_B + (16 * sb + r16) * 272 + kq * 16;
#pragma unroll
                              for (int ks = 0; ks < 4; ++ks) gt = mfma16(*(const LAS bf16x8*)(abp + ks * 64), cf[ks], gt); }
                          const f32x4 as4 = *(const LAS f32x4*)(acs + 16 * sb + 4 * kq), dt4 = *(const LAS f32x4*)(dts + 16 * sb + 4 * kq);
#pragma unroll
                          for (int r = 0; r < 4; ++r) { const int s = 16 * sb + 4 * kq + r; const float val = gt[r] * __expf(fminf(acl - as4[r], 0.f)) * dt4[r]; gv[s2 * 4 + r] = (lq >= s) ? val : 0.f; } }
                      union { bf16x8 v; unsigned u[4]; } af; af.u[0] = pk2(gv[0], gv[1]); af.u[1] = pk2(gv[2], gv[3]); af.u[2] = pk2(gv[4], gv[5]); af.u[3] = pk2(gv[6], gv[7]);
                      const unsigned xa = lds_addr(lds + SS_X + (32 * q + 4 * kq + qq) * 144 + (4 * pp) * 2);
                      bf16x8 bx[4]; tr_frag4<32, 16 * 144>(xa, bx);
#pragma unroll
                      for (int pj = 0; pj < 4; ++pj) yd[pj] = mfma16(bx[pj], af.v, yd[pj]);
                  }
              }
#pragma unroll
              for (int pj = 0; pj < 4; ++pj) { const LAS unsigned char* pb = lds + SS_PV + (16 * pj + r16) * 272 + kq * 16;
#pragma unroll
                  for (int ks = 0; ks < 4; ++ks) yo[pj] = mfma16(*(const LAS bf16x8*)(pb + ks * 64), cf[ks], yo[pj]); }
              float ssq = 0.f;
              const int lrow = 16 * w + r16; const float el = __expf(acs[lrow]);
#pragma unroll
              for (int pj = 0; pj < 4; ++pj) { const int p0 = 16 * pj + 4 * kq;
                  const u32x2 xv = *(const LAS u32x2*)(lds + SS_X + lrow * 144 + p0 * 2); LAS u32x2* zp = (LAS u32x2*)(lds + SS_Z + lrow * 144 + p0 * 2); const u32x2 zv = *zp;
                  const float y0 = yd[pj][0] + el * yo[pj][0] + dskip * bflo(xv.x), y1 = yd[pj][1] + el * yo[pj][1] + dskip * bfhi(xv.x), y2 = yd[pj][2] + el * yo[pj][2] + dskip * bflo(xv.y), y3 = yd[pj][3] + el * yo[pj][3] + dskip * bfhi(xv.y);
                  const float z0 = y0 * bflo(zv.x), z1 = y1 * bfhi(zv.x), z2 = y2 * bflo(zv.y), z3 = y3 * bfhi(zv.y);
                  ssq += (z0 * z0 + z1 * z1) + (z2 * z2 + z3 * z3);
                  u32x2 wv; wv.x = pk2(z0, z1); wv.y = pk2(z2, z3); *zp = wv; }
              ssq += __builtin_bit_cast(float, __builtin_amdgcn_ds_swizzle(__builtin_bit_cast(int, ssq), 0x401F)); ssq += __shfl_xor(ssq, 32);
              if (kq == 0) SSQ[(size_t)(t0 + lrow) * 32 + h] = ssq;
              LDS_WAIT();
#pragma unroll
              for (int k = 0; k < 2; ++k) { const int id = lane + 64 * k, row = id >> 3, cc = id & 7; const u32x4 v = *(const LAS u32x4*)(lds + SS_Z + (16 * w + row) * 144 + cc * 16);
                  *(u32x4*)(YG + (size_t)(t0 + 16 * w + row) * DMIX + h * 64 + cc * 8) = v; }
              const float cdec = __expf(acs[127]);
              bf16x8 bt[4];
              tr_frag4<32 * 272, 4 * 272>(lds_addr(lds + SS_B + (8 * kq + qq) * 272 + (16 * w + 4 * pp) * 2), bt);
#pragma unroll
              for (int pj = 0; pj < 4; ++pj) { bf16x8 xf[4]; tr_frag4<32 * 144, 4 * 144>(lds_addr(lds + SS_XD + (8 * kq + qq) * 144 + (16 * pj + 4 * pp) * 2), xf);
                  f32x4 s = pacc[pj] * cdec;
#pragma unroll
                  for (int ks = 0; ks < 4; ++ks) s = mfma16(bt[ks], xf[ks], s);
                  pacc[pj] = s; }
              __syncthreads();
#pragma unroll
              for (int pj = 0; pj < 4; ++pj) { u32x2 wv; wv.x = pk2(pacc[pj][0], pacc[pj][1]); wv.y = pk2(pacc[pj][2], pacc[pj][3]);
                  *(LAS u32x2*)(lds + SS_PV + (16 * pj + r16) * 272 + (16 * w + 4 * kq) * 2) = wv; }
            }
            __syncthreads();
        }
    }
}

__device__ __forceinline__ void post_token(int m, int lane, const bf16* PROJ, const bf16* ORAW, const bf16* YG, const float* SSQ, bf16* OMIX, const float* gnw, const float* snw) {
    u32x4 ov[4], zv[4], yv[4];
#pragma unroll
    for (int q = 0; q < 4; ++q) { ov[q] = ((const u32x4*)(ORAW + (size_t)m * D))[lane + 64 * q]; zv[q] = ((const u32x4*)(PROJ + (size_t)m * NPROJ + C_GZ))[lane + 64 * q]; yv[q] = ((const u32x4*)(YG + (size_t)m * D))[lane + 64 * q]; }
    const f32x4 s0 = *(const f32x4*)(SSQ + (size_t)m * 32 + (lane >> 4) * 8), s1 = *(const f32x4*)(SSQ + (size_t)m * 32 + (lane >> 4) * 8 + 4);
    float rs = 1.0f / sqrtf(((s0[0] + s0[1]) + (s0[2] + s0[3]) + (s1[0] + s1[1]) + (s1[2] + s1[3])) * (1.0f / 512.0f) + EPS);
#pragma unroll
    for (int q = 0; q < 4; ++q) { const unsigned w4[4] = {ov[q].x, ov[q].y, ov[q].z, ov[q].w}; const unsigned z4[4] = {zv[q].x, zv[q].y, zv[q].z, zv[q].w}; float ss = 0.f;
#pragma unroll
        for (int k = 0; k < 4; ++k) ss += bflo(w4[k]) * bflo(w4[k]) + bfhi(w4[k]) * bfhi(w4[k]);
        ss += __shfl_xor(ss, 1); ss += __shfl_xor(ss, 2); ss += __shfl_xor(ss, 4); ss += __shfl_xor(ss, 8);
        const float r = 1.0f / sqrtf(ss * (1.0f / 128.0f) + EPS); const int d0 = (lane & 15) * 8; unsigned o4[4];
        const f32x4 g0 = *(const f32x4*)(gnw + d0), g1 = *(const f32x4*)(gnw + d0 + 4); const float gw8[8] = {g0[0], g0[1], g0[2], g0[3], g1[0], g1[1], g1[2], g1[3]};
#pragma unroll
        for (int k = 0; k < 4; ++k) o4[k] = pk2(bflo(w4[k]) * r * gw8[2 * k] * siluf_(bflo(z4[k])), bfhi(w4[k]) * r * gw8[2 * k + 1] * siluf_(bfhi(z4[k])));
        ((u32x4*)(OMIX + (size_t)m * DMIX))[lane + 64 * q] = (u32x4){o4[0], o4[1], o4[2], o4[3]}; }
#pragma unroll
    for (int q = 0; q < 4; ++q) { const float r = __shfl(rs, 16 * q); const unsigned w4[4] = {yv[q].x, yv[q].y, yv[q].z, yv[q].w}; const int c0 = (lane + 64 * q) * 8; unsigned o4[4];
        const f32x4 g0 = *(const f32x4*)(snw + c0), g1 = *(const f32x4*)(snw + c0 + 4); const float gw8[8] = {g0[0], g0[1], g0[2], g0[3], g1[0], g1[1], g1[2], g1[3]};
#pragma unroll
        for (int k = 0; k < 4; ++k) o4[k] = pk2(bflo(w4[k]) * r * gw8[2 * k], bfhi(w4[k]) * r * gw8[2 * k + 1]);
        ((u32x4*)(OMIX + (size_t)m * DMIX + D))[lane + 64 * q] = (u32x4){o4[0], o4[1], o4[2], o4[3]}; }
}
__device__ __forceinline__ void phase_post(const Args& a, int gw, int NGW, int lane) {
    unsigned char* ws = a.ws;
    const bf16* PROJ = (const bf16*)(ws + WS_PROJ); const bf16* ORAW = (const bf16*)(ws + WS_ORAW); const bf16* YG = (const bf16*)(ws + WS_YG); const float* SSQ = (const float*)(ws + WS_SSQ);
    bf16* OMIX = (bf16*)(ws + WS_OMIX);
    const float* gnw = a.in[I_GNORM]; const float* snw = a.in[I_SNORM];
    for (int m = gw; m < M; m += 2 * NGW) { post_token(m, lane, PROJ, ORAW, YG, SSQ, OMIX, gnw, snw); if (m + NGW < M) post_token(m + NGW, lane, PROJ, ORAW, YG, SSQ, OMIX, gnw, snw); }
}

constexpr int RT_R = 0, RT_LG = 1024, RT_HIST = 1024 + 64 * 33 * 4;
__device__ __forceinline__ void phase_router(const Args& a, LAS unsigned char* lds, unsigned* ctl, int vcu, int G, int tid, int wave, int lane) {
    unsigned char* ws = a.ws;
    const bf16* H = (const bf16*)(ws + WS_HB); const float* nw = a.in[I_FFNN]; unsigned char* U8 = ws + WS_U8;
    const bf16* WrH = (const bf16*)(ws + WS_WRT); const bf16* WrL = WrH + NE * D;
    int* TOPI = (int*)(ws + WS_TOPI); float* GATE = (float*)(ws + WS_GATE); int* TOKS = (int*)(ws + WS_TOKS); float* GSLOT = (float*)(ws + WS_GSLOT);
    LAS float* rr = (LAS float*)(lds + RT_R); LAS float* lg = (LAS float*)(lds + RT_LG); LAS unsigned* hist = (LAS unsigned*)(lds + RT_HIST);
    for (int i = vcu * 512 + tid; i < MAXSLOT; i += G * 512) { TOKS[i] = 0; GSLOT[i] = 0.f; }
    const int r16 = lane & 15, kq = lane >> 4;
    for (int blk = vcu; blk < M / 64; blk += G) {
        const int m0 = blk * 64;
        if (tid < 32) hist[tid] = 0u;
        for (int t = 0; t < 8; t += 4) { u32x2 xq[4][8];
#pragma unroll
            for (int q = 0; q < 4; ++q)
#pragma unroll
                for (int j = 0; j < 8; ++j) xq[q][j] = *(const u32x2*)(H + (size_t)(m0 + wave * 8 + t + q) * D + 4 * (lane + 64 * j));
#pragma unroll
            for (int q = 0; q < 4; ++q) { float s = 0.f;
#pragma unroll
                for (int j = 0; j < 8; ++j) { const float v0 = bflo(xq[q][j].x), v1 = bfhi(xq[q][j].x), v2 = bflo(xq[q][j].y), v3 = bfhi(xq[q][j].y); s += (v0 * v0 + v1 * v1) + (v2 * v2 + v3 * v3); }
                s = wave_sum(s); if (lane == 0) rr[wave * 8 + t + q] = 1.0f / sqrtf(s * (1.0f / D) + EPS); } }
        __syncthreads();
        { const int tb = wave >> 1, eb = wave & 1; const int tok = m0 + 16 * tb + r16; const float rt = rr[16 * tb + r16];
          const bf16* hp = H + (size_t)tok * D + 8 * kq; const float* np = nw + 8 * kq;
          const bf16* bh = WrH + (size_t)(16 * eb + r16) * D + 8 * kq; const bf16* bl = WrL + (size_t)(16 * eb + r16) * D + 8 * kq;
          f32x4 acc = {0.f, 0.f, 0.f, 0.f};
          constexpr int GK = 8;
#pragma unroll 1
          for (int k0 = 0; k0 < D / 32; k0 += GK) {
          u32x2 hq[GK][2]; f32x4 nq[GK][2]; bf16x8 whq[GK], wlq[GK];
#pragma unroll
          for (int g = 0; g < GK; ++g) { const int ks = k0 + g; hq[g][0] = *(const u32x2*)(hp + ks * 32); hq[g][1] = *(const u32x2*)(hp + ks * 32 + 4); nq[g][0] = *(const f32x4*)(np + ks * 32); nq[g][1] = *(const f32x4*)(np + ks * 32 + 4);
              whq[g] = *(const bf16x8*)(bh + ks * 32); wlq[g] = *(const bf16x8*)(bl + ks * 32); }
          __builtin_amdgcn_sched_barrier(0);
#pragma unroll
          for (int g = 0; g < GK; ++g) { const int ks = k0 + g;
              const f32x4 h0 = {bflo(hq[g][0].x), bfhi(hq[g][0].x), bflo(hq[g][0].y), bfhi(hq[g][0].y)}, h1 = {bflo(hq[g][1].x), bfhi(hq[g][1].x), bflo(hq[g][1].y), bfhi(hq[g][1].y)}; const f32x4 n0 = nq[g][0], n1 = nq[g][1];
              float v[8] = {h0[0] * n0[0], h0[1] * n0[1], h0[2] * n0[2], h0[3] * n0[3], h1[0] * n1[0], h1[1] * n1[1], h1[2] * n1[2], h1[3] * n1[3]};
              union { bf16x8 v8; unsigned u[4]; } ah, al; unsigned hb[8];
#pragma unroll
              for (int j = 0; j < 8; ++j) { v[j] *= rt; hb[j] = f2bf(v[j]); }
#pragma unroll
              for (int j = 0; j < 4; ++j) { ah.u[j] = hb[2 * j] | (hb[2 * j + 1] << 16); al.u[j] = pk2(v[2 * j] - bf2f(hb[2 * j]), v[2 * j + 1] - bf2f(hb[2 * j + 1])); }
              if (eb == 0) { int p0 = 0, p1 = 0; p0 = __builtin_amdgcn_cvt_pk_fp8_f32(v[0], v[1], p0, false); p0 = __builtin_amdgcn_cvt_pk_fp8_f32(v[2], v[3], p0, true); p1 = __builtin_amdgcn_cvt_pk_fp8_f32(v[4], v[5], p1, false); p1 = __builtin_amdgcn_cvt_pk_fp8_f32(v[6], v[7], p1, true);
                  *(u32x2*)(U8 + (size_t)tok * D + ks * 32 + 8 * kq) = (u32x2){(unsigned)p0, (unsigned)p1}; }
              const bf16x8 wh = whq[g], wl = wlq[g];
              acc = mfma16(ah.v8, wh, acc); acc = mfma16(al.v8, wh, acc); acc = mfma16(ah.v8, wl, acc);
          }
          __builtin_amdgcn_sched_barrier(0); }
          const float br = a.in[I_BR][16 * eb + r16];
#pragma unroll
          for (int r = 0; r < 4; ++r) lg[(16 * tb + 4 * kq + r) * 33 + 16 * eb + r16] = acc[r] + br; }
        __syncthreads();
        if (tid < 64) { const int m = m0 + tid; float v[32];
#pragma unroll
            for (int e = 0; e < 32; ++e) v[e] = lg[tid * 33 + e];
            int bi[4]; float bv[4];
#pragma unroll
            for (int k = 0; k < 4; ++k) { float best = -3.0e38f; int be = 0;
#pragma unroll
                for (int e = 0; e < 32; ++e) { const bool taken = (k > 0 && bi[0] == e) || (k > 1 && bi[1] == e) || (k > 2 && bi[2] == e); if (!taken && v[e] > best) { best = v[e]; be = e; } }
                bi[k] = be; bv[k] = best; }
            const float e0 = 1.0f, e1 = __expf(bv[1] - bv[0]), e2 = __expf(bv[2] - bv[0]), e3 = __expf(bv[3] - bv[0]); const float inv = 1.0f / (e0 + e1 + e2 + e3);
            *(int4*)(TOPI + (size_t)m * 4) = make_int4(bi[0], bi[1], bi[2], bi[3]);
            *(f32x4*)(GATE + (size_t)m * 4) = (f32x4){e0 * inv, e1 * inv, e2 * inv, e3 * inv};
#pragma unroll
            for (int k = 0; k < 4; ++k) __hip_atomic_fetch_add(&hist[bi[k]], 1u, __ATOMIC_RELAXED, __HIP_MEMORY_SCOPE_WORKGROUP); }
        __syncthreads();
        if (tid < 32) { const unsigned hcount = hist[tid]; if (hcount) atomicAdd(ctl + CW_CNT + tid, hcount); }
        __syncthreads();
    }
}

__device__ __forceinline__ void moe_bases(const unsigned* ctl, LAS int* base  , int tid) {
    if (tid < 64) {
        const int c = (tid < NE) ? (int)__hip_atomic_load(ctl + CW_CNT + tid, RLX_AGENT) : 0; const int p = (c + 255) & ~255; int incl = p;
#pragma unroll
        for (int d = 1; d < 32; d <<= 1) { const int v = __shfl_up(incl, d); if (tid >= d) incl += v; }
        if (tid < NE) base[tid] = incl - p;
        if (tid == NE - 1) base[NE] = incl; }
}
__device__ __forceinline__ void moe_tile_experts(const unsigned* ctl, LAS int* base, int tid) {
    LAS unsigned char* texp = (LAS unsigned char*)(base + 36);
    if (tid < MAXSLOT / 256) { int e = 0; for (int q = 1; q < NE; ++q) e += (base[q] <= tid * 256) ? 1 : 0;
        const int valid = (int)__hip_atomic_load(ctl + CW_CNT + e, RLX_AGENT) - (tid * 256 - base[e]);
        texp[tid] = (unsigned char)(e | ((valid <= 128) ? 0x80 : 0)); }
}
__device__ __forceinline__ void phase_slots(const Args& a, LAS unsigned char* lds, unsigned* ctl, int vcu, int G, int tid) {
    unsigned char* ws = a.ws;
    const int* TOPI = (const int*)(ws + WS_TOPI); const float* GATE = (const float*)(ws + WS_GATE); int* SLOT = (int*)(ws + WS_SLOT); int* TOKS = (int*)(ws + WS_TOKS); float* GSLOT = (float*)(ws + WS_GSLOT);
    LAS int* base = (LAS int*)lds; LAS unsigned* lcnt = (LAS unsigned*)(lds + 256); LAS unsigned* bbase = (LAS unsigned*)(lds + 512);
    moe_bases(ctl, base, tid);
    for (int blk = vcu; blk < M / 64; blk += G) {
        if (tid < 32) lcnt[tid] = 0u;
        __syncthreads();
        int e = 0; unsigned lr = 0;
        if (tid < 256) { e = TOPI[(size_t)blk * 256 + tid]; lr = __hip_atomic_fetch_add(&lcnt[e], 1u, __ATOMIC_RELAXED, __HIP_MEMORY_SCOPE_WORKGROUP); }
        __syncthreads();
        if (tid < 32) { const unsigned n = lcnt[tid]; bbase[tid] = n ? atomicAdd(ctl + CW_FILL + tid, n) : 0u; }
        __syncthreads();
        if (tid < 256) { const int slot = base[e] + (int)bbase[e] + (int)lr; SLOT[(size_t)blk * 256 + tid] = slot; TOKS[slot] = blk * 64 + (tid >> 2); GSLOT[slot] = GATE[(size_t)blk * 256 + tid]; }
        __syncthreads();
    }
}

template <bool GATHER_> struct MoeOrder {
    static constexpr bool GATHER = GATHER_, HALFSEL = true;
    const LAS int* base;
    int MT, nN, G, c, KB; const int* toks; const char* A; const char* Bt; size_t bexp;
    bool rowsplit = false;
    int tev;
    __device__ __forceinline__ bool decode(int i, int& mt, int& n, int& hs) const {
        hs = 0;
        if (rowsplit && (G & 7) == 0) {
            const int per = G >> 3, x = c & 7, cl = c >> 3, lo = (x * MT) >> 3, hi = ((x + 1) * MT) >> 3; const int T = (hi - lo) * nN, R = T / per, L = T - R * per; int j;
            if (i < R) j = i * per + cl;
            else if (i == R && L > 0) { if (2 * L <= per) { if (cl >= 2 * L) return false; j = R * per + (cl >> 1); hs = 1 + (cl & 1); } else { if (cl >= L) return false; j = R * per + cl; } }
            else return false;
            mt = lo + j / nN; n = j % nN; }
        else if ((G & 7) == 0 && (nN & 7) == 0) { const int npx = nN >> 3, per = G >> 3, x = c & 7, cl = c >> 3; const int T = MT * npx, R = T / per, L = T - R * per; int j;
            if (i < R) j = i * per + cl;
            else if (i == R && L > 0) {
                if (2 * L <= per) { if (cl >= 2 * L) return false; j = R * per + (cl >> 1); hs = 1 + (cl & 1); } else { if (cl >= L) return false; j = R * per + cl; } }
            else return false;
            mt = j / npx; n = x * npx + j % npx; }
        else { const long L = (long)i * G + c; if (L >= (long)MT * nN) return false; mt = (int)(L / nN); n = (int)(L % nN); }
        return true;
    }
    __device__ __forceinline__ void prime(int lane) { int mt = 0, n, hs; tev = decode(lane, mt, n, hs) ? (int)((const LAS unsigned char*)(base + 36))[mt] : 0; }
    __device__ bool next(int i, pg8::Unit& u) const {
        int mt, n, hs;
        if (i >= 64 || !decode(i, mt, n, hs)) return false;
        const int te = __builtin_amdgcn_readlane(tev, i); const int e = te & 31;
        if (te & 0x80) { if (hs == 2) return false; hs = 1; }
        u.pm = mt; u.pn = n; u.aux = e; u.hsel = hs;
        u.A = GATHER ? A : A + (size_t)mt * 256 * KB;
        u.B = Bt + (size_t)e * bexp + (size_t)n * 256 * KB;
        return true;
    }
    __device__ __forceinline__ void a_off(const pg8::Unit& u, const int (&sR)[2], const int (&sC)[2], unsigned (&v)[2][2], const LAS unsigned char* side = nullptr) const {
#pragma unroll
        for (int h = 0; h < 2; ++h)
#pragma unroll
            for (int i = 0; i < 2; ++i) { const int row = GATHER ? ((const LAS int*)side)[h * 128 + sR[i]] : (h * 128 + sR[i]); v[h][i] = (unsigned)(row * KB + sC[i] * 2); }
    }
};

__device__ __forceinline__ void combine_tokens(int m, int m2, int lane, bf16* H, const unsigned char* Y2, const int* SLOT, unsigned char* U3, const f32x4 (&w8)[8]) {
    const int4 sa = *(const int4*)(SLOT + (size_t)m * 4), sb = *(const int4*)(SLOT + (size_t)m2 * 4); const int s4[4] = {sa.x, sa.y, sa.z, sa.w}, t4[4] = {sb.x, sb.y, sb.z, sb.w};
    bf16* hr = H + (size_t)m * D; bf16* hr2 = H + (size_t)m2 * D; f32x4 v[8], v2[8]; unsigned ya[4][8], yb[4][8];
#pragma unroll
    for (int j = 0; j < 8; ++j) { v[j] = h4_ld(hr + 4 * (lane + 64 * j)); v2[j] = h4_ld(hr2 + 4 * (lane + 64 * j)); }
#pragma unroll
    for (int k = 0; k < 4; ++k) { const unsigned* yp = (const unsigned*)(Y2 + (size_t)s4[k] * D); const unsigned* yq = (const unsigned*)(Y2 + (size_t)t4[k] * D);
#pragma unroll
        for (int j = 0; j < 8; ++j) { ya[k][j] = yp[lane + 64 * j]; yb[k][j] = yq[lane + 64 * j]; } }
    float ss = 0.f, ss2 = 0.f;
#pragma unroll
    for (int k = 0; k < 4; ++k)
#pragma unroll
        for (int j = 0; j < 8; ++j) { const f32x2 lo = __builtin_amdgcn_cvt_pk_f32_fp8((int)ya[k][j], false), hi = __builtin_amdgcn_cvt_pk_f32_fp8((int)ya[k][j], true); v[j][0] += lo[0]; v[j][1] += lo[1]; v[j][2] += hi[0]; v[j][3] += hi[1];
            const f32x2 lo2 = __builtin_amdgcn_cvt_pk_f32_fp8((int)yb[k][j], false), hi2 = __builtin_amdgcn_cvt_pk_f32_fp8((int)yb[k][j], true); v2[j][0] += lo2[0]; v2[j][1] += lo2[1]; v2[j][2] += hi2[0]; v2[j][3] += hi2[1]; }
#pragma unroll
    for (int j = 0; j < 8; ++j) { h4_st(hr + 4 * (lane + 64 * j), v[j]); ss += (v[j][0] * v[j][0] + v[j][1] * v[j][1]) + (v[j][2] * v[j][2] + v[j][3] * v[j][3]);
        if (m2 != m) h4_st(hr2 + 4 * (lane + 64 * j), v2[j]); ss2 += (v2[j][0] * v2[j][0] + v2[j][1] * v2[j][1]) + (v2[j][2] * v2[j][2] + v2[j][3] * v2[j][3]); }
    const float r = __builtin_amdgcn_rsqf(wave_sum(ss) * (1.0f / D) + EPS), r2 = __builtin_amdgcn_rsqf(wave_sum(ss2) * (1.0f / D) + EPS);
    unsigned* o = (unsigned*)(U3 + (size_t)m * D); unsigned* o2 = (unsigned*)(U3 + (size_t)m2 * D);
#pragma unroll
    for (int j = 0; j < 8; ++j) { const f32x4 w = w8[j]; int p = 0; p = __builtin_amdgcn_cvt_pk_fp8_f32(v[j][0] * r * w[0], v[j][1] * r * w[1], p, false); p = __builtin_amdgcn_cvt_pk_fp8_f32(v[j][2] * r * w[2], v[j][3] * r * w[3], p, true); o[lane + 64 * j] = (unsigned)p;
        int p2 = 0; p2 = __builtin_amdgcn_cvt_pk_fp8_f32(v2[j][0] * r2 * w[0], v2[j][1] * r2 * w[1], p2, false); p2 = __builtin_amdgcn_cvt_pk_fp8_f32(v2[j][2] * r2 * w[2], v2[j][3] * r2 * w[3], p2, true); if (m2 != m) o2[lane + 64 * j] = (unsigned)p2; }
}
__device__ __forceinline__ void phase_combine(const Args& a, int gw, int NGW, int lane) {
    unsigned char* ws = a.ws;
    bf16* H = (bf16*)(ws + WS_HB); const unsigned char* Y2 = ws + WS_Y2; const int* SLOT = (const int*)(ws + WS_SLOT); unsigned char* U3 = ws + WS_U8; const float* nw = a.in[I_PLEN];
    f32x4 w8[8];
#pragma unroll
    for (int j = 0; j < 8; ++j) w8[j] = ((const f32x4*)nw)[lane + 64 * j];
    for (int m = gw; m < M; m += 2 * NGW) combine_tokens(m, (m + NGW < M) ? m + NGW : m, lane, H, Y2, SLOT, U3, w8);
}
__device__ __forceinline__ void phase_final(const Args& a, int gw, int NGW, int lane) {
    const bf16* HB = (const bf16*)(a.ws + WS_HB); float* H = a.out; const float* nw = a.in[I_FINN];
    f32x4 w8[8];
#pragma unroll
    for (int j = 0; j < 8; ++j) w8[j] = ((const f32x4*)nw)[lane + 64 * j];
    for (int m = gw; m < M; m += 2 * NGW) {
        const int m2 = (m + NGW < M) ? m + NGW : m;
        f32x4 v[8], v2[8]; float ss = 0.f, ss2 = 0.f;
#pragma unroll
        for (int j = 0; j < 8; ++j) { v[j] = h4_ld(HB + (size_t)m * D + 4 * (lane + 64 * j)); v2[j] = h4_ld(HB + (size_t)m2 * D + 4 * (lane + 64 * j)); }
#pragma unroll
        for (int j = 0; j < 8; ++j) { ss += (v[j][0] * v[j][0] + v[j][1] * v[j][1]) + (v[j][2] * v[j][2] + v[j][3] * v[j][3]); ss2 += (v2[j][0] * v2[j][0] + v2[j][1] * v2[j][1]) + (v2[j][2] * v2[j][2] + v2[j][3] * v2[j][3]); }
        const float r = __builtin_amdgcn_rsqf(wave_sum(ss) * (1.0f / D) + EPS), r2 = __builtin_amdgcn_rsqf(wave_sum(ss2) * (1.0f / D) + EPS);
        f32x4* hr = (f32x4*)(H + (size_t)m * D); f32x4* hr2 = (f32x4*)(H + (size_t)m2 * D);
#pragma unroll
        for (int j = 0; j < 8; ++j) { const f32x4 w = w8[j]; hr[lane + 64 * j] = (f32x4){v[j][0] * r * w[0], v[j][1] * r * w[1], v[j][2] * r * w[2], v[j][3] * r * w[3]};
            hr2[lane + 64 * j] = (f32x4){v2[j][0] * r2 * w[0], v2[j][1] * r2 * w[1], v2[j][2] * r2 * w[2], v2[j][3] * r2 * w[3]}; }
    }
}

constexpr int NPH = 13;
__global__ void __launch_bounds__(512, 2) mk_fwd(Args args) {
    extern __shared__ __attribute__((aligned(16))) unsigned char lds_raw[];
    LAS unsigned char* lds = (LAS unsigned char*)lds_raw;
    volatile LAS unsigned* MISC = (volatile LAS unsigned*)(lds + MISC_OFF);
    const int tid = threadIdx.x, lane = tid & 63, wave = __builtin_amdgcn_readfirstlane(tid >> 6);
    const int G = gridDim.x; const int bx = blockIdx.x; const int vcu = (G % 8 == 0) ? (bx % 8) * (G / 8) + bx / 8 : bx;
    const int gw = vcu * 8 + wave, NGW = G * 8;
    unsigned char* ws = args.ws; unsigned* ctl = (unsigned*)(ws + WS_CTL);
    for (int u = tid; u < (LDS_BYTES - MISC_OFF) / 4; u += 512) ((LAS unsigned*)(lds + MISC_OFF))[u] = 0u;
    __syncthreads();
    XcdBarrier bar; bar.bar = ctl + CW_BAR; bar.x = 0; bar.st = nullptr;
    if (MK_N_LAUNCHES == 1) bar = xcd_barrier_post(ctl + CW_BAR, MISC + 8);
    const int lo = args.ph_lo, hi = args.ph_hi;
#ifndef PHASE_MASK
#define PHASE_MASK 0xFFFF
#endif
#define IN(k) (((PHASE_MASK >> (k)) & 1) && lo <= (k) && (k) < hi)
#define SEAM(k) do { if (IN(k) && IN((k) + 1)) { if (MK_N_LAUNCHES == 1) xcd_barrier(bar); } } while (0)

#ifndef REPEAT_MASK
#define REPEAT_MASK 0
#endif
#define REP(k) ((REPEAT_MASK >> (k)) & 1)
#define PHASE(k, ...) do { if (IN(k)) { __VA_ARGS__ if (REP(k)) { if (MK_N_LAUNCHES == 1) xcd_barrier(bar); __VA_ARGS__ } } SEAM(k); } while (0)

    PHASE(0, { phase_prologue(args, lds, gw, NGW, lane, wave); });
    PHASE(1, {
        { const int cls = ((bx >> 2) & 1) * 2;
          _Pragma("unroll") for (int slot = 0; slot < 4; ++slot) {
              if (cls == slot) { tr_pool<1>(args, lds, gw, NGW, lane, wave); __syncthreads(); f8_pool(args, lds, gw, NGW, lane, wave); __syncthreads(); if (REP(17)) { f8_pool(args, lds, gw, NGW, lane, wave); __syncthreads(); } if (REP(20)) { f8_pool<true>(args, lds, gw, NGW, lane, wave); __syncthreads(); } if (REP(18)) { stream_probe_vgpr(args, gw, NGW, lane); __syncthreads(); } if (REP(19)) { stream_probe_dma(args, lds, gw, NGW, lane, wave); __syncthreads(); } }
              pg8::StaticOrder S; S.init(ws + WS_U, ws + WS_WINT, M, NPROJ, D, G, bx); S.i0 = 3 * slot; S.i1 = slot == 3 ? (1 << 30) : 3 * slot + 3;
              pg8::EpiBf16 E{(bf16*)(ws + WS_PROJ), NPROJ, C_GZ / 256, C_X / 256, C_SZ / 256, NPROJ / 256}; pg8::gemm_phase<pg8::EpiBf16, pg8::StaticOrder>(lds, D, S, E); } }
        { pg8::StaticOrder S; S.init(ws + WS_PBF, ws + WS_WPROJT, M, D, PLE, G, bx); pg8::EpiBf16 E{(bf16*)(ws + WS_PP), D}; pg8::gemm_phase<pg8::EpiBf16, pg8::StaticOrder>(lds, PLE, S, E); }
        small_gemm((const bf16*)(ws + WS_U), (const bf16*)(ws + WS_WSMT), (float*)(ws + WS_PSM), vcu, G, wave, lane);
    });
    PHASE(2, { phase_conv(args, vcu, G, tid, lane); phase_ssd_scalars(args, vcu, G, wave, lane); if (REP(15)) phase_conv(args, vcu, G, tid, lane); xcd_barrier(bar); phase_gdn_pre(args, lds, vcu, G, tid, wave, lane); if (REP(16)) { __syncthreads(); phase_gdn_pre(args, lds, vcu, G, tid, wave, lane); } });
    PHASE(3, { phase_gdn_scan(args, lds, vcu, G, tid, wave, lane); __syncthreads(); if (REP(13)) { phase_gdn_scan(args, lds, vcu, G, tid, wave, lane); __syncthreads(); } phase_ssd(args, lds, vcu, G, tid, wave, lane); if (REP(14)) { __syncthreads(); phase_ssd(args, lds, vcu, G, tid, wave, lane); } });

    PHASE(5, { pg8::StaticOrder S; S.init(ws + WS_OMIX, ws + WS_WOUTT, M, D, DMIX, G, bx); pg8::EpiResF32 E{args.in[I_X], (bf16*)(ws + WS_HB), D, (const float*)(ws + WS_SSQG), (const float*)(ws + WS_SSQ)}; pg8::gemm_phase<pg8::EpiResF32, pg8::StaticOrder>(lds, DMIX, S, E); });
    PHASE(6, { phase_router(args, lds, ctl, vcu, G, tid, wave, lane); });
    PHASE(7, { phase_slots(args, lds, ctl, vcu, G, tid); });
    PHASE(8, {
        LAS int* base = (LAS int*)(lds + MISC_OFF + 64);
        moe_bases(ctl, base, tid); __syncthreads(); moe_tile_experts(ctl, base, tid); __syncthreads();
        MoeOrder<true> S; S.base = base; S.MT = __builtin_amdgcn_readfirstlane(base[NE]) / 256; S.nN = 16; S.G = G; S.c = bx; S.KB = D; S.toks = (const int*)(ws + WS_TOKS); S.A = (const char*)(ws + WS_U8); S.Bt = (const char*)(ws + WS_W1T); S.bexp = (size_t)2 * FF * D;
        S.prime(lane); pg8::EpiMoe1 E{ws + WS_ACT, args.in[I_B1], (const int*)(ws + WS_TOKS)};
        pg8::gemm_phase<pg8::EpiMoe1, MoeOrder<true>, true, true, true>(lds, D, S, E);
    });
    PHASE(9, {
        LAS int* base = (LAS int*)(lds + MISC_OFF + 64);
        if (MK_N_LAUNCHES != 1 || !IN(8)) { moe_bases(ctl, base, tid); __syncthreads(); moe_tile_experts(ctl, base, tid); } __syncthreads();
        MoeOrder<false> S; S.base = base; S.MT = __builtin_amdgcn_readfirstlane(base[NE]) / 256; S.nN = 8; S.G = G; S.c = bx; S.KB = FF; S.toks = nullptr; S.rowsplit = true; S.A = (const char*)(ws + WS_ACT); S.Bt = (const char*)(ws + WS_W2T); S.bexp = (size_t)D * FF;
        S.prime(lane); pg8::EpiMoe2 E{ws + WS_Y2, args.in[I_B2], (const float*)(ws + WS_GSLOT)};
        pg8::gemm_phase<pg8::EpiMoe2, MoeOrder<false>, true, true, true>(lds, FF, S, E);
    });
    PHASE(10, { phase_combine(args, gw, NGW, lane); });
    PHASE(11, { pg8::StaticOrder S; S.init(ws + WS_U8, ws + WS_WGATET, M, D, D, G, bx, true); pg8::EpiGate E{(bf16*)(ws + WS_HB), (const bf16*)(ws + WS_PP)}; pg8::gemm_phase<pg8::EpiGate, pg8::StaticOrder, true, true, true>(lds, D, S, E); });
    PHASE(12, { phase_final(args, gw, NGW, lane); });
#undef PHASE
#undef REP
#undef IN
#undef SEAM
}

extern "C" void kernel_launch(void* const* d_in, const int* in_sizes, int n_in, void* d_out, int out_size, void* d_ws, size_t ws_size, hipStream_t stream) {
    static int grid = 0;
    if (grid == 0) {
        if (n_in != 26 || out_size != M * D || ws_size < WS_END) { fprintf(stderr, "kernel_launch: unexpected shapes (n_in %d out %d ws %zu)\n", n_in, out_size, ws_size); grid = -1; return; }
        int dev = 0, cus = 0, per_cu = 0;
        if (hipGetDevice(&dev) != hipSuccess || hipDeviceGetAttribute(&cus, hipDeviceAttributeMultiprocessorCount, dev) != hipSuccess) { grid = -1; return; }
        if (hipFuncSetAttribute((const void*)mk_fwd, hipFuncAttributeMaxDynamicSharedMemorySize, LDS_BYTES) != hipSuccess) { fprintf(stderr, "kernel_launch: hipFuncSetAttribute failed\n"); grid = -1; return; }
        if (hipOccupancyMaxActiveBlocksPerMultiprocessor(&per_cu, (const void*)mk_fwd, 512, LDS_BYTES) != hipSuccess || per_cu < 1) fprintf(stderr, "kernel_launch: occupancy query says %d\n", per_cu);
        (void)hipGetLastError();
        grid = cus;
    }
    if (grid < 0) return;
    (void)hipMemsetAsync((char*)d_ws + WS_CTL, 0, CTL_ZERO_BYTES, stream);
    Args a{};
    for (int i = 0; i < 26; ++i) a.in[i] = (const float*)d_in[i];
    a.out = (float*)d_out; a.ws = (unsigned char*)d_ws;
    if (MK_N_LAUNCHES == 1) { a.ph_lo = 0; a.ph_hi = NPH; hipLaunchKernelGGL(mk_fwd, dim3(grid), dim3(512), LDS_BYTES, stream, a); }
    else { for (int p = 0; p < NPH; ++p) { a.ph_lo = p; a.ph_hi = p + 1; hipLaunchKernelGGL(mk_fwd, dim3(grid), dim3(512), LDS_BYTES, stream, a); } }
}
```
